# Optimizing an MI355X kernel written in HIP

```python
import math
import jax, jax.numpy as jnp
from jax import lax
import numpy as np

D_MODEL = 1024
BATCH = 4
SEQ = 4096
DEPTH = 1
DEC_BATCH = 32
DEC_SEQ = 32
PAST_LEN = 2048

CHUNK = 64
Q_BLOCK = 128
PLE_DIM = 256
EPS = 1e-6
A_HEADS = D_MODEL // 128
A_DIM = 64
A_VDIM = 2 * A_DIM
R_HEADS = D_MODEL // 128
R_DK = 64
R_DV = 128
ROPE_BASE = 10000.0
D_FF = -(-8 * D_MODEL // (3 * 256)) * 256
IN_WIDTHS = (
    A_HEADS * 2 * A_DIM,
    A_HEADS * 2 * A_DIM,
    A_HEADS * A_VDIM,
    R_HEADS * R_DK,
    R_HEADS * R_DK,
    R_HEADS * R_DV,
    R_HEADS * R_DV,
    D_MODEL,
    D_MODEL,
)
IN_WIDTH = sum(IN_WIDTHS)

kernel_name = "diffattn_retention_gated_stream_step"


def rmsnorm(x, g):
    xf = x.astype(jnp.float32)
    y = xf * lax.rsqrt(jnp.mean(xf * xf, axis=-1, keepdims=True) + EPS)
    return (y * g.astype(jnp.float32)).astype(x.dtype)


def rotary(x, pos):
    half = x.shape[-1] // 2
    inv_freq = ROPE_BASE ** (-jnp.arange(half, dtype=jnp.float32) / half)
    ang = pos.astype(jnp.float32)[:, None] * inv_freq[None, :]
    cos = jnp.cos(ang)[:, None, :]
    sin = jnp.sin(ang)[:, None, :]
    x1, x2 = x[..., :half], x[..., half:]
    return jnp.concatenate([x1 * cos - x2 * sin, x1 * sin + x2 * cos], axis=-1)


def mix_inputs(x, w_in, g_norm, g_qn, g_kn, pos):
    B, T, _ = x.shape
    h = rmsnorm(x, g_norm)
    z = h @ w_in
    splits = np.cumsum(IN_WIDTHS)[:-1].tolist()
    qa, ka, va, qr, kr, vr, g_ret, gate_a, gate_r = jnp.split(z, splits, axis=-1)
    qa = rmsnorm(qa.reshape(B, T, A_HEADS, 2, A_DIM), g_qn)
    ka = rmsnorm(ka.reshape(B, T, A_HEADS, 2, A_DIM), g_kn)
    va = va.reshape(B, T, A_HEADS, A_VDIM)
    qr = rotary(qr.reshape(B, T, R_HEADS, R_DK).astype(jnp.float32), pos)
    kr = rotary(kr.reshape(B, T, R_HEADS, R_DK).astype(jnp.float32), pos) * (R_DK ** -0.5)
    vr = vr.reshape(B, T, R_HEADS, R_DV).astype(jnp.float32)
    return qa, ka, va, qr, kr, vr, g_ret, gate_a, gate_r


def diff_attn_prompt(qa, ka, va, lam):
    B, S = qa.shape[:2]
    nb = S // Q_BLOCK
    scale = A_DIM ** -0.5
    k_chunk = jnp.arange(S) // CHUNK
    qb = qa.reshape(B, nb, Q_BLOCK, A_HEADS, 2, A_DIM).swapaxes(0, 1)

    def block(args):
        q_blk, bi = args
        s = jnp.einsum('bqhcd,bkhcd->bhcqk', q_blk, ka).astype(jnp.float32) * scale
        q_chunk = (bi * Q_BLOCK + jnp.arange(Q_BLOCK)) // CHUNK
        mask = k_chunk[None, :] <= q_chunk[:, None]
        p = jax.nn.softmax(jnp.where(mask, s, -jnp.inf), axis=-1)
        a = p[:, :, 0] - lam * p[:, :, 1]
        return jnp.einsum('bhqk,bkhe->bqhe', a.astype(va.dtype), va)

    o = lax.map(block, (qb, jnp.arange(nb)))
    return o.swapaxes(0, 1).reshape(B, S, A_HEADS, A_VDIM)


def diff_attn_sample(qa, k_all, v_all, lam):
    s = jnp.einsum('bqhcd,bkhcd->bhcqk', qa, k_all).astype(jnp.float32) * (A_DIM ** -0.5)
    p = jax.nn.softmax(s, axis=-1)
    a = p[:, :, 0] - lam * p[:, :, 1]
    return jnp.einsum('bhqk,bkhe->bqhe', a.astype(v_all.dtype), v_all)


def diff_out(o, g_sub, lam_init):
    B, T = o.shape[:2]
    return (rmsnorm(o, g_sub) * (1.0 - lam_init)).reshape(B, T, A_HEADS * A_VDIM)


def ret_decay(T):
    log_g = jnp.log1p(-jnp.exp2(-5.0 - jnp.arange(R_HEADS, dtype=jnp.float32)))
    i = jnp.arange(T, dtype=jnp.float32)
    diff = i[:, None] - i[None, :]
    d_mat = jnp.where(diff >= 0, jnp.exp(log_g[:, None, None] * jnp.maximum(diff, 0.0)), 0.0)
    q_decay = jnp.exp(log_g[None, :] * (i[:, None] + 1.0))
    k_decay = jnp.exp(log_g[None, :] * (T - 1.0 - i[:, None]))
    chunk_decay = jnp.exp(log_g * T)
    return d_mat, q_decay, k_decay, chunk_decay


def retention_chunk(q, k, v, s0, d_mat, q_decay):
    inner = jnp.einsum('...ihd,...jhd->...hij', q, k) * d_mat
    o = jnp.einsum('...hij,...jhe->...ihe', inner, v)
    return o + jnp.einsum('...ihd,...hde->...ihe', q, s0) * q_decay[:, :, None]


def ret_increment(k, v, k_decay):
    return jnp.einsum('...jhd,...jhe->...hde', k * k_decay[:, :, None], v)


def retention_prompt(q, k, v):
    B, S = q.shape[:2]
    nc = S // CHUNK
    d_mat, q_decay, k_decay, chunk_decay = ret_decay(CHUNK)
    qc = q.reshape(B, nc, CHUNK, R_HEADS, R_DK)
    kc = k.reshape(B, nc, CHUNK, R_HEADS, R_DK)
    vc = v.reshape(B, nc, CHUNK, R_HEADS, R_DV)
    kv = ret_increment(kc, vc, k_decay)

    def step(s, kv_c):
        return chunk_decay[:, None, None] * s + kv_c, s

    s0 = jnp.zeros((B, R_HEADS, R_DK, R_DV), jnp.float32)
    s_final, s_starts = lax.scan(step, s0, kv.swapaxes(0, 1))
    o = retention_chunk(qc, kc, vc, s_starts.swapaxes(0, 1), d_mat, q_decay)
    return o.reshape(B, S, R_HEADS, R_DV), s_final


def retention_sample(q, k, v, s0):
    T = q.shape[1]
    d_mat, q_decay, k_decay, chunk_decay = ret_decay(T)
    o = retention_chunk(q, k, v, s0, d_mat, q_decay)
    s_new = chunk_decay[:, None, None] * s0 + ret_increment(k, v, k_decay)
    return o, s_new


def ret_out(o, g_ret, g_rn):
    B, T = o.shape[:2]
    o = rmsnorm(o, g_rn).reshape(B, T, R_HEADS * R_DV).astype(g_ret.dtype)
    return o * jax.nn.silu(g_ret)


def merge_and_tail(x, o_a, o_r, gate_a, gate_r, p, w_o, g_ffn, w_ff_gate, w_ff_up,
                   w_ff_down, g_ple, w_ple, w_ple_gate):
    mix = jax.nn.sigmoid(gate_a) * o_a + jax.nn.sigmoid(gate_r) * o_r
    x = x + mix @ w_o
    h = rmsnorm(x, g_ffn)
    x = x + (jax.nn.silu(h @ w_ff_gate) * (h @ w_ff_up)) @ w_ff_down
    gate = jax.nn.sigmoid(rmsnorm(x, g_ple) @ w_ple_gate)
    return x + gate * (p @ w_ple)


def setup_inputs(seed: int = 0) -> dict:
    key = jax.random.key(seed)
    ks = jax.random.split(key, 24)
    f32 = jnp.float32

    def nrm(k, shape, s):
        return jax.random.normal(k, shape, f32) * s

    def gain(k, shape):
        return 1.0 + 0.02 * jax.random.normal(k, shape, f32)

    return {
        "x_prompt": nrm(ks[0], (BATCH, SEQ, D_MODEL), 1.0),
        "x_sample": nrm(ks[1], (DEC_BATCH, DEC_SEQ, D_MODEL), 1.0),
        "cache_attn_k": nrm(ks[2], (DEPTH, DEC_BATCH, PAST_LEN, A_HEADS, 2 * A_DIM), 1.0),
        "cache_attn_v": nrm(ks[3], (DEPTH, DEC_BATCH, PAST_LEN, A_HEADS, A_VDIM), 1.0),
        "state_ret": nrm(ks[4], (DEPTH, DEC_BATCH, R_HEADS, R_DK, R_DV), 0.5),
        "p_prompt": nrm(ks[5], (DEPTH, BATCH, SEQ, PLE_DIM), 1.0),
        "p_sample": nrm(ks[6], (DEPTH, DEC_BATCH, DEC_SEQ, PLE_DIM), 1.0),
        "w_in": nrm(ks[7], (DEPTH, D_MODEL, IN_WIDTH), D_MODEL ** -0.5),
        "g_mix_norm": gain(ks[8], (DEPTH, D_MODEL)),
        "g_q_norm": gain(ks[9], (DEPTH, A_DIM)),
        "g_k_norm": gain(ks[10], (DEPTH, A_DIM)),
        "lam_q": nrm(ks[11], (DEPTH, 2, A_DIM), 0.1),
        "lam_k": nrm(ks[12], (DEPTH, 2, A_DIM), 0.1),
        "g_sub_norm": gain(ks[13], (DEPTH, A_VDIM)),
        "g_ret_norm": gain(ks[14], (DEPTH, R_HEADS, R_DV)),
        "w_o": nrm(ks[15], (DEPTH, D_MODEL, D_MODEL), D_MODEL ** -0.5),
        "g_ffn_norm": gain(ks[16], (DEPTH, D_MODEL)),
        "w_ff_gate": nrm(ks[17], (DEPTH, D_MODEL, D_FF), D_MODEL ** -0.5),
        "w_ff_up": nrm(ks[18], (DEPTH, D_MODEL, D_FF), D_MODEL ** -0.5),
        "w_ff_down": nrm(ks[19], (DEPTH, D_FF, D_MODEL), D_FF ** -0.5),
        "g_ple_norm": gain(ks[20], (DEPTH, D_MODEL)),
        "w_ple": nrm(ks[21], (DEPTH, PLE_DIM, D_MODEL), PLE_DIM ** -0.5),
        "w_ple_gate": nrm(ks[22], (DEPTH, D_MODEL, D_MODEL), D_MODEL ** -0.5),
    }


def reference(x_prompt, x_sample, cache_attn_k, cache_attn_v, state_ret, p_prompt, p_sample,
              w_in, g_mix_norm, g_q_norm, g_k_norm, lam_q, lam_k, g_sub_norm, g_ret_norm, w_o,
              g_ffn_norm, w_ff_gate, w_ff_up, w_ff_down, g_ple_norm, w_ple, w_ple_gate):
    S = x_prompt.shape[1]
    T = x_sample.shape[1]
    P = cache_attn_k.shape[2]
    DB = x_sample.shape[0]
    pos_p = jnp.arange(S)
    pos_s = P + jnp.arange(T)
    xp, xs = x_prompt, x_sample
    kp_l, vp_l, sp_l, ks_l, vs_l, ss_l = [], [], [], [], [], []
    for l in range(DEPTH):
        lam_init = 0.8 - 0.6 * math.exp(-0.3 * l)
        lq = lam_q[l].astype(jnp.float32)
        lk = lam_k[l].astype(jnp.float32)
        lam = jnp.exp(jnp.sum(lq[0] * lk[0])) - jnp.exp(jnp.sum(lq[1] * lk[1])) + lam_init

        qa, ka, va, qr, kr, vr, g_ret, gate_a, gate_r = mix_inputs(
            xp, w_in[l], g_mix_norm[l], g_q_norm[l], g_k_norm[l], pos_p)
        o_a = diff_out(diff_attn_prompt(qa, ka, va, lam), g_sub_norm[l], lam_init)
        o_r, s_fin = retention_prompt(qr, kr, vr)
        o_r = ret_out(o_r, g_ret, g_ret_norm[l])
        kp_l.append(ka.reshape(xp.shape[0], S, A_HEADS, 2 * A_DIM).astype(cache_attn_k.dtype))
        vp_l.append(va.astype(cache_attn_v.dtype))
        sp_l.append(s_fin.astype(state_ret.dtype))
        xp = merge_and_tail(xp, o_a, o_r, gate_a, gate_r, p_prompt[l], w_o[l], g_ffn_norm[l],
                            w_ff_gate[l], w_ff_up[l], w_ff_down[l], g_ple_norm[l], w_ple[l],
                            w_ple_gate[l])

        qa, ka, va, qr, kr, vr, g_ret, gate_a, gate_r = mix_inputs(
            xs, w_in[l], g_mix_norm[l], g_q_norm[l], g_k_norm[l], pos_s)
        k_all = jnp.concatenate(
            [cache_attn_k[l].reshape(DB, P, A_HEADS, 2, A_DIM).astype(ka.dtype), ka], axis=1)
        v_all = jnp.concatenate([cache_attn_v[l].astype(va.dtype), va], axis=1)
        o_a = diff_out(diff_attn_sample(qa, k_all, v_all, lam), g_sub_norm[l], lam_init)
        o_r, s_new = retention_sample(qr, kr, vr, state_ret[l].astype(jnp.float32))
        o_r = ret_out(o_r, g_ret, g_ret_norm[l])
        ks_l.append(ka.reshape(DB, T, A_HEADS, 2 * A_DIM).astype(cache_attn_k.dtype))
        vs_l.append(va.astype(cache_attn_v.dtype))
        ss_l.append(s_new.astype(state_ret.dtype))
        xs = merge_and_tail(xs, o_a, o_r, gate_a, gate_r, p_sample[l], w_o[l], g_ffn_norm[l],
                            w_ff_gate[l], w_ff_up[l], w_ff_down[l], g_ple_norm[l], w_ple[l],
                            w_ple_gate[l])

    return (xp, xs, jnp.stack(kp_l), jnp.stack(vp_l), jnp.stack(sp_l),
            jnp.stack(ks_l), jnp.stack(vs_l), jnp.stack(ss_l))
```

```cpp
#include <hip/hip_runtime.h>
#include <cstdint>
#include <cstdio>

typedef unsigned short bf16_t;

constexpr int DM = 1024, SEQ = 4096, NB = 4, MP = NB * SEQ;
constexpr int DB = 32, DT = 32, MS = DB * DT, PAST = 2048;
constexpr int M = MP + MS;
constexpr int NIN = 8192, DFF = 2816, PLE = 256, NH = 8;
constexpr float EPS = 1e-6f;
constexpr float LAM_INIT = 0.2f;
constexpr float LOG2E = 1.4426950408889634f;
constexpr float QSCALE = 0.125f * LOG2E;

constexpr size_t O_Y = 0, O_NKP = 17825792, O_NVP = 34603008, O_NRP = 51380224, O_NKS = 51642368, O_NVS = 52690944, O_NRS = 53739520, O_END = 55836672;

constexpr size_t MiB = 1u << 20;
constexpr size_t WS_CTL = 0;
constexpr size_t WS_SC = 512 * 1024;
constexpr size_t WS_ROPE = 1 * MiB;
constexpr size_t WS_WIN = 4 * MiB;
constexpr size_t WS_WO = 20 * MiB;
constexpr size_t WS_WGU = 24 * MiB;
constexpr size_t WS_WDN = 35 * MiB;
constexpr size_t WS_WPG = 41 * MiB;
constexpr size_t WS_WPL = 43 * MiB;
constexpr size_t WS_H = 44 * MiB;
constexpr size_t WS_PB = 78 * MiB;
constexpr size_t WS_Q = 87 * MiB;
constexpr size_t WS_KB = 121 * MiB;
constexpr size_t WS_VB = 155 * MiB;
constexpr size_t WS_QR = 189 * MiB;
constexpr size_t WS_KR = 206 * MiB;
constexpr size_t WS_VR = 223 * MiB;
constexpr size_t WS_GS = 257 * MiB;
constexpr size_t WS_GA = 291 * MiB;
constexpr size_t WS_GR = 325 * MiB;
constexpr size_t WS_MIX = 359 * MiB;
constexpr size_t WS_X1 = 427 * MiB;
constexpr size_t WS_X1G = 495 * MiB;
constexpr size_t WS_SS = 529 * MiB;
constexpr size_t WS_HID = 530 * MiB;
constexpr size_t WS_X2G = 624 * MiB;
constexpr size_t WS_T = 658 * MiB;
constexpr size_t WS_NS1 = 692 * MiB;
constexpr size_t WS_NS2 = 828 * MiB;
constexpr size_t WS_END = 964 * MiB;

__device__ __forceinline__ float bf2f(bf16_t v) { return __uint_as_float((unsigned)v << 16); }
__device__ __forceinline__ bf16_t f2bf(float f) { unsigned u = __float_as_uint(f); return (bf16_t)((u + 0x7fffu + ((u >> 16) & 1u)) >> 16); }
__device__ __forceinline__ unsigned pk2(float lo, float hi) { return (unsigned)f2bf(lo) | ((unsigned)f2bf(hi) << 16); }
__device__ __forceinline__ float sigmoidf_(float x) { return 1.0f / (1.0f + __expf(-x)); }
__device__ __forceinline__ float siluf_(float x) { return x / (1.0f + __expf(-x)); }

struct Ptrs {
    const float* in[23];
    float* out;
    unsigned char* ws;
};
namespace pg8 {
#define PG8_LAS __attribute__((address_space(3)))
typedef unsigned short bf16_t;
typedef short bf16x8 __attribute__((ext_vector_type(8)));
typedef float f32x4 __attribute__((ext_vector_type(4)));
typedef unsigned u32x4 __attribute__((ext_vector_type(4)));
constexpr int BM = 256, BK = 64, HALF = 128, HTB = HALF * BK * 2  , STAGE_BYTES = 8 * HTB, NXCD = 8, WGM = 8;

__host__ __device__ __forceinline__ int lds_byte(int r, int c) { const int st = (r >> 4) * 2 + (c >> 5), rr = r & 15, cc = c & 31, ob = rr * 64 + cc * 2; return st * 1024 + (ob ^ (((ob >> 9) & 1) << 5)); }
__host__ __device__ __forceinline__ void stage_rc(int b, int& R, int& C) { const int st = b / 1024, sb = b % 1024, swz = sb ^ (((sb >> 9) & 1) << 5); R = (st >> 1) * 16 + swz / 64; C = (st & 1) * 32 + (swz % 64) / 2; }
__host__ __device__ __forceinline__ int perm32(int rho) { const int n = rho >> 4, i = rho & 15; return 8 * (i >> 2) + 4 * n + (i & 3); }

struct Unit { int pm, pn; };
struct Gemm { const bf16_t* A; const bf16_t* Bt; int M, N, K; };

struct StaticOrder {
    int nM, nN, nwg, G, c;
    __host__ __device__ void init(int M, int N, int G_, int c_) { nM = M / BM; nN = N / BM; nwg = nM * nN; G = G_; c = c_; }
    __host__ __device__ bool next(int i, Unit& u) const {
        const long L = (long)i * G + c; if (L >= nwg) return false;
        int wgid = (int)L; { const int q = nwg / NXCD, r = nwg % NXCD, xcd = wgid % NXCD, off = wgid / NXCD; wgid = (xcd < r ? xcd * (q + 1) : r * (q + 1) + (xcd - r) * q) + off; }
        const int nig = WGM * nN, gid = wgid / nig, fm = gid * WGM, gsz = (nM - fm) < WGM ? (nM - fm) : WGM;
        u.pm = fm + ((wgid % nig) % gsz); u.pn = (wgid % nig) / gsz; return true;
    }
    __device__ __forceinline__ void a_ready(const Unit&) const {}
    __device__ __forceinline__ void done(const Unit&) const {}
};
__device__ __forceinline__ unsigned cvt_pk_bf16(float lo, float hi) { unsigned r; asm volatile("v_cvt_pk_bf16_f32 %0, %1, %2" : "=v"(r) : "v"(lo), "v"(hi)); return r; }
typedef float f32x2 __attribute__((ext_vector_type(2)));
template <class Epi, class Sched, bool ALIGN_EPI = false, bool SP2 = false>
__device__ __forceinline__ void gemm_phase(PG8_LAS unsigned char* lds, const Gemm g, const Sched& S, const Epi& E) {
    const int tid = threadIdx.x, wid = __builtin_amdgcn_readfirstlane(tid >> 6), lane = tid & 63, wr = wid >> 2, wc = wid & 3, fr = lane & 15, fq = lane >> 4;
    const int K = g.K, nt = K / BK;
    unsigned voffA[2], voffB[2];
#pragma unroll
    for (int i = 0; i < 2; ++i) { int R, C; stage_rc(tid * 16 + i * 8192, R, C); const int Rb = Epi::PERM ? ((R & ~31) + perm32(R & 31)) : R;
        voffA[i] = (unsigned)(R * K + C) * 2u; voffB[i] = (unsigned)(Rb * K + C) * 2u; }
    const size_t kstep = (size_t)(BK * 2);
    const size_t hstep = (size_t)HALF * K * 2;
    const size_t tstep = 2 * hstep;
    const unsigned ldsw = (unsigned)wid * 1024u;
    const int aoff = lds_byte(wr * 64 + fr, fq * 8), boff = lds_byte(wc * 32 + fr, fq * 8);
#define PG8_SA(b, h) (((b) * 2 + (h)) * HTB)
#define PG8_SB(b, h) ((4 + (b) * 2 + (h)) * HTB)
#define PG8_STAGE(bufoff, gbase, voff) do { _Pragma("unroll") for (int _i = 0; _i < 2; ++_i) \
        __builtin_amdgcn_global_load_lds((const unsigned*)((const char*)(gbase) + (voff)[_i]), (PG8_LAS unsigned*)(lds + (bufoff) + ldsw + _i * 8192), 16, 0, 0); } while (0)
#define PG8_LDA(dst, b, h) do { _Pragma("unroll") for (int m = 0; m < 4; ++m) _Pragma("unroll") for (int k = 0; k < 2; ++k) dst[m][k] = *(const PG8_LAS bf16x8*)(lds + PG8_SA(b, h) + aoff + m * 2048 + k * 1024); } while (0)
#define PG8_LDB(dst, b, h) do { _Pragma("unroll") for (int n = 0; n < 2; ++n) _Pragma("unroll") for (int k = 0; k < 2; ++k) dst[n][k] = *(const PG8_LAS bf16x8*)(lds + PG8_SB(b, h) + boff + n * 2048 + k * 1024); } while (0)
#define PG8_MMA(ai, bj, At, Bt) do { __builtin_amdgcn_s_setprio(1); _Pragma("unroll") for (int m = 0; m < 4; ++m) _Pragma("unroll") for (int n = 0; n < 2; ++n) _Pragma("unroll") for (int k = 0; k < 2; ++k) \
        acc[ai][bj][m][n] = __builtin_amdgcn_mfma_f32_16x16x32_bf16(Bt[n][k], At[m][k], acc[ai][bj][m][n], 0, 0, 0); __builtin_amdgcn_s_setprio(0); } while (0)
#define PG8_WAIT_V(n) asm volatile("s_waitcnt vmcnt(" #n ")" ::: "memory")
#define PG8_WAIT_L(n) asm volatile("s_waitcnt lgkmcnt(" #n ")" ::: "memory")
#define PG8_BAR __builtin_amdgcn_s_barrier()
#define PG8_SCHED __builtin_amdgcn_sched_barrier(0)
    Unit cur, nxt; int ui = 0;
    if (!S.next(0, cur)) return;
    f32x4 acc[2][2][4][2];
#pragma unroll
    for (int a = 0; a < 2; ++a)
#pragma unroll
        for (int b = 0; b < 2; ++b)
#pragma unroll
            for (int m = 0; m < 4; ++m)
#pragma unroll
                for (int n = 0; n < 2; ++n) acc[a][b][m][n] = (f32x4){0.f, 0.f, 0.f, 0.f};
    bf16x8 At[4][2], B0[2][2], B1[2][2];
    const char* cA = (const char*)g.A + (size_t)cur.pm * tstep; const char* cB = (const char*)g.Bt + (size_t)cur.pn * tstep;
    S.a_ready(cur);
    if constexpr (SP2) {
        PG8_STAGE(PG8_SB(0, 0), cB, voffB); PG8_STAGE(PG8_SB(0, 1), cB + hstep, voffB); PG8_STAGE(PG8_SA(0, 0), cA, voffA); PG8_STAGE(PG8_SA(0, 1), cA + hstep, voffA);
        if (wr == 1) PG8_BAR;
        PG8_WAIT_V(2); PG8_BAR;
        PG8_STAGE(PG8_SB(1, 0), cB + kstep, voffB); PG8_STAGE(PG8_SA(1, 0), cA + kstep, voffA); PG8_STAGE(PG8_SB(1, 1), cB + hstep + kstep, voffB);
        PG8_WAIT_V(6); PG8_BAR;
    } else {
        PG8_STAGE(PG8_SB(0, 0), cB, voffB); PG8_STAGE(PG8_SA(0, 0), cA, voffA); PG8_STAGE(PG8_SB(0, 1), cB + hstep, voffB); PG8_STAGE(PG8_SA(0, 1), cA + hstep, voffA);
        if (wr == 1) PG8_BAR;
        PG8_WAIT_V(4); PG8_BAR;
        PG8_STAGE(PG8_SB(1, 0), cB + kstep, voffB); PG8_STAGE(PG8_SA(1, 0), cA + kstep, voffA); PG8_STAGE(PG8_SB(1, 1), cB + hstep + kstep, voffB);
        PG8_WAIT_V(6); PG8_BAR;
    }
    for (;;) {
        const bool has_next = S.next(ui + 1, nxt);
        const char* nA = has_next ? (const char*)g.A + (size_t)nxt.pm * tstep : cA; const char* nB = has_next ? (const char*)g.Bt + (size_t)nxt.pn * tstep : cB;
        for (int t = 0; t < nt; t += 2) {
            const bool last = (t == nt - 2);
            const char* a1 = cA + (size_t)(t + 1) * kstep;
            const char* a2 = last ? nA : cA + (size_t)(t + 2) * kstep; const char* b2 = last ? nB : cB + (size_t)(t + 2) * kstep;
            const char* a3 = a2 + kstep; const char* b3 = b2 + kstep;
            if (last && has_next) S.a_ready(nxt);
            if constexpr (SP2) {
            PG8_LDB(B0, 0, 0); PG8_LDB(B1, 0, 1); PG8_SCHED; PG8_LDA(At, 0, 0); PG8_STAGE(PG8_SA(1, 1), a1 + hstep, voffA);
            PG8_WAIT_V(8); PG8_WAIT_L(0); PG8_BAR; PG8_MMA(0, 0, At, B0); PG8_MMA(0, 1, At, B1); PG8_BAR; PG8_SCHED;
            PG8_LDA(At, 0, 1); PG8_STAGE(PG8_SB(0, 0), b2, voffB); PG8_STAGE(PG8_SB(0, 1), b2 + hstep, voffB); PG8_STAGE(PG8_SA(0, 0), a2, voffA);
            PG8_WAIT_V(8); PG8_WAIT_L(0); PG8_BAR; PG8_MMA(1, 0, At, B0); PG8_MMA(1, 1, At, B1); PG8_BAR; PG8_SCHED;
            PG8_LDB(B0, 1, 0); PG8_LDB(B1, 1, 1); PG8_SCHED; PG8_LDA(At, 1, 0); PG8_STAGE(PG8_SA(0, 1), a2 + hstep, voffA);
            PG8_WAIT_V(8); PG8_WAIT_L(0); PG8_BAR; PG8_MMA(0, 0, At, B0); PG8_MMA(0, 1, At, B1); PG8_BAR; PG8_SCHED;
            PG8_LDA(At, 1, 1); PG8_STAGE(PG8_SB(1, 0), b3, voffB); PG8_STAGE(PG8_SB(1, 1), b3 + hstep, voffB); PG8_STAGE(PG8_SA(1, 0), a3, voffA);
            PG8_WAIT_V(8); PG8_WAIT_L(0); PG8_BAR; PG8_MMA(1, 0, At, B0); PG8_MMA(1, 1, At, B1); PG8_BAR; PG8_SCHED;
            } else {
            PG8_LDB(B0, 0, 0); PG8_SCHED; PG8_LDA(At, 0, 0); PG8_STAGE(PG8_SA(1, 1), a1 + hstep, voffA);
            PG8_WAIT_L(8); PG8_BAR; PG8_WAIT_L(0); PG8_MMA(0, 0, At, B0); PG8_BAR; PG8_SCHED;
            PG8_LDB(B1, 0, 1); PG8_STAGE(PG8_SB(0, 0), b2, voffB);
            PG8_BAR; PG8_WAIT_L(0); PG8_MMA(0, 1, At, B1); PG8_BAR;
            PG8_LDA(At, 0, 1); PG8_STAGE(PG8_SA(0, 0), a2, voffA);
            PG8_BAR; PG8_WAIT_L(0); PG8_MMA(1, 0, At, B0); PG8_BAR; PG8_SCHED;
            PG8_STAGE(PG8_SB(0, 1), b2 + hstep, voffB);
            PG8_WAIT_V(6); PG8_BAR; PG8_MMA(1, 1, At, B1); PG8_BAR;
            PG8_LDB(B0, 1, 0); PG8_SCHED; PG8_LDA(At, 1, 0); PG8_STAGE(PG8_SA(0, 1), a2 + hstep, voffA);
            PG8_WAIT_L(8); PG8_BAR; PG8_WAIT_L(0); PG8_MMA(0, 0, At, B0); PG8_BAR; PG8_SCHED;
            PG8_LDB(B1, 1, 1); PG8_STAGE(PG8_SB(1, 0), b3, voffB);
            PG8_BAR; PG8_WAIT_L(0); PG8_MMA(0, 1, At, B1); PG8_BAR;
            PG8_LDA(At, 1, 1); PG8_STAGE(PG8_SA(1, 0), a3, voffA);
            PG8_BAR; PG8_WAIT_L(0); PG8_MMA(1, 0, At, B0); PG8_BAR; PG8_SCHED;
            PG8_STAGE(PG8_SB(1, 1), b3 + hstep, voffB);
            PG8_WAIT_V(6); PG8_BAR; PG8_MMA(1, 1, At, B1); PG8_BAR;
            }
        }
        if constexpr (ALIGN_EPI) { if (wr == 0) PG8_BAR; }
        if constexpr (!Epi::AFTER_DRAIN) { E(acc, cur, wr, wc, fr, fq); S.done(cur); }
        if (!has_next) break;
#pragma unroll
        for (int a = 0; a < 2; ++a)
#pragma unroll
            for (int b = 0; b < 2; ++b)
#pragma unroll
                for (int m = 0; m < 4; ++m)
#pragma unroll
                    for (int n = 0; n < 2; ++n) acc[a][b][m][n] = (f32x4){0.f, 0.f, 0.f, 0.f};
        cur = nxt; cA = nA; cB = nB; ++ui;
        if constexpr (ALIGN_EPI) { if (wr == 1) PG8_BAR; }
    }
    PG8_WAIT_V(0);
    if constexpr (!ALIGN_EPI) { if (wr == 0) PG8_BAR; }
    PG8_BAR;
    if constexpr (Epi::AFTER_DRAIN) { E.fused(acc, cur, wr, wc, fr, fq, lds, wid, lane); S.done(cur); }
#undef PG8_SA
#undef PG8_SB
#undef PG8_STAGE
#undef PG8_LDA
#undef PG8_LDB
#undef PG8_MMA
#undef PG8_WAIT_V
#undef PG8_WAIT_L
#undef PG8_BAR
#undef PG8_SCHED
}
}
#define GAS __attribute__((address_space(1)))
#define LAS __attribute__((address_space(3)))
typedef unsigned v4u __attribute__((ext_vector_type(4)));
typedef unsigned v2u __attribute__((ext_vector_type(2)));
typedef float f32x4 __attribute__((ext_vector_type(4)));
typedef float f32x16 __attribute__((ext_vector_type(16)));
typedef short bf16x8 __attribute__((ext_vector_type(8)));
typedef short s16x4 __attribute__((ext_vector_type(4)));
typedef GAS unsigned gu32;
#define LDS_WAIT() asm volatile("s_waitcnt lgkmcnt(0)" ::: "memory")
#define VM_WAIT() asm volatile("s_waitcnt vmcnt(0)" ::: "memory")
#define LBAR() asm volatile("s_waitcnt lgkmcnt(0)\n\ts_barrier" ::: "memory")

constexpr int NWAVES = 8, NTHREADS = 512;
constexpr int RING_OFF = 0, RING_BYTES = 131072;
constexpr int LDSCTL_OFF = RING_BYTES, MISC_OFF = LDSCTL_OFF + 320;
constexpr int LDS_BYTES = 147456;
constexpr int CW_BAR = 4096;
constexpr int CW_QUEUE = 1024;
constexpr size_t CTL_ZERO_BYTES = 64 * 1024;

#define XB_TMO      128
#define XB_XCNT(j)  (256  + 64 * (j))
#define XB_XSUB(j)  (1280 + 64 * (j))
#define XB_XGEN(j)  (2304 + 64 * (j))
#define XB_TOP      3328
#define XB_TOPGEN   3392
#define XCD_BAR_WORDS 3456
#define XB_SPIN_CAP (1u << 18)

__device__ __forceinline__ unsigned xb_ld(unsigned* p)              { return __hip_atomic_load(p, __ATOMIC_RELAXED, __HIP_MEMORY_SCOPE_AGENT); }
__device__ __forceinline__ unsigned xb_add(unsigned* p, unsigned v) { return __hip_atomic_fetch_add(p, v, __ATOMIC_RELAXED, __HIP_MEMORY_SCOPE_AGENT); }
__device__ __forceinline__ unsigned xb_xcc_id() { return (unsigned)__builtin_amdgcn_s_getreg((3 << 11) | 20) & 0xFu; }
#define XB_SPIN(cond, bar) do { unsigned _sp = 0; while (cond) { __builtin_amdgcn_s_sleep(1); \
    if ((++_sp & 255u) == 0u) { if (xb_ld(&(bar)[XB_TMO])) break; if (_sp > XB_SPIN_CAP) { atomicAdd(&(bar)[XB_TMO], 1u); break; } } } } while (0)

struct XcdBarrier {
    unsigned* bar; unsigned x;
    volatile LAS unsigned* st;
};

__device__ __forceinline__ XcdBarrier xcd_barrier_post(unsigned* bar, volatile LAS unsigned* st) {
    XcdBarrier b; b.bar = bar; b.x = xb_xcc_id(); b.st = st;
    if (threadIdx.x == 0) (void)xb_add(&bar[XB_XCNT(b.x)], 1u);
    return b;
}
__device__ __forceinline__ void xcd_barrier_complete(unsigned* bar, unsigned x, unsigned& nloc, unsigned& nx) {
    const unsigned G = gridDim.x * gridDim.y * gridDim.z;
    unsigned sum, cnt, mine, sp = 0u;
    for (;;) {
        sum = 0u; cnt = 0u; mine = 0u;
#pragma unroll
        for (unsigned j = 0; j < 16; ++j) { const unsigned c = xb_ld(&bar[XB_XCNT(j)]); sum += c; cnt += (c > 0u) ? 1u : 0u; mine = (j == x) ? c : mine; }
        if (sum == G) break;
        __builtin_amdgcn_s_sleep(1);
        if ((++sp & 255u) == 0u) { if (xb_ld(&bar[XB_TMO])) break; if (sp > XB_SPIN_CAP) { atomicAdd(&bar[XB_TMO], 1u); break; } }
    }
    nloc = mine > 0u ? mine : 1u; nx = cnt > 0u ? cnt : 1u;
}

__device__ __forceinline__ void xcd_barrier(const XcdBarrier& b) {
    asm volatile("s_waitcnt vmcnt(0)" ::: "memory");
    __syncthreads();
    if (threadIdx.x == 0) {
        unsigned* bar = b.bar;
        __builtin_amdgcn_s_waitcnt(0);
        unsigned nloc = b.st[0], nx = b.st[1];
        if (nloc == 0u) { xcd_barrier_complete(bar, b.x, nloc, nx); b.st[0] = nloc; b.st[1] = nx; }
        const unsigned old = xb_add(&bar[XB_XSUB(b.x)], 1u);
        const unsigned gen = old / nloc;
        if (old + 1u == (gen + 1u) * nloc) {
            __builtin_amdgcn_fence(__ATOMIC_RELEASE, "agent");
            asm volatile("s_waitcnt vmcnt(0)" ::: "memory");
            const unsigned og = xb_add(&bar[XB_TOP], 1u);
            const unsigned tg = og / nx;
            if (og + 1u == (tg + 1u) * nx) xb_add(&bar[XB_TOPGEN], 1u);
            else XB_SPIN(xb_ld(&bar[XB_TOPGEN]) == tg, bar);
            __builtin_amdgcn_fence(__ATOMIC_ACQUIRE, "agent");
            xb_add(&bar[XB_XGEN(b.x)], 1u);
            asm volatile("s_waitcnt vmcnt(0)" ::: "memory");
        } else {
            XB_SPIN(xb_ld(&bar[XB_XGEN(b.x)]) == gen, bar);
            __builtin_amdgcn_fence(__ATOMIC_ACQUIRE, "agent");
            asm volatile("s_waitcnt vmcnt(0)" ::: "memory");
        }
    }
    __syncthreads();
}
namespace pg8 {
#define PG8_LANEPOS int t_ = threadIdx.x; asm volatile("" : "+v"(t_)); const int wid_ = __builtin_amdgcn_readfirstlane(t_ >> 6), wr = wid_ >> 2, wc = wid_ & 3, fr = t_ & 15, fq = (t_ >> 4) & 3

__device__ __forceinline__ u32x4 pack8(const f32x4 a, const f32x4 b) { u32x4 w; w.x = cvt_pk_bf16(a[0], a[1]); w.y = cvt_pk_bf16(a[2], a[3]); w.z = cvt_pk_bf16(b[0], b[1]); w.w = cvt_pk_bf16(b[2], b[3]); return w; }
__device__ __forceinline__ float fsig(float x) { return __builtin_amdgcn_rcpf(1.0f + __builtin_amdgcn_exp2f(-LOG2E * x)); }
__device__ __forceinline__ f32x4 sig4(const f32x4 v) { return (f32x4){fsig(v[0]), fsig(v[1]), fsig(v[2]), fsig(v[3])}; }
__device__ __forceinline__ f32x4 silu4(const f32x4 v) { return (f32x4){v[0] * fsig(v[0]), v[1] * fsig(v[1]), v[2] * fsig(v[2]), v[3] * fsig(v[3])}; }
__device__ __forceinline__ f32x4 bf4_lo(const u32x4 w, int half) {
    const unsigned a = half ? w.z : w.x, b = half ? w.w : w.y;
    return (f32x4){__uint_as_float(a << 16), __uint_as_float(a & 0xffff0000u), __uint_as_float(b << 16), __uint_as_float(b & 0xffff0000u)};
}

struct EpiInProj {
    static constexpr bool PERM = true, AFTER_DRAIN = false;
    const float* gq; const float* gk; float* out; unsigned char* ws; int force_cat;
    __device__ __forceinline__ void operator()(const f32x4 (&acc)[2][2][4][2], const Unit& u, int, int, int, int) const {
        PG8_LANEPOS;
        const int pn = u.pn, cat = force_cat >= 0 ? force_cat : (pn >> 2);
        const int row0 = u.pm * BM + wr * 64 + fr;
        const int lc0 = (pn & 3) * 256 + wc * 64 + 8 * fq;
        const bool smp = u.pm >= (MP / BM);
        bf16_t* const Q = (bf16_t*)(ws + WS_Q); bf16_t* const Kb = (bf16_t*)(ws + WS_KB);
        if (cat == 0 || cat == 1) {
            const float* g = cat == 0 ? gq : gk; f32x4 gv[2][2];
#pragma unroll
            for (int bj = 0; bj < 2; ++bj)
#pragma unroll
                for (int n = 0; n < 2; ++n) { gv[bj][n] = *(const f32x4*)(g + 32 * bj + 8 * fq + 4 * n); if (cat == 0) gv[bj][n] = gv[bj][n] * QSCALE; }
            float* ok = smp ? out + O_NKS - (size_t)MP * DM : out + O_NKP;
            float rs[2][4];
#pragma unroll
            for (int ai = 0; ai < 2; ++ai)
#pragma unroll
                for (int m = 0; m < 4; ++m) { float ss = 0.f;
#pragma unroll
                    for (int bj = 0; bj < 2; ++bj)
#pragma unroll
                        for (int n = 0; n < 2; ++n) { const f32x4 v = acc[ai][bj][m][n]; ss += (v[0] * v[0] + v[1] * v[1]) + (v[2] * v[2] + v[3] * v[3]); }
                    rs[ai][m] = ss; }
#pragma unroll
            for (int ai = 0; ai < 2; ++ai)
#pragma unroll
                for (int m = 0; m < 4; ++m) rs[ai][m] += __shfl_xor(rs[ai][m], 16);
#pragma unroll
            for (int ai = 0; ai < 2; ++ai)
#pragma unroll
                for (int m = 0; m < 4; ++m) rs[ai][m] += __shfl_xor(rs[ai][m], 32);
#pragma unroll
            for (int ai = 0; ai < 2; ++ai)
#pragma unroll
                for (int m = 0; m < 4; ++m) { const int row = row0 + ai * HALF + m * 16;
                    const float r = __builtin_amdgcn_rsqf(rs[ai][m] * (1.0f / 64.0f) + EPS);
#pragma unroll
                    for (int bj = 0; bj < 2; ++bj) { const f32x4 a = acc[ai][bj][m][0] * r * gv[bj][0], b = acc[ai][bj][m][1] * r * gv[bj][1];
                        const size_t off = (size_t)row * DM + lc0 + 32 * bj;
                        if (cat == 0) { *(u32x4*)(Q + off) = pack8(a, b); }
                        else { *(f32x4*)(ok + off) = a; *(f32x4*)(ok + off + 4) = b; *(u32x4*)(Kb + off) = pack8(a, b); } } }
        } else if (cat == 2 || cat == 8) {
            float* ov = cat == 8 ? (float*)(ws + WS_NS2) : smp ? out + O_NVS - (size_t)MP * DM : out + O_NVP;
            bf16_t* const Vb = (bf16_t*)(ws + (cat == 8 ? WS_NS1 : WS_VB));
#pragma unroll
            for (int ai = 0; ai < 2; ++ai)
#pragma unroll
                for (int m = 0; m < 4; ++m) { const int row = row0 + ai * HALF + m * 16;
#pragma unroll
                    for (int bj = 0; bj < 2; ++bj) { const f32x4 a = acc[ai][bj][m][0], b = acc[ai][bj][m][1]; const size_t off = (size_t)row * DM + lc0 + 32 * bj;
                        *(f32x4*)(ov + off) = a; *(f32x4*)(ov + off + 4) = b; *(u32x4*)(Vb + off) = pack8(a, b); } }
        } else if (cat == 3) {
            const int g64 = (pn - 12) * 4 + wc, hh = g64 & 7; const bool isk = g64 >= 8;
            bf16_t* dst = (bf16_t*)(ws + (isk ? WS_KR : WS_QR)); const float sc = isk ? 0.125f : 1.0f;
            f32x4 rv[2];
#pragma unroll
            for (int n = 0; n < 2; ++n)
#pragma unroll
                for (int e = 0; e < 4; ++e) rv[n][e] = __builtin_amdgcn_exp2f(-(float)(8 * fq + 4 * n + e) * (13.287712379549449f / 32.0f));
#pragma unroll
            for (int ai = 0; ai < 2; ++ai)
#pragma unroll
                for (int m = 0; m < 4; ++m) { const int row = row0 + ai * HALF + m * 16;
                    const float pos = (float)(smp ? PAST + ((row - MP) & 31) : (row & 4095));
                    f32x4 o1[2], o2[2];
#pragma unroll
                    for (int n = 0; n < 2; ++n) { f32x4 cs, sn;
#pragma unroll
                        for (int e = 0; e < 4; ++e) { const float ang = pos * rv[n][e]; const float fr = __builtin_amdgcn_fractf(ang * 0.15915494309189535f);
                            cs[e] = __builtin_amdgcn_cosf(fr); sn[e] = __builtin_amdgcn_sinf(fr); }
                        const f32x4 x1 = acc[ai][0][m][n], x2 = acc[ai][1][m][n];
                        o1[n] = (x1 * cs - x2 * sn) * sc; o2[n] = (x1 * sn + x2 * cs) * sc; }
                    const size_t off = (size_t)row * 512 + hh * 64 + 8 * fq;
                    *(u32x4*)(dst + off) = pack8(o1[0], o1[1]); *(u32x4*)(dst + off + 32) = pack8(o2[0], o2[1]); }
        } else {
            bf16_t* dst = (bf16_t*)(ws + (force_cat >= 0 ? WS_NS1 : cat == 4 ? WS_VR : cat == 5 ? WS_GS : cat == 6 ? WS_GA : WS_GR));
#pragma unroll
            for (int ai = 0; ai < 2; ++ai)
#pragma unroll
                for (int m = 0; m < 4; ++m) { const int row = row0 + ai * HALF + m * 16;
#pragma unroll
                    for (int bj = 0; bj < 2; ++bj) { f32x4 a = acc[ai][bj][m][0], b = acc[ai][bj][m][1];
                        if (cat == 5) { a = silu4(a); b = silu4(b); } else if (cat >= 6) { a = sig4(a); b = sig4(b); }
                        *(u32x4*)(dst + (size_t)row * DM + lc0 + 32 * bj) = pack8(a, b); } }
        }
    }
};

struct EpiStoreBf16 {
    static constexpr bool PERM = true, AFTER_DRAIN = false;
    bf16_t* O;
    __device__ __forceinline__ void operator()(const f32x4 (&acc)[2][2][4][2], const Unit& u, int, int, int, int) const {
        PG8_LANEPOS;
        const int row0 = u.pm * BM + wr * 64 + fr, col0 = u.pn * BM + wc * 64 + 8 * fq;
#pragma unroll
        for (int ai = 0; ai < 2; ++ai)
#pragma unroll
            for (int m = 0; m < 4; ++m)
#pragma unroll
                for (int bj = 0; bj < 2; ++bj) *(u32x4*)(O + (size_t)(row0 + ai * HALF + m * 16) * DM + col0 + 32 * bj) = pack8(acc[ai][bj][m][0], acc[ai][bj][m][1]);
    }
};

struct EpiResid {
    static constexpr bool PERM = true, AFTER_DRAIN = false;
    const float* base0; const float* base1;
    float* Xo; bf16_t* Xg; const float* g; float* SS;
    __device__ __forceinline__ void operator()(const f32x4 (&acc)[2][2][4][2], const Unit& u, int, int, int, int) const {
        PG8_LANEPOS;
        const int row0 = u.pm * BM + wr * 64 + fr, col0 = u.pn * BM + wc * 64 + 8 * fq;
        const float* base = u.pm >= (MP / BM) ? base1 - (size_t)MP * DM : base0;
        f32x4 gv[2][2];
#pragma unroll
        for (int bj = 0; bj < 2; ++bj)
#pragma unroll
            for (int n = 0; n < 2; ++n) gv[bj][n] = *(const f32x4*)(g + col0 + 32 * bj + 4 * n);
#pragma unroll
        for (int ai = 0; ai < 2; ++ai) {
            f32x4 r[4][2][2];
#pragma unroll
            for (int m = 0; m < 4; ++m)
#pragma unroll
                for (int bj = 0; bj < 2; ++bj) { const size_t off = (size_t)(row0 + ai * HALF + m * 16) * DM + col0 + 32 * bj;
                    r[m][bj][0] = *(const f32x4*)(base + off); r[m][bj][1] = *(const f32x4*)(base + off + 4); }
            asm volatile("" ::: "memory");
#pragma unroll
            for (int m = 0; m < 4; ++m) { const int row = row0 + ai * HALF + m * 16; float ss = 0.f;
#pragma unroll
                for (int bj = 0; bj < 2; ++bj) { const size_t off = (size_t)row * DM + col0 + 32 * bj;
                    const f32x4 a = r[m][bj][0] + acc[ai][bj][m][0], b = r[m][bj][1] + acc[ai][bj][m][1];
                    ss += (a[0] * a[0] + a[1] * a[1]) + (a[2] * a[2] + a[3] * a[3]) + (b[0] * b[0] + b[1] * b[1]) + (b[2] * b[2] + b[3] * b[3]);
                    *(f32x4*)(Xo + off) = a; *(f32x4*)(Xo + off + 4) = b; *(u32x4*)(Xg + off) = pack8(a * gv[bj][0], b * gv[bj][1]); }
                ss += __shfl_xor(ss, 16); ss += __shfl_xor(ss, 32);
                if (fq == 0) atomicAdd(SS + row, ss); }
            asm volatile("" ::: "memory");
        }
    }
};

struct EpiGateUp {
    static constexpr bool PERM = true, AFTER_DRAIN = false;
    const float* SS; bf16_t* HID;
    __device__ __forceinline__ void operator()(const f32x4 (&acc)[2][2][4][2], const Unit& u, int, int, int, int) const {
        PG8_LANEPOS;
        const int row0 = u.pm * BM + wr * 64 + fr, col0 = u.pn * 128 + wc * 32 + 8 * fq;
        float sv[2][4];
#pragma unroll
        for (int ai = 0; ai < 2; ++ai)
#pragma unroll
            for (int m = 0; m < 4; ++m) sv[ai][m] = SS[row0 + ai * HALF + m * 16];
        asm volatile("" ::: "memory");
#pragma unroll
        for (int ai = 0; ai < 2; ++ai)
#pragma unroll
            for (int m = 0; m < 4; ++m) { const int row = row0 + ai * HALF + m * 16;
                const float r = __builtin_amdgcn_rsqf(sv[ai][m] * (1.0f / DM) + EPS);
                const f32x4 g0 = acc[ai][0][m][0] * r, g1 = acc[ai][0][m][1] * r, u0 = acc[ai][1][m][0] * r, u1 = acc[ai][1][m][1] * r;
                *(u32x4*)(HID + (size_t)row * DFF + col0) = pack8(silu4(g0) * u0, silu4(g1) * u1); }
    }
};

struct EpiFinal {
    static constexpr bool PERM = true, AFTER_DRAIN = false;
    const float* SS; const bf16_t* T; const float* y; float* yo;
    __device__ __forceinline__ void operator()(const f32x4 (&acc)[2][2][4][2], const Unit& u, int, int, int, int) const {
        PG8_LANEPOS;
        const int row0 = u.pm * BM + wr * 64 + fr, col0 = u.pn * BM + wc * 64 + 8 * fq;
#pragma unroll
        for (int ai = 0; ai < 2; ++ai)
#pragma unroll
            for (int mp = 0; mp < 2; ++mp) {
                f32x4 yv[2][2][2]; u32x4 tv[2][2]; float sv[2];
#pragma unroll
                for (int mm = 0; mm < 2; ++mm) { const int row = row0 + ai * HALF + (2 * mp + mm) * 16; sv[mm] = SS[row];
#pragma unroll
                    for (int bj = 0; bj < 2; ++bj) { const size_t off = (size_t)row * DM + col0 + 32 * bj;
                        yv[mm][bj][0] = *(const f32x4*)(y + off); yv[mm][bj][1] = *(const f32x4*)(y + off + 4); tv[mm][bj] = *(const u32x4*)(T + off); } }
                asm volatile("" ::: "memory");
#pragma unroll
                for (int mm = 0; mm < 2; ++mm) { const int m = 2 * mp + mm, row = row0 + ai * HALF + m * 16;
                    const float r = __builtin_amdgcn_rsqf(sv[mm] * (1.0f / DM) + EPS);
#pragma unroll
                    for (int bj = 0; bj < 2; ++bj) { const size_t off = (size_t)row * DM + col0 + 32 * bj;
                        const f32x4 a = yv[mm][bj][0] + sig4(acc[ai][bj][m][0] * r) * bf4_lo(tv[mm][bj], 0), b = yv[mm][bj][1] + sig4(acc[ai][bj][m][1] * r) * bf4_lo(tv[mm][bj], 1);
                        *(f32x4*)(yo + off) = a; *(f32x4*)(yo + off + 4) = b; } }
                asm volatile("" ::: "memory");
            }
    }
};

}
struct Args { const float* in[23]; float* out; unsigned char* ws; int ph_lo, ph_hi, li, fc; };

__device__ __forceinline__ void transpose_item(const float* src, int ldw, bf16_t* dst, int ldk, LAS float* scr, int lane) {
    float tv[32];
#pragma unroll
    for (int i = 0; i < 32; ++i) tv[i] = src[(size_t)(2 * i + (lane >> 5)) * ldw + (lane & 31)];
#pragma unroll
    for (int i = 0; i < 32; ++i) scr[(2 * i + (lane >> 5)) * 33 + (lane & 31)] = tv[i];
    LDS_WAIT(); asm volatile("" ::: "memory");
    const int c = lane & 7;
#pragma unroll
    for (int j = 0; j < 4; ++j) { const int n = (lane >> 3) + 8 * j; const LAS float* s = scr + (8 * c) * 33 + n;
        v4u o; o.x = pk2(s[0 * 33], s[1 * 33]); o.y = pk2(s[2 * 33], s[3 * 33]); o.z = pk2(s[4 * 33], s[5 * 33]); o.w = pk2(s[6 * 33], s[7 * 33]);
        *(v4u*)(dst + (size_t)n * ldk + 8 * c) = o; }
    LDS_WAIT(); asm volatile("" ::: "memory");
}

__device__ __forceinline__ int perm_col0(int g32) { const int pn = g32 >> 3, bj = (g32 >> 2) & 1, wc = g32 & 3; return 256 * pn + 64 * wc + 32 * bj; }

constexpr int LW_I_O = (DM / 32) * (2048 / 64), LW_I_GU = (2 * DFF / 32) * (DM / 64), LW_I_DN = (DM / 32) * (DFF / 64), LW_I_PG = (DM / 32) * (DM / 64);
constexpr int LW_ITEMS = LW_I_O + LW_I_GU + LW_I_DN + LW_I_PG;
__device__ __forceinline__ void late_weight_item(const Args& a, int it, LAS float* scr, int lane) {
    unsigned char* ws = a.ws;
    const float *w_o = a.in[15], *w_g = a.in[17], *w_u = a.in[18], *w_d = a.in[19], *w_pg = a.in[22];
    bf16_t *WO = (bf16_t*)(ws + WS_WO), *WGU = (bf16_t*)(ws + WS_WGU), *WDN = (bf16_t*)(ws + WS_WDN), *WPG = (bf16_t*)(ws + WS_WPG);
    int r = it;
    if (r < LW_I_O) { const int g32 = r / 32, kb = r % 32; transpose_item(w_o + (size_t)((kb * 64) % DM) * DM + perm_col0(g32), DM, WO + (size_t)g32 * 32 * 2048 + kb * 64, 2048, scr, lane); return; } r -= LW_I_O;
    if (r < LW_I_GU) { const int g32 = r / (DM / 64), kb = r % (DM / 64); const int pn = g32 >> 3, bj = (g32 >> 2) & 1, wc = g32 & 3;
        transpose_item((bj ? w_u : w_g) + (size_t)kb * 64 * DFF + 128 * pn + 32 * wc, DFF, WGU + (size_t)g32 * 32 * DM + kb * 64, DM, scr, lane); return; } r -= LW_I_GU;
    if (r < LW_I_DN) { const int g32 = r / (DFF / 64), kb = r % (DFF / 64); transpose_item(w_d + (size_t)kb * 64 * DM + perm_col0(g32), DM, WDN + (size_t)g32 * 32 * DFF + kb * 64, DFF, scr, lane); return; } r -= LW_I_DN;
    { const int g32 = r / (DM / 64), kb = r % (DM / 64); transpose_item(w_pg + (size_t)kb * 64 * DM + perm_col0(g32), DM, WPG + (size_t)g32 * 32 * DM + kb * 64, DM, scr, lane); }
}

__device__ __forceinline__ void p0_prologue(const Args& a, LAS unsigned char* lds, int gw, int NGW, int lane) {
    unsigned char* ws = a.ws;
    LAS float* scr = (LAS float*)(lds + (threadIdx.x >> 6) * 16384);
    const float *w_in = a.in[7], *w_ple = a.in[21];
    bf16_t *WIN = (bf16_t*)(ws + WS_WIN), *WPL = (bf16_t*)(ws + WS_WPL);
    constexpr int I_IN = (NIN / 32) * (DM / 64), I_PL = (DM / 32) * (PLE / 64);
    constexpr int NITEMS = I_IN + I_PL;
    for (int it = gw; it < NITEMS; it += NGW) {
        int r = it;
        if (r < I_IN) { const int g32 = r / (DM / 64), kb = r % (DM / 64); transpose_item(w_in + (size_t)kb * 64 * NIN + perm_col0(g32), NIN, WIN + (size_t)g32 * 32 * DM + kb * 64, DM, scr, lane); continue; } r -= I_IN;
        { const int g32 = r / (PLE / 64), kb = r % (PLE / 64); transpose_item(w_ple + (size_t)kb * 64 * DM + perm_col0(g32), DM, WPL + (size_t)g32 * 32 * PLE + kb * 64, PLE, scr, lane); }
    }
    const float *xp = a.in[0], *xs = a.in[1], *g = a.in[8]; bf16_t* H = (bf16_t*)(ws + WS_H);
    for (int row0 = gw; row0 < M; row0 += 2 * NGW) {
        const int row1 = row0 + NGW; const bool has1 = row1 < M;
        const f32x4* x0 = (const f32x4*)(row0 < MP ? xp + (size_t)row0 * DM : xs + (size_t)(row0 - MP) * DM);
        const f32x4* x1 = (const f32x4*)(!has1 ? (const float*)x0 : row1 < MP ? xp + (size_t)row1 * DM : xs + (size_t)(row1 - MP) * DM);
        f32x4 v[4], u[4]; float s = 0.f, t = 0.f;
#pragma unroll
        for (int j = 0; j < 4; ++j) { v[j] = x0[lane + 64 * j]; u[j] = x1[lane + 64 * j]; }
#pragma unroll
        for (int j = 0; j < 4; ++j) { s += (v[j][0] * v[j][0] + v[j][1] * v[j][1]) + (v[j][2] * v[j][2] + v[j][3] * v[j][3]); t += (u[j][0] * u[j][0] + u[j][1] * u[j][1]) + (u[j][2] * u[j][2] + u[j][3] * u[j][3]); }
#pragma unroll
        for (int o = 1; o < 64; o <<= 1) { s += __shfl_xor(s, o); t += __shfl_xor(t, o); }
        const float r = rsqrtf(s * (1.0f / DM) + EPS), q = rsqrtf(t * (1.0f / DM) + EPS);
#pragma unroll
        for (int j = 0; j < 4; ++j) { const f32x4 gg = ((const f32x4*)g)[lane + 64 * j];
            v2u o; o.x = pk2(v[j][0] * r * gg[0], v[j][1] * r * gg[1]); o.y = pk2(v[j][2] * r * gg[2], v[j][3] * r * gg[3]);
            ((v2u*)(H + (size_t)row0 * DM))[lane + 64 * j] = o;
            if (has1) { v2u w; w.x = pk2(u[j][0] * q * gg[0], u[j][1] * q * gg[1]); w.y = pk2(u[j][2] * q * gg[2], u[j][3] * q * gg[3]);
                ((v2u*)(H + (size_t)row1 * DM))[lane + 64 * j] = w; } }
    }
    { const float *pp = a.in[5], *ps = a.in[6]; bf16_t* PB = (bf16_t*)(ws + WS_PB);
      const size_t n4 = (size_t)M * PLE / 4, np4 = (size_t)MP * PLE / 4;
      const size_t st = (size_t)NGW * 64;
      for (size_t i0 = (size_t)gw * 64 + lane; i0 < n4; i0 += 4 * st) {
          f32x4 v[4];
#pragma unroll
          for (int k = 0; k < 4; ++k) { const size_t i = i0 + k * st; v[k] = i < np4 ? ((const f32x4*)pp)[i] : i < n4 ? ((const f32x4*)ps)[i - np4] : (f32x4){0.f, 0.f, 0.f, 0.f}; }
#pragma unroll
          for (int k = 0; k < 4; ++k) { const size_t i = i0 + k * st; if (i < n4) { v2u o; o.x = pk2(v[k][0], v[k][1]); o.y = pk2(v[k][2], v[k][3]); ((v2u*)PB)[i] = o; } }
      } }
    { float* SS = (float*)(ws + WS_SS);
      for (int i = gw * 64 + lane; i < 65536; i += NGW * 64) SS[i] = 0.f; }
    { const float *lq = a.in[11], *lk = a.in[12], *gq = a.in[9], *gk = a.in[10]; float* sc = (float*)(ws + WS_SC);
      if (gw == 0) {
          float s0 = lq[lane] * lk[lane], s1 = lq[64 + lane] * lk[64 + lane], mq = fabsf(gq[lane]), mk = fabsf(gk[lane]);
#pragma unroll
          for (int o = 1; o < 64; o <<= 1) { s0 += __shfl_xor(s0, o); s1 += __shfl_xor(s1, o); mq = fmaxf(mq, __shfl_xor(mq, o)); mk = fmaxf(mk, __shfl_xor(mk, o)); }
          if (lane == 0) { sc[0] = expf(s0) - expf(s1) + LAM_INIT; sc[1] = 8.0f * LOG2E * mq * mk * 1.01f; }
      }
    }
}
namespace att {
typedef short v4i16_t __attribute__((ext_vector_type(4)));
typedef float f32x2_t __attribute__((ext_vector_type(2)));
typedef __bf16 bf16x2_t __attribute__((ext_vector_type(2)));
__device__ __forceinline__ unsigned cvtpk(float lo, float hi) { f32x2_t v = {lo, hi}; bf16x2_t b = __builtin_convertvector(v, bf16x2_t); return __builtin_bit_cast(unsigned, b); }
__device__ __forceinline__ s16x4 vtr(const LAS unsigned char* p) { return __builtin_bit_cast(s16x4, __builtin_amdgcn_ds_read_tr16_b64_v4i16((LAS v4i16_t*)p)); }
__device__ __forceinline__ void glds16(const void* gsrc, unsigned lds_dst) { unsigned keep;
    asm volatile("s_mov_b32 %0, m0\n\ts_mov_b32 m0, %2\n\ts_nop 0\n\tglobal_load_lds_dwordx4 %1, off\n\ts_mov_b32 m0, %0" : "=&s"(keep) : "v"(gsrc), "s"(lds_dst) : "memory"); }
__device__ __forceinline__ int crow(int r, int hi) { return (r & 3) + 8 * (r >> 2) + 4 * hi; }
__device__ __forceinline__ int koff(int row, int ch) { return 256 * row + 16 * (ch ^ (((row & 3) << 2) | ((row >> 2) & 3))); }
constexpr int L_K = 0, L_V = 32768, L_WS = 132096;
constexpr int L_CONST = 131520;

template <bool SAMPLE, int ABL = 0>
__device__ __forceinline__ void attn_unit(const Args& a, LAS unsigned char* lds, int b, int h, int qb, bf16_t* mixbase = nullptr, gu32* qhead = nullptr) {
    unsigned char* ws = a.ws;
    const bf16_t *Q = (const bf16_t*)(ws + WS_Q), *Kb = (const bf16_t*)(ws + WS_KB), *Vb = (const bf16_t*)(ws + WS_VB), *GA = (const bf16_t*)(ws + WS_GA);
    bf16_t* MIX = mixbase ? mixbase : (bf16_t*)(ws + WS_MIX);
    const float *cK = a.in[2], *cV = a.in[3];
    const LAS float* cst = (const LAS float*)(lds + L_CONST);
    int tid_ = threadIdx.x; asm volatile("" : "+v"(tid_));
    const int tid = tid_, lane = tid & 63, r32 = lane & 31, hi = lane >> 5;
    const int wave = __builtin_amdgcn_readfirstlane(tid >> 6), rb = wave >> 1, map = wave & 1;
    const int row0 = SAMPLE ? MP + b * DT : b * SEQ + qb * 128;
    const int NT = SAMPLE ? (PAST / 64 + 1) : 2 * qb + 2;
    const int tlast = SAMPLE ? NT - 1 : 2 * qb + (rb >> 1);
    const bool wactive = SAMPLE ? (rb == 0) : true;
    const float lam = cst[128], shift = cst[129];

    v4u kreg[2], vreg[2];
    auto stage_load = [&](int t) {
#pragma unroll
        for (int i = 0; i < 2; ++i) {
            const int kid = tid + 512 * i, key = kid >> 4, c = kid & 15;
            const int pz = wave + 8 * i, vkey = 16 * (pz & 3) + (lane >> 2), vd = 32 * (pz >> 2) + 8 * (lane & 3);
            if (!SAMPLE) {
                const size_t kr = (size_t)(b * SEQ + 64 * t + key) * DM + h * 128 + 8 * c;
                const size_t vr = (size_t)(b * SEQ + 64 * t + vkey) * DM + h * 128 + vd;
                kreg[i] = *(const v4u*)(Kb + kr); vreg[i] = *(const v4u*)(Vb + vr);
            } else if (t < PAST / 64) {
                const float* kp = cK + ((size_t)(b * PAST + 64 * t + key) * NH + h) * 128 + 8 * c;
                const float* vp = cV + ((size_t)(b * PAST + 64 * t + vkey) * NH + h) * 128 + vd;
                const f32x4 k0 = __builtin_nontemporal_load((const f32x4*)kp), k1 = __builtin_nontemporal_load((const f32x4*)(kp + 4)), v0 = __builtin_nontemporal_load((const f32x4*)vp), v1 = __builtin_nontemporal_load((const f32x4*)(vp + 4));
                kreg[i] = (v4u){cvtpk(k0[0], k0[1]), cvtpk(k0[2], k0[3]), cvtpk(k1[0], k1[1]), cvtpk(k1[2], k1[3])};
                vreg[i] = (v4u){cvtpk(v0[0], v0[1]), cvtpk(v0[2], v0[3]), cvtpk(v1[0], v1[1]), cvtpk(v1[2], v1[3])};
            } else {
                const size_t kr = (size_t)(MP + b * DT + (key & 31)) * DM + h * 128 + 8 * c;
                const size_t vr = (size_t)(MP + b * DT + (vkey & 31)) * DM + h * 128 + vd;
                kreg[i] = *(const v4u*)(Kb + kr); vreg[i] = *(const v4u*)(Vb + vr);
            }
        }
    };
    auto stage_write = [&](int buf) {
#pragma unroll
        for (int i = 0; i < 2; ++i) {
            { const int kid = tid + 512 * i; *(LAS v4u*)(lds + buf * 32768 + koff(kid >> 4, kid & 15)) = kreg[i]; }
            *(LAS v4u*)(lds + buf * 32768 + 16384 + (wave + 8 * i) * 1024 + lane * 16) = vreg[i];
        }
    };

    bf16x8 qf[4];
    const bf16_t* qp = Q + (size_t)(row0 + (SAMPLE ? 0 : 32 * rb) + r32) * DM + h * 128 + map * 64 + 8 * hi;
    if constexpr (SAMPLE) {
#pragma unroll
        for (int d0 = 0; d0 < 4; ++d0) qf[d0] = *(const bf16x8*)(qp + 16 * d0);
    }
    f32x16 o[4];
#pragma unroll
    for (int d = 0; d < 4; ++d)
#pragma unroll
        for (int r = 0; r < 16; ++r) o[d][r] = 0.f;
    float l_reg = 0.f;
    f32x16 negs;
#pragma unroll
    for (int r = 0; r < 16; ++r) negs[r] = -shift;
    const int vp0 = ((lane >> 4) & 1) * 32 + (lane & 3) * 8 + (4 * hi + ((lane & 15) >> 2)) * 64;

    __syncthreads();
    if constexpr (!SAMPLE) {
        const int lds0 = (int)(size_t)lds;
        auto dma_tile = [&](int t, int slot_off) {
#pragma unroll
            for (int i = 0; i < 2; ++i) {
                const int kid = tid + 512 * i, key = kid >> 4, cl = kid & 15;
                const int csrc = cl ^ (((key & 3) << 2) | ((key >> 2) & 3));
                const int pz = wave + 8 * i, vkey = 16 * (pz & 3) + (lane >> 2), vd = 32 * (pz >> 2) + 8 * (lane & 3);
                const bf16_t* ksrc = Kb + (size_t)(b * SEQ + 64 * t + key) * DM + h * 128 + 8 * csrc;
                const bf16_t* vsrc = Vb + (size_t)(b * SEQ + 64 * t + vkey) * DM + h * 128 + vd;
                glds16(ksrc, (unsigned)__builtin_amdgcn_readfirstlane(lds0 + slot_off + wave * 1024 + i * 8192));
                glds16(vsrc, (unsigned)__builtin_amdgcn_readfirstlane(lds0 + slot_off + 16384 + (wave + 8 * i) * 1024));
            }
        };
        dma_tile(0, 0); dma_tile(1, 32768);
#pragma unroll
        for (int d0 = 0; d0 < 4; ++d0) qf[d0] = *(const bf16x8*)(qp + 16 * d0);
        asm volatile("" : "+v"(qf[0]), "+v"(qf[1]), "+v"(qf[2]), "+v"(qf[3]));
        int s_cur = 0, s_n1 = 32768, s_n2 = 65536;
        for (int t = 0; t < NT; ++t) {
            if (!(ABL & 16)) {
            if (t + 1 < NT) asm volatile("s_waitcnt vmcnt(4) lgkmcnt(0)\n\ts_barrier" ::: "memory");
            else asm volatile("s_waitcnt vmcnt(0) lgkmcnt(0)\n\ts_barrier" ::: "memory");
            }
            if (!(ABL & 32)) { if (t + 2 < NT) dma_tile(t + 2, s_n2); }
            if (t <= tlast) {
                const LAS unsigned char* Kt = lds + s_cur;
                const LAS unsigned char* Vt = lds + s_cur + 16384 + vp0;
#define MFMA32(A_, B_, C_) __builtin_amdgcn_mfma_f32_32x32x16_bf16(A_, B_, C_, 0, 0, 0)
#define VLD(dst, ks) do { _Pragma("unroll") for (int db = 0; db < 4; ++db) { if (!(ABL & 8)) { const s16x4 lo_ = vtr(Vt + db * 4096 + (ks) * 1024), hh_ = vtr(Vt + db * 4096 + (ks) * 1024 + 512); \
                          dst[db] = (bf16x8){lo_[0], lo_[1], lo_[2], lo_[3], hh_[0], hh_[1], hh_[2], hh_[3]}; } else dst[db] = qf[db]; } } while (0)
#define SGB(mask, n) __builtin_amdgcn_sched_group_barrier(mask, n, 0)
#define PVM(P_, V_, O_) do { if (!(ABL & 2)) O_ = MFMA32(__builtin_bit_cast(bf16x8, P_), V_, O_); else asm volatile("" :: "v"(P_), "v"(V_)); } while (0)
                bf16x8 ka[4], kb[4], va[4], vb[4];
#pragma unroll
                for (int d0 = 0; d0 < 4; ++d0) { const int c = map * 8 + 2 * d0 + hi; ka[d0] = *(const LAS bf16x8*)(Kt + koff(r32, c)); kb[d0] = *(const LAS bf16x8*)(Kt + koff(32 + r32, c)); }
                VLD(va, 0);
                f32x16 p0 = negs, p1 = negs;
                __builtin_amdgcn_s_setprio(1);
#pragma unroll
                for (int d0 = 0; d0 < 4; ++d0) { if (!(ABL & 4)) { p0 = MFMA32(ka[d0], qf[d0], p0); p1 = MFMA32(kb[d0], qf[d0], p1); } else { asm volatile("" :: "v"(ka[d0]), "v"(kb[d0])); } }
                __builtin_amdgcn_sched_barrier(0);
                float s0 = 0.f, s1 = 0.f;
#pragma unroll
                for (int r = 0; r < 16; ++r) { if (!(ABL & 1)) p0[r] = __builtin_amdgcn_exp2f(p0[r]); s0 += p0[r]; }
                v4u pw0 = (v4u){cvtpk(p0[0], p0[1]), cvtpk(p0[2], p0[3]), cvtpk(p0[4], p0[5]), cvtpk(p0[6], p0[7])};
                v4u pw1 = (v4u){cvtpk(p0[8], p0[9]), cvtpk(p0[10], p0[11]), cvtpk(p0[12], p0[13]), cvtpk(p0[14], p0[15])};
                VLD(vb, 1);
                __builtin_amdgcn_sched_barrier(0);
#pragma unroll
                for (int db = 0; db < 4; ++db) PVM(pw0, va[db], o[db]);
#pragma unroll
                for (int r = 0; r < 16; ++r) { if (!(ABL & 1)) p1[r] = __builtin_amdgcn_exp2f(p1[r]); s1 += p1[r]; }
                v4u pw2 = (v4u){cvtpk(p1[0], p1[1]), cvtpk(p1[2], p1[3]), cvtpk(p1[4], p1[5]), cvtpk(p1[6], p1[7])};
                v4u pw3 = (v4u){cvtpk(p1[8], p1[9]), cvtpk(p1[10], p1[11]), cvtpk(p1[12], p1[13]), cvtpk(p1[14], p1[15])};
                VLD(va, 2);
#pragma unroll
                for (int db = 0; db < 4; ++db) PVM(pw1, vb[db], o[db]);
#pragma unroll
                for (int i = 0; i < 8; ++i) { SGB(0x8, 1); SGB(0x2, 5); SGB(0x100, 1); }
                __builtin_amdgcn_sched_barrier(0);
                VLD(vb, 3);
#pragma unroll
                for (int db = 0; db < 4; ++db) PVM(pw2, va[db], o[db]);
#pragma unroll
                for (int db = 0; db < 4; ++db) PVM(pw3, vb[db], o[db]);
                __builtin_amdgcn_s_setprio(0);
                l_reg += s0 + s1;
#undef MFMA32
#undef VLD
#undef SGB
#undef PVM
            }
            { const int tmp = s_cur; s_cur = s_n1; s_n1 = s_n2; s_n2 = tmp; }
        }
        asm volatile("s_waitcnt lgkmcnt(0)\n\ts_barrier" ::: "memory");
    } else {
        stage_load(0); stage_write(0);
        __syncthreads();
        for (int t = 0; t < NT; ++t) {
            if (t + 1 < NT) stage_load(t + 1);
            if (wactive && t <= tlast) {
                const LAS unsigned char* Kt = lds + (t & 1) * 32768;
                const LAS unsigned char* Vt = lds + (t & 1) * 32768 + 16384 + vp0;
                const bool halftile = (t == NT - 1);
                f32x16 p0 = negs, p1 = negs;
#pragma unroll
                for (int d0 = 0; d0 < 4; ++d0) {
                    const int c = map * 8 + 2 * d0 + hi;
                    p0 = __builtin_amdgcn_mfma_f32_32x32x16_bf16(*(const LAS bf16x8*)(Kt + koff(r32, c)), qf[d0], p0, 0, 0, 0);
                    if (!halftile) p1 = __builtin_amdgcn_mfma_f32_32x32x16_bf16(*(const LAS bf16x8*)(Kt + koff(32 + r32, c)), qf[d0], p1, 0, 0, 0);
                }
                float s = 0.f;
#pragma unroll
                for (int r = 0; r < 16; ++r) { p0[r] = __builtin_amdgcn_exp2f(p0[r]); s += p0[r]; }
                if (!halftile) {
#pragma unroll
                    for (int r = 0; r < 16; ++r) { p1[r] = __builtin_amdgcn_exp2f(p1[r]); s += p1[r]; }
                }
                l_reg += s;
                v4u pw[4];
                pw[0] = (v4u){cvtpk(p0[0], p0[1]), cvtpk(p0[2], p0[3]), cvtpk(p0[4], p0[5]), cvtpk(p0[6], p0[7])};
                pw[1] = (v4u){cvtpk(p0[8], p0[9]), cvtpk(p0[10], p0[11]), cvtpk(p0[12], p0[13]), cvtpk(p0[14], p0[15])};
                pw[2] = (v4u){cvtpk(p1[0], p1[1]), cvtpk(p1[2], p1[3]), cvtpk(p1[4], p1[5]), cvtpk(p1[6], p1[7])};
                pw[3] = (v4u){cvtpk(p1[8], p1[9]), cvtpk(p1[10], p1[11]), cvtpk(p1[12], p1[13]), cvtpk(p1[14], p1[15])};
#pragma unroll
                for (int db = 0; db < 4; ++db)
#pragma unroll
                    for (int ks = 0; ks < 4; ++ks) {
                        if (ks < 2 || !halftile) {
                            const s16x4 lo = vtr(Vt + db * 4096 + ks * 1024), hh = vtr(Vt + db * 4096 + ks * 1024 + 512);
                            const bf16x8 vf = (bf16x8){lo[0], lo[1], lo[2], lo[3], hh[0], hh[1], hh[2], hh[3]};
                            o[db] = __builtin_amdgcn_mfma_f32_32x32x16_bf16(__builtin_bit_cast(bf16x8, pw[ks]), vf, o[db], 0, 0, 0);
                        }
                    }
            }
            if (t + 1 < NT) stage_write((t + 1) & 1);
            __syncthreads();
        }
    }
    unsigned nxt_unit = 0u;
    if (qhead && tid == 0) nxt_unit = __hip_atomic_fetch_add(qhead, 1u, __ATOMIC_RELAXED, __HIP_MEMORY_SCOPE_AGENT);
    LAS float* wsf = (LAS float*)(lds + L_WS) + wave * 64;
    l_reg += __shfl_xor(l_reg, 32);
    if (hi == 0) wsf[r32] = (map == 0 ? 1.0f : -lam) / l_reg;
    LDS_WAIT();
    LAS float* Tw = (LAS float*)(lds + rb * 16896) + hi * 528 + r32;
    const int rowo = row0 + (SAMPLE ? 0 : 32 * rb) + r32;
    v4u gaw[8];
#pragma unroll
    for (int i = 0; i < 8; ++i) gaw[i] = (v4u){0u, 0u, 0u, 0u};
    if (wactive && map == 0) { const bf16_t* gap = GA + (size_t)rowo * DM + h * 128 + 64 * hi;
#pragma unroll
        for (int i = 0; i < 8; ++i) gaw[i] = *(const v4u*)(gap + 8 * i); }
    if (wactive) {
#pragma unroll
        for (int r = 0; r < 16; ++r) { const float inv = wsf[crow(r, hi)];
#pragma unroll
            for (int db = 0; db < 4; ++db) o[db][r] *= inv; }
    }
    if (wactive && map == 1) {
#pragma unroll
        for (int db = 0; db < 4; ++db)
#pragma unroll
            for (int r = 0; r < 16; ++r) Tw[crow(r, 0) * 132 + 32 * db] = o[db][r];
    }
    __syncthreads();
    if (wactive && map == 0) {
#pragma unroll
        for (int db = 0; db < 4; ++db) {
#pragma unroll
            for (int r = 0; r < 16; ++r) o[db][r] += Tw[crow(r, 0) * 132 + 32 * db];
#pragma unroll
            for (int r = 0; r < 16; ++r) Tw[crow(r, 0) * 132 + 32 * db] = o[db][r];
            asm volatile("" ::: "memory");
        }
        f32x4 gsv[16];
        { const LAS float* gs = cst + 64 * hi;
#pragma unroll
          for (int i = 0; i < 16; ++i) gsv[i] = *(const LAS f32x4*)(gs + 4 * i); }
        LDS_WAIT();
        const LAS float* Tr = (const LAS float*)(lds + rb * 16896) + r32 * 132 + 64 * hi;
        float ss = 0.f;
#pragma unroll
        for (int i = 0; i < 16; ++i) { const f32x4 v = *(const LAS f32x4*)(Tr + 4 * i); ss += (v[0] * v[0] + v[1] * v[1]) + (v[2] * v[2] + v[3] * v[3]); }
        ss += __shfl_xor(ss, 32);
        const float rn = __builtin_amdgcn_rsqf(ss * (1.0f / 128.0f) + EPS) * (1.0f - LAM_INIT);
        bf16_t* mp = MIX + (size_t)rowo * 2048 + h * 128 + 64 * hi;
#pragma unroll
        for (int i = 0; i < 8; ++i) {
            const f32x4 v0 = *(const LAS f32x4*)(Tr + 8 * i), v1 = *(const LAS f32x4*)(Tr + 8 * i + 4);
            const v4u gw = gaw[i];
            const f32x4 a0 = (f32x4){__uint_as_float(gw.x << 16), __uint_as_float(gw.x & 0xffff0000u), __uint_as_float(gw.y << 16), __uint_as_float(gw.y & 0xffff0000u)};
            const f32x4 a1 = (f32x4){__uint_as_float(gw.z << 16), __uint_as_float(gw.z & 0xffff0000u), __uint_as_float(gw.w << 16), __uint_as_float(gw.w & 0xffff0000u)};
            const f32x4 r0 = v0 * rn * gsv[2 * i] * a0, r1 = v1 * rn * gsv[2 * i + 1] * a1;
            *(v4u*)(mp + 8 * i) = (v4u){cvtpk(r0[0], r0[1]), cvtpk(r0[2], r0[3]), cvtpk(r1[0], r1[1]), cvtpk(r1[2], r1[3])};
        }
    }
    if (qhead && tid == 0) ((volatile LAS unsigned*)(lds + MISC_OFF))[12] = nxt_unit;
}
}
namespace ret {
using att::cvtpk; using att::vtr;
__device__ __forceinline__ int ioff(int row, int ch) { return 256 * row + 16 * (ch ^ (((row & 3) << 2) | ((row >> 2) & 3))); }
__device__ __forceinline__ v4u scale8(const v4u w, float s) {
    v4u o;
    o.x = cvtpk(__uint_as_float(w.x << 16) * s, __uint_as_float(w.x & 0xffff0000u) * s); o.y = cvtpk(__uint_as_float(w.y << 16) * s, __uint_as_float(w.y & 0xffff0000u) * s);
    o.z = cvtpk(__uint_as_float(w.z << 16) * s, __uint_as_float(w.z & 0xffff0000u) * s); o.w = cvtpk(__uint_as_float(w.w << 16) * s, __uint_as_float(w.w & 0xffff0000u) * s);
    return o;
}
__device__ __forceinline__ bf16x8 mk8(const s16x4 a, const s16x4 b) { return (bf16x8){a[0], a[1], a[2], a[3], b[0], b[1], b[2], b[3]}; }
__device__ __forceinline__ bf16x8 mk8u(const v2u a, const v2u b) { const v4u w = (v4u){a.x, a.y, b.x, b.y}; return __builtin_bit_cast(bf16x8, w); }

template <bool SAMPLE>
__device__ __forceinline__ void ret_unit(const Args& a, LAS unsigned char* lds, int b, int h) {
    unsigned char* ws = a.ws;
    const bf16_t *QR = (const bf16_t*)(ws + WS_QR), *KR = (const bf16_t*)(ws + WS_KR), *VR = (const bf16_t*)(ws + WS_VR), *GS = (const bf16_t*)(ws + WS_GS), *GR = (const bf16_t*)(ws + WS_GR);
    bf16_t* MIX = (bf16_t*)(ws + WS_MIX);
    const float* grn = a.in[14];
    constexpr int T = SAMPLE ? DT : 64, NCH = SAMPLE ? 1 : 64;
    constexpr int IMG = 32768, P_IN = 65536, P_O = 81920;
    int tid_ = threadIdx.x; asm volatile("" : "+v"(tid_));
    const int tid = tid_, lane = tid & 63, l15 = lane & 15, fq = lane >> 4;
    const int w = __builtin_amdgcn_readfirstlane(tid >> 6);
    const float lg2 = log1pf(-exp2f(-5.0f - (float)h)) * LOG2E;
    const float cd = __builtin_amdgcn_exp2f(lg2 * (float)T);
    const float ginvT = __builtin_amdgcn_exp2f(-lg2 * (float)T);

    f32x4 S[4];
    { const float* sp = a.in[4] + ((size_t)(b * NH + h) * 64) * 128 + 16 * w + l15;
#pragma unroll
      for (int blk = 0; blk < 4; ++blk)
#pragma unroll
          for (int r = 0; r < 4; ++r) S[blk][r] = SAMPLE ? sp[(size_t)(16 * blk + 4 * fq + r) * 128] : 0.f; }

    const int stok = tid >> 3, sc8 = tid & 7;
    v4u qreg, kreg, vreg[2], gsr[2], grr[2];
    auto stage_load = [&](int c) {
        const int row = (SAMPLE ? MP + b * DT : b * SEQ + c * 64) + (SAMPLE ? (stok & 31) : stok);
        qreg = *(const v4u*)(QR + (size_t)row * 512 + h * 64 + 8 * sc8);
        kreg = *(const v4u*)(KR + (size_t)row * 512 + h * 64 + 8 * sc8);
        vreg[0] = *(const v4u*)(VR + (size_t)row * DM + h * 128 + 16 * sc8);
        vreg[1] = *(const v4u*)(VR + (size_t)row * DM + h * 128 + 16 * sc8 + 8);
    };
    auto gate_load = [&](int c) {
        const int row = (SAMPLE ? MP + b * DT : b * SEQ + c * 64) + (SAMPLE ? (stok & 31) : stok);
        gsr[0] = *(const v4u*)(GS + (size_t)row * DM + h * 128 + 16 * sc8); gsr[1] = *(const v4u*)(GS + (size_t)row * DM + h * 128 + 16 * sc8 + 8);
        grr[0] = *(const v4u*)(GR + (size_t)row * DM + h * 128 + 16 * sc8); grr[1] = *(const v4u*)(GR + (size_t)row * DM + h * 128 + 16 * sc8 + 8);
    };
    const float qd = __builtin_amdgcn_exp2f(lg2 * (float)(stok + 1)), kd = __builtin_amdgcn_exp2f(lg2 * (float)(T - 1 - stok));
    auto stage_write = [&](int buf) {
        const bool valid = stok < T;
        const v4u z = (v4u){0u, 0u, 0u, 0u};
        LAS unsigned char* im = lds + buf * IMG;
        *(LAS v4u*)(im + ioff(stok, sc8)) = valid ? scale8(qreg, qd) : z;
        *(LAS v4u*)(im + ioff(stok, 8 + sc8)) = valid ? scale8(kreg, kd) : z;
        *(LAS v4u*)(im + 16384 + ioff(stok, 2 * sc8)) = valid ? vreg[0] : z;
        *(LAS v4u*)(im + 16384 + ioff(stok, 2 * sc8 + 1)) = valid ? vreg[1] : z;
    };
    const int tq = (lane & 15) >> 2, tp = lane & 3;
    int vrel[2][2], krow[2][2];
#pragma unroll
    for (int s = 0; s < 2; ++s)
#pragma unroll
        for (int hf = 0; hf < 2; ++hf) { const int row = 32 * s + 8 * fq + tq + 4 * hf;
            vrel[s][hf] = 16384 + ioff(row, 2 * w + (tp >> 1)) + 8 * (tp & 1);
            krow[s][hf] = row; }
    f32x4 n0, n1, n2, n3;
    { const float* gp = grn + h * 128 + 16 * sc8; n0 = *(const f32x4*)gp; n1 = *(const f32x4*)(gp + 4); n2 = *(const f32x4*)(gp + 8); n3 = *(const f32x4*)(gp + 12); }
    stage_load(0);
    __syncthreads();
    stage_write(0);
    if (NCH > 1) stage_load(1);
    gate_load(0);
    LBAR();
    for (int c = 0; c < NCH; ++c) {
        const int row0 = SAMPLE ? MP + b * DT : b * SEQ + c * 64;
        const LAS unsigned char* im = lds + (c & 1) * IMG;
#pragma unroll
        for (int bi = 0; bi < 2; ++bi) {
            const int blk = 2 * w + bi, ib = blk >> 2, jb = blk & 3;
            f32x4 d = (f32x4){0.f, 0.f, 0.f, 0.f};
            if (jb <= ib) {
#pragma unroll
                for (int s = 0; s < 2; ++s) {
                    const bf16x8 kf = *(const LAS bf16x8*)(im + ioff(16 * jb + l15, 8 + 4 * s + fq));
                    const bf16x8 qf = *(const LAS bf16x8*)(im + ioff(16 * ib + l15, 4 * s + fq));
                    d = __builtin_amdgcn_mfma_f32_16x16x32_bf16(kf, qf, d, 0, 0, 0);
                }
                const int ti = 16 * ib + l15, tj0 = 16 * jb + 4 * fq;
#pragma unroll
                for (int r = 0; r < 4; ++r) d[r] = (ti - (tj0 + r) >= 0) ? d[r] * ginvT : 0.f;
            }
            *(LAS v2u*)(lds + P_IN + ioff(16 * ib + l15, 2 * jb + (fq >> 1)) + 8 * (fq & 1)) = (v2u){cvtpk(d[0], d[1]), cvtpk(d[2], d[3])};
        }
        bf16x8 vf[2];
#pragma unroll
        for (int s = 0; s < 2; ++s) vf[s] = mk8(vtr(im + vrel[s][0]), vtr(im + vrel[s][1]));
        f32x4 o[4];
        { bf16x8 sf[2];
#pragma unroll
          for (int s = 0; s < 2; ++s) { const v4u wv = (v4u){cvtpk(S[2 * s][0], S[2 * s][1]), cvtpk(S[2 * s][2], S[2 * s][3]), cvtpk(S[2 * s + 1][0], S[2 * s + 1][1]), cvtpk(S[2 * s + 1][2], S[2 * s + 1][3])};
              sf[s] = __builtin_bit_cast(bf16x8, wv); }
#pragma unroll
          for (int tb = 0; tb < 4; ++tb) { o[tb] = (f32x4){0.f, 0.f, 0.f, 0.f};
#pragma unroll
              for (int s = 0; s < 2; ++s) {
                  const int row = 16 * tb + l15;
                  const v2u q0 = *(const LAS v2u*)(im + ioff(row, 4 * s + (fq >> 1)) + 8 * (fq & 1));
                  const v2u q1 = *(const LAS v2u*)(im + ioff(row, 4 * s + 2 + (fq >> 1)) + 8 * (fq & 1));
                  o[tb] = __builtin_amdgcn_mfma_f32_16x16x32_bf16(mk8u(q0, q1), sf[s], o[tb], 0, 0, 0);
              } } }
#pragma unroll
        for (int blk = 0; blk < 4; ++blk) { S[blk] = S[blk] * cd;
#pragma unroll
            for (int s = 0; s < 2; ++s) {
                const bf16x8 kdf = mk8(vtr(im + ioff(krow[s][0], 8 + 2 * blk + (tp >> 1)) + 8 * (tp & 1)), vtr(im + ioff(krow[s][1], 8 + 2 * blk + (tp >> 1)) + 8 * (tp & 1)));
                S[blk] = __builtin_amdgcn_mfma_f32_16x16x32_bf16(kdf, vf[s], S[blk], 0, 0, 0);
            } }
        if (c + 1 < NCH) { stage_write((c + 1) & 1); if (c + 2 < NCH) stage_load(c + 2); }
        LBAR();
#pragma unroll
        for (int tb = 0; tb < 4; ++tb)
#pragma unroll
            for (int s = 0; s < 2; ++s) {
                const bf16x8 inf = *(const LAS bf16x8*)(lds + P_IN + ioff(16 * tb + l15, 4 * s + fq));
                o[tb] = __builtin_amdgcn_mfma_f32_16x16x32_bf16(inf, vf[s], o[tb], 0, 0, 0);
            }
        { LAS float* Os = (LAS float*)(lds + P_O) + (4 * fq) * 132 + 16 * w + l15;
#pragma unroll
          for (int tb = 0; tb < 4; ++tb)
#pragma unroll
              for (int r = 0; r < 4; ++r) Os[(16 * tb + r) * 132] = o[tb][r]; }
        LBAR();
        { const int tok = tid >> 3, seg = tid & 7;
          const LAS float* Or = (const LAS float*)(lds + P_O) + tok * 132 + 16 * seg;
          f32x4 v[4]; float ss = 0.f;
#pragma unroll
          for (int i = 0; i < 4; ++i) { v[i] = *(const LAS f32x4*)(Or + 4 * i); ss += (v[i][0] * v[i][0] + v[i][1] * v[i][1]) + (v[i][2] * v[i][2] + v[i][3] * v[i][3]); }
          ss += __shfl_xor(ss, 1); ss += __shfl_xor(ss, 2); ss += __shfl_xor(ss, 4);
          const float rn = __builtin_amdgcn_rsqf(ss * (1.0f / 128.0f) + EPS);
          if (tok < T) {
              const size_t row = (size_t)(row0 + tok); const int cc = h * 128 + 16 * seg;
              const v4u gs0 = gsr[0], gs1 = gsr[1], gr0 = grr[0], gr1 = grr[1];
#define BF4(wd, hf) ((f32x4){__uint_as_float(((hf) ? (wd).z : (wd).x) << 16), __uint_as_float(((hf) ? (wd).z : (wd).x) & 0xffff0000u), __uint_as_float(((hf) ? (wd).w : (wd).y) << 16), __uint_as_float(((hf) ? (wd).w : (wd).y) & 0xffff0000u)})
              const f32x4 r0 = v[0] * rn * n0 * BF4(gs0, 0) * BF4(gr0, 0), r1 = v[1] * rn * n1 * BF4(gs0, 1) * BF4(gr0, 1);
              const f32x4 r2 = v[2] * rn * n2 * BF4(gs1, 0) * BF4(gr1, 0), r3 = v[3] * rn * n3 * BF4(gs1, 1) * BF4(gr1, 1);
#undef BF4
              bf16_t* mp = MIX + row * 2048 + 1024 + cc;
              *(v4u*)mp = (v4u){cvtpk(r0[0], r0[1]), cvtpk(r0[2], r0[3]), cvtpk(r1[0], r1[1]), cvtpk(r1[2], r1[3])};
              *(v4u*)(mp + 8) = (v4u){cvtpk(r2[0], r2[1]), cvtpk(r2[2], r2[3]), cvtpk(r3[0], r3[1]), cvtpk(r3[2], r3[3])};
          }
          if (c + 1 < NCH) gate_load(c + 1); }
    }
    { float* op = a.out + (SAMPLE ? O_NRS : O_NRP) + ((size_t)(b * NH + h) * 64) * 128 + 16 * w + l15;
#pragma unroll
      for (int blk = 0; blk < 4; ++blk)
#pragma unroll
          for (int r = 0; r < 4; ++r) op[(size_t)(16 * blk + 4 * fq + r) * 128] = S[blk][r]; }
}
}
__device__ __forceinline__ int p2_pop(gu32* qhead, volatile LAS unsigned* MISC) {
    __syncthreads();
    if (threadIdx.x == 0) MISC[12] = __hip_atomic_fetch_add(qhead, 1u, __ATOMIC_RELAXED, __HIP_MEMORY_SCOPE_AGENT);
    __syncthreads();
    return (int)MISC[12];
}
__device__ __forceinline__ void p2_mixers(const Args& a, LAS unsigned char* lds, int rep) {
    constexpr int E_RP = 32, E_AP = E_RP + 1024, E_AS = E_AP + 256, E_RS = E_AS + 256, E_LW = E_RS + LW_ITEMS / 32;
    gu32* qhead = (gu32*)(a.ws + WS_CTL) + CW_QUEUE + 64 * rep;
    volatile LAS unsigned* MISC = (volatile LAS unsigned*)(lds + MISC_OFF);
    { LAS float* cst = (LAS float*)(lds + att::L_CONST);
      if (threadIdx.x < 128) cst[threadIdx.x] = a.in[13][threadIdx.x];
      if (threadIdx.x < 2) cst[128 + threadIdx.x] = ((const float*)(a.ws + WS_SC))[threadIdx.x];
      __syncthreads(); }
#ifdef PROBE_P2SUB
    if (rep == 1) {
        int r = p2_pop(qhead, MISC);
        if (PROBE_P2SUB == 1) while (r < 32) { ret::ret_unit<false>(a, lds, r >> 3, r & 7); r = p2_pop(qhead, MISC); }
#ifndef PROBE_ABL
#define PROBE_ABL 0
#endif
        if (PROBE_P2SUB == 2) while (r < 1024) { const int qb = 31 - (r >> 5), bh = r & 31; att::attn_unit<false, PROBE_ABL>(a, lds, bh >> 3, bh & 7, qb, (bf16_t*)(a.ws + WS_NS1)); r = p2_pop(qhead, MISC); }
        if (PROBE_P2SUB == 3) while (r < 256) { att::attn_unit<true>(a, lds, r >> 3, r & 7, 0); r = p2_pop(qhead, MISC); }
        if (PROBE_P2SUB == 4) while (r < 256) { ret::ret_unit<true>(a, lds, r >> 3, r & 7); r = p2_pop(qhead, MISC); }
        return;
    }
#endif
    constexpr int F_RP = 32, F_AP = F_RP + 1024, F_LW = F_AP + LW_ITEMS / 32, F_RS = F_LW + 256, F_AS = F_RS + 256;
    int r = p2_pop(qhead, MISC);
    while (r < F_RP) { ret::ret_unit<false>(a, lds, r >> 3, r & 7); r = p2_pop(qhead, MISC); }
    asm volatile("" ::: "memory");
    while (r < F_AP) { const int pu = r - F_RP, qb = 31 - (pu >> 5), bh = pu & 31; att::attn_unit<false>(a, lds, bh >> 3, bh & 7, qb, nullptr, qhead); __syncthreads(); r = (int)MISC[12]; }
    asm volatile("" ::: "memory");
    {
        const int lw_wave = __builtin_amdgcn_readfirstlane(threadIdx.x >> 6);
        LAS float* scr = (LAS float*)(lds + lw_wave * 16384);
        while (r < F_LW) { const int u = r - F_AP;
            if (rep == 0) {
#pragma unroll 1
                for (int i = 0; i < 4; ++i) late_weight_item(a, u * 32 + i * 8 + lw_wave, scr, threadIdx.x & 63); }
            r = p2_pop(qhead, MISC); }
    }
    asm volatile("" ::: "memory");
    while (r < F_RS) { const int u = r - F_LW; ret::ret_unit<true>(a, lds, u >> 3, u & 7); r = p2_pop(qhead, MISC); }
    asm volatile("" ::: "memory");
    while (r < F_AS) { const int g = r - F_RS; att::attn_unit<true>(a, lds, g >> 3, g & 7, 0); r = p2_pop(qhead, MISC); }
}
namespace sg {
__device__ __forceinline__ int logical_col(int p) { return (p & ~255) + 64 * ((p >> 5) & 3) + 32 * ((p >> 7) & 1) + (p & 31); }

template <class Epi>
__device__ __forceinline__ void sgemm_phase(LAS unsigned char* lds, const bf16_t* A  , const bf16_t* Wt, int K, int bx, int G, const Epi& E) {
    int t_ = threadIdx.x; asm volatile("" : "+v"(t_));
    const int tid = t_, lane = tid & 63, l15 = lane & 15, fq = lane >> 4, w = __builtin_amdgcn_readfirstlane(tid >> 6), wr = w >> 1, wc = w & 1;
    const int lds0 = (int)(size_t)lds;
    const int nkb = K / 128;
    for (int tile = bx; tile < 256; tile += G) {
        const int r0 = (tile >> 4) * 64, c0 = (tile & 15) * 64;
        auto dma_blk = [&](int kb, int slot_off) {
#pragma unroll
            for (int i = 0; i < 2; ++i) {
                const int kid = tid + 512 * i, row = kid >> 4, cl = kid & 15, csrc = cl ^ (((row & 3) << 2) | ((row >> 2) & 3));
                att::glds16(A + (size_t)(r0 + row) * K + kb * 128 + 8 * csrc, (unsigned)__builtin_amdgcn_readfirstlane(lds0 + slot_off + w * 1024 + i * 8192));
                att::glds16(Wt + (size_t)(c0 + row) * K + kb * 128 + 8 * csrc, (unsigned)__builtin_amdgcn_readfirstlane(lds0 + slot_off + 16384 + w * 1024 + i * 8192));
            }
        };
        f32x4 acc[2] = {(f32x4){0.f, 0.f, 0.f, 0.f}, (f32x4){0.f, 0.f, 0.f, 0.f}};
        asm volatile("s_waitcnt lgkmcnt(0)\n\ts_barrier" ::: "memory");
        dma_blk(0, 0); dma_blk(1, 32768);
        int s_cur = 0, s_n1 = 32768, s_n2 = 65536;
        for (int kb = 0; kb < nkb; ++kb) {
            if (kb + 1 < nkb) asm volatile("s_waitcnt vmcnt(4) lgkmcnt(0)\n\ts_barrier" ::: "memory");
            else asm volatile("s_waitcnt vmcnt(0) lgkmcnt(0)\n\ts_barrier" ::: "memory");
            if (kb + 2 < nkb) dma_blk(kb + 2, s_n2);
            const LAS unsigned char* Ai = lds + s_cur; const LAS unsigned char* Bi = lds + s_cur + 16384;
#pragma unroll
            for (int st = 0; st < 4; ++st) {
                const bf16x8 fa = *(const LAS bf16x8*)(Ai + ret::ioff(16 * wr + l15, 4 * st + fq));
                const bf16x8 fb0 = *(const LAS bf16x8*)(Bi + ret::ioff(32 * wc + l15, 4 * st + fq));
                const bf16x8 fb1 = *(const LAS bf16x8*)(Bi + ret::ioff(32 * wc + 16 + l15, 4 * st + fq));
                acc[0] = __builtin_amdgcn_mfma_f32_16x16x32_bf16(fb0, fa, acc[0], 0, 0, 0);
                acc[1] = __builtin_amdgcn_mfma_f32_16x16x32_bf16(fb1, fa, acc[1], 0, 0, 0);
            }
            { const int tmp = s_cur; s_cur = s_n1; s_n1 = s_n2; s_n2 = tmp; }
        }
        const int row = MP + r0 + 16 * wr + l15, p0 = c0 + 32 * wc + 4 * fq;
        E(row, logical_col(p0), acc[0], logical_col(p0 + 16), acc[1], fq);
    }
    asm volatile("s_waitcnt lgkmcnt(0)\n\ts_barrier" ::: "memory");
}

struct EpiStoreBf16 {
    bf16_t* O;
    __device__ __forceinline__ void operator()(int row, int c0, const f32x4 a0, int c1, const f32x4 a1, int) const {
        *(v2u*)(O + (size_t)row * DM + c0) = (v2u){att::cvtpk(a0[0], a0[1]), att::cvtpk(a0[2], a0[3])};
        *(v2u*)(O + (size_t)row * DM + c1) = (v2u){att::cvtpk(a1[0], a1[1]), att::cvtpk(a1[2], a1[3])};
    }
};
struct EpiResid {
    const float* base; float* Xo; bf16_t* Xg; const float* g; float* SS;
    __device__ __forceinline__ void operator()(int row, int c0, const f32x4 a0, int c1, const f32x4 a1, int fq) const {
        const size_t o0 = (size_t)row * DM + c0, o1 = (size_t)row * DM + c1;
        const f32x4 x0 = *(const f32x4*)(base + o0) + a0, x1 = *(const f32x4*)(base + o1) + a1;
        float ss = (x0[0] * x0[0] + x0[1] * x0[1]) + (x0[2] * x0[2] + x0[3] * x0[3]) + (x1[0] * x1[0] + x1[1] * x1[1]) + (x1[2] * x1[2] + x1[3] * x1[3]);
        *(f32x4*)(Xo + o0) = x0; *(f32x4*)(Xo + o1) = x1;
        const f32x4 g0 = *(const f32x4*)(g + c0), g1 = *(const f32x4*)(g + c1), y0 = x0 * g0, y1 = x1 * g1;
        *(v2u*)(Xg + o0) = (v2u){att::cvtpk(y0[0], y0[1]), att::cvtpk(y0[2], y0[3])};
        *(v2u*)(Xg + o1) = (v2u){att::cvtpk(y1[0], y1[1]), att::cvtpk(y1[2], y1[3])};
        ss += __shfl_xor(ss, 16); ss += __shfl_xor(ss, 32);
        if (fq == 0) atomicAdd(SS + row, ss);
    }
};
struct EpiFinal {
    const float* SS; const bf16_t* T; const float* y; float* yo;
    __device__ __forceinline__ void operator()(int row, int c0, const f32x4 a0, int c1, const f32x4 a1, int) const {
        const float r = __builtin_amdgcn_rsqf(SS[row] * (1.0f / DM) + EPS);
        const size_t o0 = (size_t)row * DM + c0, o1 = (size_t)row * DM + c1;
        const v2u t0 = *(const v2u*)(T + o0), t1 = *(const v2u*)(T + o1);
        const f32x4 tf0 = (f32x4){__uint_as_float(t0.x << 16), __uint_as_float(t0.x & 0xffff0000u), __uint_as_float(t0.y << 16), __uint_as_float(t0.y & 0xffff0000u)};
        const f32x4 tf1 = (f32x4){__uint_as_float(t1.x << 16), __uint_as_float(t1.x & 0xffff0000u), __uint_as_float(t1.y << 16), __uint_as_float(t1.y & 0xffff0000u)};
        *(f32x4*)(yo + o0) = *(const f32x4*)(y + o0) + pg8::sig4(a0 * r) * tf0;
        *(f32x4*)(yo + o1) = *(const f32x4*)(y + o1) + pg8::sig4(a1 * r) * tf1;
    }
};
}
#ifndef PG8_SP2
#define PG8_SP2 true
#endif
#ifndef PG8_ALIGN
#define PG8_ALIGN true
#endif
__global__ void __launch_bounds__(NTHREADS, 2) fwd(Args args) {
    extern __shared__ __attribute__((aligned(16))) unsigned char lds_raw[];
    LAS unsigned char* lds = (LAS unsigned char*)lds_raw;
    volatile LAS unsigned* MISC = (volatile LAS unsigned*)(lds + MISC_OFF);
    const int tid = threadIdx.x, lane = tid & 63, wave = __builtin_amdgcn_readfirstlane(tid >> 6);
    const int G = gridDim.x, bx = blockIdx.x;
    const int vcu = (G % 8 == 0) ? (bx % 8) * (G / 8) + bx / 8 : bx;
    gu32* ctl = (gu32*)(args.ws + WS_CTL);
    for (int u = tid; u < (LDS_BYTES - LDSCTL_OFF) / 4; u += NTHREADS) ((LAS unsigned*)(lds + LDSCTL_OFF))[u] = 0u;
    __syncthreads();
    const int lo = args.ph_lo, hi = args.ph_hi;
    const bool multi = (hi - lo) > 1;
    XcdBarrier bar; bar.bar = (unsigned*)ctl + CW_BAR + args.li * XCD_BAR_WORDS; bar.x = 0; bar.st = nullptr;
    if (multi) bar = xcd_barrier_post((unsigned*)ctl + CW_BAR + args.li * XCD_BAR_WORDS, MISC + 8);
#ifndef PHASE_MASK
#define PHASE_MASK 0x7f
#endif
#define WSB(T_, off) ((T_*)(args.ws + (off)))
#define IN(k) (((PHASE_MASK >> (k)) & 1) && lo <= (k) && (k) < hi)
#define SEAM(k) do { if (IN(k) && IN((k) + 1)) xcd_barrier(bar); } while (0)
#ifndef PROBE_REP
#define PROBE_REP (-1)
#endif
#define PHASE(k, ...) do { if (IN(k)) { { constexpr int rep = 0; (void)rep; __VA_ARGS__ } if (PROBE_REP == (k)) { xcd_barrier(bar); { constexpr int rep = 1; (void)rep; __VA_ARGS__ } } } } while (0)
    PHASE(0, { p0_prologue(args, lds, vcu * NWAVES + wave, G * NWAVES, lane); });
    SEAM(0);
    PHASE(1, {
        { pg8::Gemm g{WSB(bf16_t, WS_H), WSB(const bf16_t, WS_WIN), M, NIN, DM}; pg8::StaticOrder S; S.init(M, NIN, G, bx);
          pg8::EpiInProj E{args.in[9], args.in[10], args.out, args.ws, args.fc};
          pg8::gemm_phase<pg8::EpiInProj, pg8::StaticOrder, PG8_ALIGN, PG8_SP2>(lds + RING_OFF, g, S, E); }
        asm volatile("" ::: "memory");
        if (G != 256 || bx >= 128) {
          pg8::Gemm g{WSB(bf16_t, WS_PB), WSB(const bf16_t, WS_WPL), MP, DM, PLE}; pg8::StaticOrder S; S.init(MP, DM, G == 256 ? 128 : G, G == 256 ? (bx & 127) : bx);
          pg8::EpiStoreBf16 E{WSB(bf16_t, WS_T)};
          pg8::gemm_phase<pg8::EpiStoreBf16, pg8::StaticOrder, PG8_ALIGN, PG8_SP2>(lds + RING_OFF, g, S, E); }
        { sg::EpiStoreBf16 E{WSB(bf16_t, WS_T)}; sg::sgemm_phase(lds + RING_OFF, WSB(const bf16_t, WS_PB) + (size_t)MP * PLE, WSB(const bf16_t, WS_WPL), PLE, bx, G, E); }
    });
    SEAM(1);
    PHASE(2, { p2_mixers(args, lds, rep); });
    SEAM(2);
    PHASE(3, {
        { pg8::Gemm g{WSB(bf16_t, WS_MIX), WSB(const bf16_t, WS_WO), MP, DM, 2048}; pg8::StaticOrder S; S.init(MP, DM, G, bx);
          pg8::EpiResid E{args.in[0], args.in[1], WSB(float, WS_X1), WSB(bf16_t, WS_X1G), args.in[16], WSB(float, WS_SS + rep * 256 * 1024)};
          pg8::gemm_phase<pg8::EpiResid, pg8::StaticOrder, PG8_ALIGN, PG8_SP2>(lds + RING_OFF, g, S, E); }
        { sg::EpiResid E{args.in[1] - (size_t)MP * DM, WSB(float, WS_X1), WSB(bf16_t, WS_X1G), args.in[16], WSB(float, WS_SS + rep * 256 * 1024)};
          sg::sgemm_phase(lds + RING_OFF, WSB(const bf16_t, WS_MIX) + (size_t)MP * 2048, WSB(const bf16_t, WS_WO), 2048, bx, G, E); }
    });
    SEAM(3);
    PHASE(4, {
        pg8::Gemm g{WSB(bf16_t, WS_X1G), WSB(const bf16_t, WS_WGU), M, 2 * DFF, DM}; pg8::StaticOrder S; S.init(M, 2 * DFF, G, bx);
        pg8::EpiGateUp E{WSB(const float, WS_SS), WSB(bf16_t, WS_HID)};
        pg8::gemm_phase<pg8::EpiGateUp, pg8::StaticOrder, PG8_ALIGN, PG8_SP2>(lds + RING_OFF, g, S, E);
    });
    SEAM(4);
    PHASE(5, {
        { pg8::Gemm g{WSB(bf16_t, WS_HID), WSB(const bf16_t, WS_WDN), MP, DM, DFF}; pg8::StaticOrder S; S.init(MP, DM, G, bx);
          pg8::EpiResid E{WSB(const float, WS_X1), WSB(const float, WS_X1) + (size_t)MP * DM, args.out + O_Y, WSB(bf16_t, WS_X2G), args.in[20], WSB(float, WS_SS + 128 * 1024 + rep * 256 * 1024)};
          pg8::gemm_phase<pg8::EpiResid, pg8::StaticOrder, PG8_ALIGN, PG8_SP2>(lds + RING_OFF, g, S, E); }
        { sg::EpiResid E{WSB(const float, WS_X1), args.out + O_Y, WSB(bf16_t, WS_X2G), args.in[20], WSB(float, WS_SS + 128 * 1024 + rep * 256 * 1024)};
          sg::sgemm_phase(lds + RING_OFF, WSB(const bf16_t, WS_HID) + (size_t)MP * DFF, WSB(const bf16_t, WS_WDN), DFF, bx, G, E); }
    });
    SEAM(5);
#ifndef PROBE_P6SUB
#define PROBE_P6SUB 3
#endif
    if (PROBE_REP == 6 && IN(6)) {
        if (PROBE_P6SUB & 1) { pg8::Gemm g{WSB(bf16_t, WS_X2G), WSB(const bf16_t, WS_WPG), MP, DM, DM}; pg8::StaticOrder S; S.init(MP, DM, G, bx);
          pg8::EpiFinal E{WSB(const float, WS_SS + 128 * 1024), WSB(const bf16_t, WS_T), args.out + O_Y, WSB(float, WS_NS1)};
          pg8::gemm_phase<pg8::EpiFinal, pg8::StaticOrder, PG8_ALIGN, PG8_SP2>(lds + RING_OFF, g, S, E); }
        if (PROBE_P6SUB & 2) { sg::EpiFinal E{WSB(const float, WS_SS + 128 * 1024), WSB(const bf16_t, WS_T), args.out + O_Y, WSB(float, WS_NS1)};
          sg::sgemm_phase(lds + RING_OFF, WSB(const bf16_t, WS_X2G) + (size_t)MP * DM, WSB(const bf16_t, WS_WPG), DM, bx, G, E); }
        xcd_barrier(bar);
    }
    if (IN(6)) {
        { pg8::Gemm g{WSB(bf16_t, WS_X2G), WSB(const bf16_t, WS_WPG), MP, DM, DM}; pg8::StaticOrder S; S.init(MP, DM, G, bx);
          pg8::EpiFinal E{WSB(const float, WS_SS + 128 * 1024), WSB(const bf16_t, WS_T), args.out + O_Y, args.out + O_Y};
          pg8::gemm_phase<pg8::EpiFinal, pg8::StaticOrder, PG8_ALIGN, PG8_SP2>(lds + RING_OFF, g, S, E); }
        { sg::EpiFinal E{WSB(const float, WS_SS + 128 * 1024), WSB(const bf16_t, WS_T), args.out + O_Y, args.out + O_Y};
          sg::sgemm_phase(lds + RING_OFF, WSB(const bf16_t, WS_X2G) + (size_t)MP * DM, WSB(const bf16_t, WS_WPG), DM, bx, G, E); }
    }
#undef PHASE
#undef IN
#undef SEAM
}
extern "C" void kernel_launch(void* const* d_in, const int* in_sizes, int n_in, void* d_out, int out_size, void* d_ws, size_t ws_size, hipStream_t stream) {
    static int grid = 0;
    if (grid == 0) {
        if (n_in != 23 || out_size != (int)O_END || ws_size < WS_END) { fprintf(stderr, "kernel_launch: unexpected sizes n_in %d out %d ws %zu\n", n_in, out_size, ws_size); grid = -1; return; }
        int dev = 0, cus = 0;
        if (hipGetDevice(&dev) != hipSuccess || hipDeviceGetAttribute(&cus, hipDeviceAttributeMultiprocessorCount, dev) != hipSuccess) { grid = -1; return; }
        if (hipFuncSetAttribute((const void*)fwd, hipFuncAttributeMaxDynamicSharedMemorySize, LDS_BYTES) != hipSuccess) { fprintf(stderr, "kernel_launch: hipFuncSetAttribute failed\n"); grid = -1; return; }
        grid = cus;
    }
    if (grid < 0) return;
    Args a{};
    for (int i = 0; i < 23; ++i) a.in[i] = (const float*)d_in[i];
    a.out = (float*)d_out; a.ws = (unsigned char*)d_ws; a.ph_lo = 0; a.ph_hi = 7; a.li = 0; a.fc = -1;
    (void)hipMemsetAsync((unsigned char*)d_ws + WS_CTL, 0, CTL_ZERO_BYTES, stream);
#ifdef PROBE_LAUNCH_BASE
    a.ph_hi = 2; hipLaunchKernelGGL(fwd, dim3(grid), dim3(NTHREADS), LDS_BYTES, stream, a);
    a.ph_lo = 2; a.ph_hi = 7; a.li = 2; hipLaunchKernelGGL(fwd, dim3(grid), dim3(NTHREADS), LDS_BYTES, stream, a);
#elif defined(PROBE_LAUNCH_P1)
    a.ph_hi = 2; hipLaunchKernelGGL(fwd, dim3(grid), dim3(NTHREADS), LDS_BYTES, stream, a);
    a.ph_lo = 1; a.ph_hi = 2; a.li = 1; a.fc = PROBE_LAUNCH_P1; hipLaunchKernelGGL(fwd, dim3(grid), dim3(NTHREADS), LDS_BYTES, stream, a);
    a.ph_lo = 2; a.ph_hi = 7; a.li = 2; a.fc = -1; hipLaunchKernelGGL(fwd, dim3(grid), dim3(NTHREADS), LDS_BYTES, stream, a);
#else
    hipLaunchKernelGGL(fwd, dim3(grid), dim3(NTHREADS), LDS_BYTES, stream, a);
#endif
}
```

```cpp
#include <hip/hip_runtime.h>
#include <cstdint>
#include <cstdio>
#include <type_traits>

typedef unsigned short bf16_t;

constexpr int DM = 1024, SEQ = 4096, NB = 4, MP = NB * SEQ;
constexpr int DB = 32, DT = 32, MS = DB * DT, PAST = 2048;
constexpr int M = MP + MS;
constexpr int NIN = 8192, DFF = 2816, PLE = 256, NH = 8;
constexpr float EPS = 1e-6f;
constexpr float LAM_INIT = 0.2f;
constexpr float LOG2E = 1.4426950408889634f;
constexpr float QSCALE = 0.125f * LOG2E;

constexpr size_t O_Y = 0, O_NKP = 17825792, O_NVP = 34603008, O_NRP = 51380224, O_NKS = 51642368, O_NVS = 52690944, O_NRS = 53739520, O_END = 55836672;

constexpr size_t MiB = 1u << 20;
constexpr size_t WS_CTL = 0;
constexpr size_t WS_SC = 512 * 1024;
constexpr size_t WS_ROPE = 1 * MiB;
constexpr size_t WS_WIN = 4 * MiB;
constexpr size_t WS_WO = 20 * MiB;
constexpr size_t WS_WGU = 24 * MiB;
constexpr size_t WS_WDN = 35 * MiB;
constexpr size_t WS_WPG = 41 * MiB;
constexpr size_t WS_WPL = 43 * MiB;
constexpr size_t WS_H = 44 * MiB;
constexpr size_t WS_PB = 78 * MiB;
constexpr size_t WS_Q = 87 * MiB;
constexpr size_t WS_KB = 121 * MiB;
constexpr size_t WS_VB = 155 * MiB;
constexpr size_t WS_QR = 189 * MiB;
constexpr size_t WS_KR = 206 * MiB;
constexpr size_t WS_VR = 223 * MiB;
constexpr size_t WS_GS = 257 * MiB;
constexpr size_t WS_GA = 291 * MiB;
constexpr size_t WS_GR = 325 * MiB;
constexpr size_t WS_MIX = 359 * MiB;
constexpr size_t WS_X1 = 427 * MiB;
constexpr size_t WS_X1G = 495 * MiB;
constexpr size_t WS_SS = 529 * MiB;
constexpr size_t WS_HID = 530 * MiB;
constexpr size_t WS_X2G = 624 * MiB;
constexpr size_t WS_T = 658 * MiB;
constexpr size_t WS_NS1 = 692 * MiB;
constexpr size_t WS_NS2 = 828 * MiB;
constexpr size_t WS_END = 964 * MiB;

__device__ __forceinline__ float bf2f(bf16_t v) { return __uint_as_float((unsigned)v << 16); }
__device__ __forceinline__ bf16_t f2bf(float f) { unsigned u = __float_as_uint(f); return (bf16_t)((u + 0x7fffu + ((u >> 16) & 1u)) >> 16); }
__device__ __forceinline__ unsigned pk2(float lo, float hi) { return (unsigned)f2bf(lo) | ((unsigned)f2bf(hi) << 16); }
__device__ __forceinline__ float sigmoidf_(float x) { return 1.0f / (1.0f + __expf(-x)); }
__device__ __forceinline__ float siluf_(float x) { return x / (1.0f + __expf(-x)); }

struct Ptrs {
    const float* in[23];
    float* out;
    unsigned char* ws;
};
namespace pg8 {
#define PG8_LAS __attribute__((address_space(3)))
typedef unsigned short bf16_t;
typedef short bf16x8 __attribute__((ext_vector_type(8)));
typedef float f32x4 __attribute__((ext_vector_type(4)));
typedef unsigned u32x4 __attribute__((ext_vector_type(4)));
constexpr int BM = 256, BK = 64, HALF = 128, HTB = HALF * BK * 2  , STAGE_BYTES = 8 * HTB, NXCD = 8, WGM = 8;

__host__ __device__ __forceinline__ int lds_byte(int r, int c) { const int st = (r >> 4) * 2 + (c >> 5), rr = r & 15, cc = c & 31, ob = rr * 64 + cc * 2; return st * 1024 + (ob ^ (((ob >> 9) & 1) << 5)); }
__host__ __device__ __forceinline__ void stage_rc(int b, int& R, int& C) { const int st = b / 1024, sb = b % 1024, swz = sb ^ (((sb >> 9) & 1) << 5); R = (st >> 1) * 16 + swz / 64; C = (st & 1) * 32 + (swz % 64) / 2; }
__host__ __device__ __forceinline__ int perm32(int rho) { const int n = rho >> 4, i = rho & 15; return 8 * (i >> 2) + 4 * n + (i & 3); }

struct Unit { int pm, pn; };
struct Gemm { const bf16_t* A; const bf16_t* Bt; int M, N, K; };

struct StaticOrder {
    int nM, nN, nwg, G, c;
    __host__ __device__ void init(int M, int N, int G_, int c_) { nM = M / BM; nN = N / BM; nwg = nM * nN; G = G_; c = c_; }
    __host__ __device__ bool next(int i, Unit& u) const {
        const long L = (long)i * G + c; if (L >= nwg) return false;
        int wgid = (int)L; { const int q = nwg / NXCD, r = nwg % NXCD, xcd = wgid % NXCD, off = wgid / NXCD; wgid = (xcd < r ? xcd * (q + 1) : r * (q + 1) + (xcd - r) * q) + off; }
        const int nig = WGM * nN, gid = wgid / nig, fm = gid * WGM, gsz = (nM - fm) < WGM ? (nM - fm) : WGM;
        u.pm = fm + ((wgid % nig) % gsz); u.pn = (wgid % nig) / gsz; return true;
    }
    __device__ __forceinline__ void a_ready(const Unit&) const {}
    __device__ __forceinline__ void done(const Unit&) const {}
};
__device__ __forceinline__ unsigned cvt_pk_bf16(float lo, float hi) { unsigned r; asm volatile("v_cvt_pk_bf16_f32 %0, %1, %2" : "=v"(r) : "v"(lo), "v"(hi)); return r; }
typedef float f32x2 __attribute__((ext_vector_type(2)));
template <class Epi, class Sched, bool ALIGN_EPI = false, bool SP2 = false>
__device__ __forceinline__ void gemm_phase(PG8_LAS unsigned char* lds, const Gemm g, const Sched& S, const Epi& E) {
    const int tid = threadIdx.x, wid = __builtin_amdgcn_readfirstlane(tid >> 6), lane = tid & 63, wr = wid >> 2, wc = wid & 3, fr = lane & 15, fq = lane >> 4;
    const int K = g.K, nt = K / BK;
    unsigned voffA[2], voffB[2];
#pragma unroll
    for (int i = 0; i < 2; ++i) { int R, C; stage_rc(tid * 16 + i * 8192, R, C); const int Rb = Epi::PERM ? ((R & ~31) + perm32(R & 31)) : R;
        voffA[i] = (unsigned)(R * K + C) * 2u; voffB[i] = (unsigned)(Rb * K + C) * 2u; }
    const size_t kstep = (size_t)(BK * 2);
    const size_t hstep = (size_t)HALF * K * 2;
    const size_t tstep = 2 * hstep;
    const unsigned ldsw = (unsigned)wid * 1024u;
    const int aoff = lds_byte(wr * 64 + fr, fq * 8), boff = lds_byte(wc * 32 + fr, fq * 8);
#define PG8_SA(b, h) (((b) * 2 + (h)) * HTB)
#define PG8_SB(b, h) ((4 + (b) * 2 + (h)) * HTB)
#define PG8_STAGE(bufoff, gbase, voff) do { _Pragma("unroll") for (int _i = 0; _i < 2; ++_i) \
        __builtin_amdgcn_global_load_lds((const unsigned*)((const char*)(gbase) + (voff)[_i]), (PG8_LAS unsigned*)(lds + (bufoff) + ldsw + _i * 8192), 16, 0, 0); } while (0)
#define PG8_LDA(dst, b, h) do { _Pragma("unroll") for (int m = 0; m < 4; ++m) _Pragma("unroll") for (int k = 0; k < 2; ++k) dst[m][k] = *(const PG8_LAS bf16x8*)(lds + PG8_SA(b, h) + aoff + m * 2048 + k * 1024); } while (0)
#define PG8_LDB(dst, b, h) do { _Pragma("unroll") for (int n = 0; n < 2; ++n) _Pragma("unroll") for (int k = 0; k < 2; ++k) dst[n][k] = *(const PG8_LAS bf16x8*)(lds + PG8_SB(b, h) + boff + n * 2048 + k * 1024); } while (0)
#define PG8_MMA(ai, bj, At, Bt) do { __builtin_amdgcn_s_setprio(1); _Pragma("unroll") for (int m = 0; m < 4; ++m) _Pragma("unroll") for (int n = 0; n < 2; ++n) _Pragma("unroll") for (int k = 0; k < 2; ++k) \
        acc[ai][bj][m][n] = __builtin_amdgcn_mfma_f32_16x16x32_bf16(Bt[n][k], At[m][k], acc[ai][bj][m][n], 0, 0, 0); __builtin_amdgcn_s_setprio(0); } while (0)
#define PG8_WAIT_V(n) asm volatile("s_waitcnt vmcnt(" #n ")" ::: "memory")
#define PG8_WAIT_L(n) asm volatile("s_waitcnt lgkmcnt(" #n ")" ::: "memory")
#define PG8_BAR __builtin_amdgcn_s_barrier()
#define PG8_SCHED __builtin_amdgcn_sched_barrier(0)
    Unit cur, nxt; int ui = 0;
    if (!S.next(0, cur)) return;
    f32x4 acc[2][2][4][2];
#pragma unroll
    for (int a = 0; a < 2; ++a)
#pragma unroll
        for (int b = 0; b < 2; ++b)
#pragma unroll
            for (int m = 0; m < 4; ++m)
#pragma unroll
                for (int n = 0; n < 2; ++n) acc[a][b][m][n] = (f32x4){0.f, 0.f, 0.f, 0.f};
    bf16x8 At[4][2], B0[2][2], B1[2][2];
    const char* cA = (const char*)g.A + (size_t)cur.pm * tstep; const char* cB = (const char*)g.Bt + (size_t)cur.pn * tstep;
    S.a_ready(cur);
    if constexpr (SP2) {
        PG8_STAGE(PG8_SB(0, 0), cB, voffB); PG8_STAGE(PG8_SB(0, 1), cB + hstep, voffB); PG8_STAGE(PG8_SA(0, 0), cA, voffA); PG8_STAGE(PG8_SA(0, 1), cA + hstep, voffA);
        if (wr == 1) PG8_BAR;
        PG8_WAIT_V(2); PG8_BAR;
        PG8_STAGE(PG8_SB(1, 0), cB + kstep, voffB); PG8_STAGE(PG8_SA(1, 0), cA + kstep, voffA); PG8_STAGE(PG8_SB(1, 1), cB + hstep + kstep, voffB);
        PG8_WAIT_V(6); PG8_BAR;
    } else {
        PG8_STAGE(PG8_SB(0, 0), cB, voffB); PG8_STAGE(PG8_SA(0, 0), cA, voffA); PG8_STAGE(PG8_SB(0, 1), cB + hstep, voffB); PG8_STAGE(PG8_SA(0, 1), cA + hstep, voffA);
        if (wr == 1) PG8_BAR;
        PG8_WAIT_V(4); PG8_BAR;
        PG8_STAGE(PG8_SB(1, 0), cB + kstep, voffB); PG8_STAGE(PG8_SA(1, 0), cA + kstep, voffA); PG8_STAGE(PG8_SB(1, 1), cB + hstep + kstep, voffB);
        PG8_WAIT_V(6); PG8_BAR;
    }
    for (;;) {
        const bool has_next = S.next(ui + 1, nxt);
        const char* nA = has_next ? (const char*)g.A + (size_t)nxt.pm * tstep : cA; const char* nB = has_next ? (const char*)g.Bt + (size_t)nxt.pn * tstep : cB;
        for (int t = 0; t < nt; t += 2) {
            const bool last = (t == nt - 2);
            const char* a1 = cA + (size_t)(t + 1) * kstep;
            const char* a2 = last ? nA : cA + (size_t)(t + 2) * kstep; const char* b2 = last ? nB : cB + (size_t)(t + 2) * kstep;
            const char* a3 = a2 + kstep; const char* b3 = b2 + kstep;
            if (last && has_next) S.a_ready(nxt);
            if constexpr (SP2) {
            PG8_LDB(B0, 0, 0); PG8_LDB(B1, 0, 1); PG8_SCHED; PG8_LDA(At, 0, 0); PG8_STAGE(PG8_SA(1, 1), a1 + hstep, voffA);
            PG8_WAIT_V(8); PG8_WAIT_L(0); PG8_BAR; PG8_MMA(0, 0, At, B0); PG8_MMA(0, 1, At, B1); PG8_BAR; PG8_SCHED;
            PG8_LDA(At, 0, 1); PG8_STAGE(PG8_SB(0, 0), b2, voffB); PG8_STAGE(PG8_SB(0, 1), b2 + hstep, voffB); PG8_STAGE(PG8_SA(0, 0), a2, voffA);
            PG8_WAIT_V(8); PG8_WAIT_L(0); PG8_BAR; PG8_MMA(1, 0, At, B0); PG8_MMA(1, 1, At, B1); PG8_BAR; PG8_SCHED;
            PG8_LDB(B0, 1, 0); PG8_LDB(B1, 1, 1); PG8_SCHED; PG8_LDA(At, 1, 0); PG8_STAGE(PG8_SA(0, 1), a2 + hstep, voffA);
            PG8_WAIT_V(8); PG8_WAIT_L(0); PG8_BAR; PG8_MMA(0, 0, At, B0); PG8_MMA(0, 1, At, B1); PG8_BAR; PG8_SCHED;
            PG8_LDA(At, 1, 1); PG8_STAGE(PG8_SB(1, 0), b3, voffB); PG8_STAGE(PG8_SB(1, 1), b3 + hstep, voffB); PG8_STAGE(PG8_SA(1, 0), a3, voffA);
            PG8_WAIT_V(8); PG8_WAIT_L(0); PG8_BAR; PG8_MMA(1, 0, At, B0); PG8_MMA(1, 1, At, B1); PG8_BAR; PG8_SCHED;
            } else {
            PG8_LDB(B0, 0, 0); PG8_SCHED; PG8_LDA(At, 0, 0); PG8_STAGE(PG8_SA(1, 1), a1 + hstep, voffA);
            PG8_WAIT_L(8); PG8_BAR; PG8_WAIT_L(0); PG8_MMA(0, 0, At, B0); PG8_BAR; PG8_SCHED;
            PG8_LDB(B1, 0, 1); PG8_STAGE(PG8_SB(0, 0), b2, voffB);
            PG8_BAR; PG8_WAIT_L(0); PG8_MMA(0, 1, At, B1); PG8_BAR;
            PG8_LDA(At, 0, 1); PG8_STAGE(PG8_SA(0, 0), a2, voffA);
            PG8_BAR; PG8_WAIT_L(0); PG8_MMA(1, 0, At, B0); PG8_BAR; PG8_SCHED;
            PG8_STAGE(PG8_SB(0, 1), b2 + hstep, voffB);
            PG8_WAIT_V(6); PG8_BAR; PG8_MMA(1, 1, At, B1); PG8_BAR;
            PG8_LDB(B0, 1, 0); PG8_SCHED; PG8_LDA(At, 1, 0); PG8_STAGE(PG8_SA(0, 1), a2 + hstep, voffA);
            PG8_WAIT_L(8); PG8_BAR; PG8_WAIT_L(0); PG8_MMA(0, 0, At, B0); PG8_BAR; PG8_SCHED;
            PG8_LDB(B1, 1, 1); PG8_STAGE(PG8_SB(1, 0), b3, voffB);
            PG8_BAR; PG8_WAIT_L(0); PG8_MMA(0, 1, At, B1); PG8_BAR;
            PG8_LDA(At, 1, 1); PG8_STAGE(PG8_SA(1, 0), a3, voffA);
            PG8_BAR; PG8_WAIT_L(0); PG8_MMA(1, 0, At, B0); PG8_BAR; PG8_SCHED;
            PG8_STAGE(PG8_SB(1, 1), b3 + hstep, voffB);
            PG8_WAIT_V(6); PG8_BAR; PG8_MMA(1, 1, At, B1); PG8_BAR;
            }
        }
        if constexpr (ALIGN_EPI) { if (wr == 0) PG8_BAR; }
        if constexpr (!Epi::AFTER_DRAIN) { E(acc, cur, wr, wc, fr, fq); S.done(cur); }
        if (!has_next) break;
#pragma unroll
        for (int a = 0; a < 2; ++a)
#pragma unroll
            for (int b = 0; b < 2; ++b)
#pragma unroll
                for (int m = 0; m < 4; ++m)
#pragma unroll
                    for (int n = 0; n < 2; ++n) acc[a][b][m][n] = (f32x4){0.f, 0.f, 0.f, 0.f};
        cur = nxt; cA = nA; cB = nB; ++ui;
        if constexpr (ALIGN_EPI) { if (wr == 1) PG8_BAR; }
    }
    PG8_WAIT_V(0);
    if constexpr (!ALIGN_EPI) { if (wr == 0) PG8_BAR; }
    PG8_BAR;
    if constexpr (Epi::AFTER_DRAIN) { E.fused(acc, cur, wr, wc, fr, fq, lds, wid, lane); S.done(cur); }
#undef PG8_SA
#undef PG8_SB
#undef PG8_STAGE
#undef PG8_LDA
#undef PG8_LDB
#undef PG8_MMA
#undef PG8_WAIT_V
#undef PG8_WAIT_L
#undef PG8_BAR
#undef PG8_SCHED
}
}
#define GAS __attribute__((address_space(1)))
#define LAS __attribute__((address_space(3)))
typedef unsigned v4u __attribute__((ext_vector_type(4)));
typedef unsigned v2u __attribute__((ext_vector_type(2)));
typedef float f32x4 __attribute__((ext_vector_type(4)));
typedef float f32x16 __attribute__((ext_vector_type(16)));
typedef short bf16x8 __attribute__((ext_vector_type(8)));
typedef short s16x4 __attribute__((ext_vector_type(4)));
typedef GAS unsigned gu32;
#define LDS_WAIT() asm volatile("s_waitcnt lgkmcnt(0)" ::: "memory")
#define VM_WAIT() asm volatile("s_waitcnt vmcnt(0)" ::: "memory")
#define LBAR() asm volatile("s_waitcnt lgkmcnt(0)\n\ts_barrier" ::: "memory")

constexpr int NWAVES = 8, NTHREADS = 512;
constexpr int RING_OFF = 0, RING_BYTES = 131072;
constexpr int LDSCTL_OFF = RING_BYTES, MISC_OFF = LDSCTL_OFF + 320;
constexpr int LDS_BYTES = 147456;
constexpr int CW_BAR = 4096;
constexpr int CW_QUEUE = 1024;
constexpr size_t CTL_ZERO_BYTES = 64 * 1024;

#define XB_TMO      128
#define XB_XCNT(j)  (256  + 64 * (j))
#define XB_XSUB(j)  (1280 + 64 * (j))
#define XB_XGEN(j)  (2304 + 64 * (j))
#define XB_TOP      3328
#define XB_TOPGEN   3392
#define XCD_BAR_WORDS 3456
#define XB_SPIN_CAP (1u << 18)

__device__ __forceinline__ unsigned xb_ld(unsigned* p)              { return __hip_atomic_load(p, __ATOMIC_RELAXED, __HIP_MEMORY_SCOPE_AGENT); }
__device__ __forceinline__ unsigned xb_add(unsigned* p, unsigned v) { return __hip_atomic_fetch_add(p, v, __ATOMIC_RELAXED, __HIP_MEMORY_SCOPE_AGENT); }
__device__ __forceinline__ unsigned xb_xcc_id() { return (unsigned)__builtin_amdgcn_s_getreg((3 << 11) | 20) & 0xFu; }
#define XB_SPIN(cond, bar) do { unsigned _sp = 0; while (cond) { __builtin_amdgcn_s_sleep(1); \
    if ((++_sp & 255u) == 0u) { if (xb_ld(&(bar)[XB_TMO])) break; if (_sp > XB_SPIN_CAP) { atomicAdd(&(bar)[XB_TMO], 1u); break; } } } } while (0)

struct XcdBarrier {
    unsigned* bar; unsigned x;
    volatile LAS unsigned* st;
};

__device__ __forceinline__ XcdBarrier xcd_barrier_post(unsigned* bar, volatile LAS unsigned* st) {
    XcdBarrier b; b.bar = bar; b.x = xb_xcc_id(); b.st = st;
    if (threadIdx.x == 0) (void)xb_add(&bar[XB_XCNT(b.x)], 1u);
    return b;
}
__device__ __forceinline__ void xcd_barrier_complete(unsigned* bar, unsigned x, unsigned& nloc, unsigned& nx) {
    const unsigned G = gridDim.x * gridDim.y * gridDim.z;
    unsigned sum, cnt, mine, sp = 0u;
    for (;;) {
        sum = 0u; cnt = 0u; mine = 0u;
#pragma unroll
        for (unsigned j = 0; j < 16; ++j) { const unsigned c = xb_ld(&bar[XB_XCNT(j)]); sum += c; cnt += (c > 0u) ? 1u : 0u; mine = (j == x) ? c : mine; }
        if (sum == G) break;
        __builtin_amdgcn_s_sleep(1);
        if ((++sp & 255u) == 0u) { if (xb_ld(&bar[XB_TMO])) break; if (sp > XB_SPIN_CAP) { atomicAdd(&bar[XB_TMO], 1u); break; } }
    }
    nloc = mine > 0u ? mine : 1u; nx = cnt > 0u ? cnt : 1u;
}

__device__ __forceinline__ void xcd_barrier(const XcdBarrier& b) {
    asm volatile("s_waitcnt vmcnt(0)" ::: "memory");
    __syncthreads();
    if (threadIdx.x == 0) {
        unsigned* bar = b.bar;
        __builtin_amdgcn_s_waitcnt(0);
        unsigned nloc = b.st[0], nx = b.st[1];
        if (nloc == 0u) { xcd_barrier_complete(bar, b.x, nloc, nx); b.st[0] = nloc; b.st[1] = nx; }
        const unsigned old = xb_add(&bar[XB_XSUB(b.x)], 1u);
        const unsigned gen = old / nloc;
        if (old + 1u == (gen + 1u) * nloc) {
            __builtin_amdgcn_fence(__ATOMIC_RELEASE, "agent");
            asm volatile("s_waitcnt vmcnt(0)" ::: "memory");
            const unsigned og = xb_add(&bar[XB_TOP], 1u);
            const unsigned tg = og / nx;
            if (og + 1u == (tg + 1u) * nx) xb_add(&bar[XB_TOPGEN], 1u);
            else XB_SPIN(xb_ld(&bar[XB_TOPGEN]) == tg, bar);
            __builtin_amdgcn_fence(__ATOMIC_ACQUIRE, "agent");
            xb_add(&bar[XB_XGEN(b.x)], 1u);
            asm volatile("s_waitcnt vmcnt(0)" ::: "memory");
        } else {
            XB_SPIN(xb_ld(&bar[XB_XGEN(b.x)]) == gen, bar);
            __builtin_amdgcn_fence(__ATOMIC_ACQUIRE, "agent");
            asm volatile("s_waitcnt vmcnt(0)" ::: "memory");
        }
    }
    __syncthreads();
}
namespace pg8 {
#define PG8_LANEPOS int t_ = threadIdx.x; asm volatile("" : "+v"(t_)); const int wid_ = __builtin_amdgcn_readfirstlane(t_ >> 6), wr = wid_ >> 2, wc = wid_ & 3, fr = t_ & 15, fq = (t_ >> 4) & 3

__device__ __forceinline__ u32x4 pack8(const f32x4 a, const f32x4 b) { u32x4 w; w.x = cvt_pk_bf16(a[0], a[1]); w.y = cvt_pk_bf16(a[2], a[3]); w.z = cvt_pk_bf16(b[0], b[1]); w.w = cvt_pk_bf16(b[2], b[3]); return w; }
__device__ __forceinline__ float fsig(float x) { return __builtin_amdgcn_rcpf(1.0f + __builtin_amdgcn_exp2f(-LOG2E * x)); }
__device__ __forceinline__ f32x4 sig4(const f32x4 v) { return (f32x4){fsig(v[0]), fsig(v[1]), fsig(v[2]), fsig(v[3])}; }
__device__ __forceinline__ f32x4 silu4(const f32x4 v) { return (f32x4){v[0] * fsig(v[0]), v[1] * fsig(v[1]), v[2] * fsig(v[2]), v[3] * fsig(v[3])}; }
__device__ __forceinline__ f32x4 bf4_lo(const u32x4 w, int half) {
    const unsigned a = half ? w.z : w.x, b = half ? w.w : w.y;
    return (f32x4){__uint_as_float(a << 16), __uint_as_float(a & 0xffff0000u), __uint_as_float(b << 16), __uint_as_float(b & 0xffff0000u)};
}

struct EpiInProj {
    static constexpr bool PERM = true, AFTER_DRAIN = false;
    const float* gq; const float* gk; float* out; unsigned char* ws; int force_cat;
    __device__ __forceinline__ void operator()(const f32x4 (&acc)[2][2][4][2], const Unit& u, int, int, int, int) const {
        PG8_LANEPOS;
        const int pn = u.pn, cat = force_cat >= 0 ? force_cat : (pn >> 2);
        const int row0 = u.pm * BM + wr * 64 + fr;
        const int lc0 = (pn & 3) * 256 + wc * 64 + 8 * fq;
        const bool smp = u.pm >= (MP / BM);
        bf16_t* const Q = (bf16_t*)(ws + WS_Q); bf16_t* const Kb = (bf16_t*)(ws + WS_KB);
        if (cat == 0 || cat == 1) {
            const float* g = cat == 0 ? gq : gk; f32x4 gv[2][2];
#pragma unroll
            for (int bj = 0; bj < 2; ++bj)
#pragma unroll
                for (int n = 0; n < 2; ++n) { gv[bj][n] = *(const f32x4*)(g + 32 * bj + 8 * fq + 4 * n); if (cat == 0) gv[bj][n] = gv[bj][n] * QSCALE; }
            float* ok = smp ? out + O_NKS - (size_t)MP * DM : out + O_NKP;
            float rs[2][4];
#pragma unroll
            for (int ai = 0; ai < 2; ++ai)
#pragma unroll
                for (int m = 0; m < 4; ++m) { float ss = 0.f;
#pragma unroll
                    for (int bj = 0; bj < 2; ++bj)
#pragma unroll
                        for (int n = 0; n < 2; ++n) { const f32x4 v = acc[ai][bj][m][n]; ss += (v[0] * v[0] + v[1] * v[1]) + (v[2] * v[2] + v[3] * v[3]); }
                    rs[ai][m] = ss; }
#pragma unroll
            for (int ai = 0; ai < 2; ++ai)
#pragma unroll
                for (int m = 0; m < 4; ++m) rs[ai][m] += __shfl_xor(rs[ai][m], 16);
#pragma unroll
            for (int ai = 0; ai < 2; ++ai)
#pragma unroll
                for (int m = 0; m < 4; ++m) rs[ai][m] += __shfl_xor(rs[ai][m], 32);
#pragma unroll
            for (int ai = 0; ai < 2; ++ai)
#pragma unroll
                for (int m = 0; m < 4; ++m) { const int row = row0 + ai * HALF + m * 16;
                    const float r = __builtin_amdgcn_rsqf(rs[ai][m] * (1.0f / 64.0f) + EPS);
#pragma unroll
                    for (int bj = 0; bj < 2; ++bj) { const f32x4 a = acc[ai][bj][m][0] * r * gv[bj][0], b = acc[ai][bj][m][1] * r * gv[bj][1];
                        const size_t off = (size_t)row * DM + lc0 + 32 * bj;
                        if (cat == 0) { *(u32x4*)(Q + off) = pack8(a, b); }
                        else { *(f32x4*)(ok + off) = a; *(f32x4*)(ok + off + 4) = b; *(u32x4*)(Kb + off) = pack8(a, b); } } }
        } else if (cat == 2 || cat == 8) {
            float* ov = cat == 8 ? (float*)(ws + WS_NS2) : smp ? out + O_NVS - (size_t)MP * DM : out + O_NVP;
            bf16_t* const Vb = (bf16_t*)(ws + (cat == 8 ? WS_NS1 : WS_VB));
#pragma unroll
            for (int ai = 0; ai < 2; ++ai)
#pragma unroll
                for (int m = 0; m < 4; ++m) { const int row = row0 + ai * HALF + m * 16;
#pragma unroll
                    for (int bj = 0; bj < 2; ++bj) { const f32x4 a = acc[ai][bj][m][0], b = acc[ai][bj][m][1]; const size_t off = (size_t)row * DM + lc0 + 32 * bj;
                        *(f32x4*)(ov + off) = a; *(f32x4*)(ov + off + 4) = b; *(u32x4*)(Vb + off) = pack8(a, b); } }
        } else if (cat == 3) {
            const int g64 = (pn - 12) * 4 + wc, hh = g64 & 7; const bool isk = g64 >= 8;
            bf16_t* dst = (bf16_t*)(ws + (isk ? WS_KR : WS_QR)); const float sc = isk ? 0.125f : 1.0f;
            f32x4 rv[2];
#pragma unroll
            for (int n = 0; n < 2; ++n)
#pragma unroll
                for (int e = 0; e < 4; ++e) rv[n][e] = __builtin_amdgcn_exp2f(-(float)(8 * fq + 4 * n + e) * (13.287712379549449f / 32.0f));
#pragma unroll
            for (int ai = 0; ai < 2; ++ai)
#pragma unroll
                for (int m = 0; m < 4; ++m) { const int row = row0 + ai * HALF + m * 16;
                    const float pos = (float)(smp ? PAST + ((row - MP) & 31) : (row & 4095));
                    f32x4 o1[2], o2[2];
#pragma unroll
                    for (int n = 0; n < 2; ++n) { f32x4 cs, sn;
#pragma unroll
                        for (int e = 0; e < 4; ++e) { const float ang = pos * rv[n][e]; const float fr = __builtin_amdgcn_fractf(ang * 0.15915494309189535f);
                            cs[e] = __builtin_amdgcn_cosf(fr); sn[e] = __builtin_amdgcn_sinf(fr); }
                        const f32x4 x1 = acc[ai][0][m][n], x2 = acc[ai][1][m][n];
                        o1[n] = (x1 * cs - x2 * sn) * sc; o2[n] = (x1 * sn + x2 * cs) * sc; }
                    const size_t off = (size_t)row * 512 + hh * 64 + 8 * fq;
                    *(u32x4*)(dst + off) = pack8(o1[0], o1[1]); *(u32x4*)(dst + off + 32) = pack8(o2[0], o2[1]); }
        } else {
            bf16_t* dst = (bf16_t*)(ws + (force_cat >= 0 ? WS_NS1 : cat == 4 ? WS_VR : cat == 5 ? WS_GS : cat == 6 ? WS_GA : WS_GR));
#pragma unroll
            for (int ai = 0; ai < 2; ++ai)
#pragma unroll
                for (int m = 0; m < 4; ++m) { const int row = row0 + ai * HALF + m * 16;
#pragma unroll
                    for (int bj = 0; bj < 2; ++bj) { f32x4 a = acc[ai][bj][m][0], b = acc[ai][bj][m][1];
                        if (cat == 5) { a = silu4(a); b = silu4(b); } else if (cat >= 6) { a = sig4(a); b = sig4(b); }
                        *(u32x4*)(dst + (size_t)row * DM + lc0 + 32 * bj) = pack8(a, b); } }
        }
    }
};

struct EpiStoreBf16 {
    static constexpr bool PERM = true, AFTER_DRAIN = false;
    bf16_t* O;
    __device__ __forceinline__ void operator()(const f32x4 (&acc)[2][2][4][2], const Unit& u, int, int, int, int) const {
        PG8_LANEPOS;
        const int row0 = u.pm * BM + wr * 64 + fr, col0 = u.pn * BM + wc * 64 + 8 * fq;
#pragma unroll
        for (int ai = 0; ai < 2; ++ai)
#pragma unroll
            for (int m = 0; m < 4; ++m)
#pragma unroll
                for (int bj = 0; bj < 2; ++bj) *(u32x4*)(O + (size_t)(row0 + ai * HALF + m * 16) * DM + col0 + 32 * bj) = pack8(acc[ai][bj][m][0], acc[ai][bj][m][1]);
    }
};

struct EpiResid {
    static constexpr bool PERM = true, AFTER_DRAIN = false;
    const float* base0; const float* base1;
    float* Xo; bf16_t* Xg; const float* g; float* SS;
    __device__ __forceinline__ void operator()(const f32x4 (&acc)[2][2][4][2], const Unit& u, int, int, int, int) const {
        PG8_LANEPOS;
        const int row0 = u.pm * BM + wr * 64 + fr, col0 = u.pn * BM + wc * 64 + 8 * fq;
        const float* base = u.pm >= (MP / BM) ? base1 - (size_t)MP * DM : base0;
        f32x4 gv[2][2];
#pragma unroll
        for (int bj = 0; bj < 2; ++bj)
#pragma unroll
            for (int n = 0; n < 2; ++n) gv[bj][n] = *(const f32x4*)(g + col0 + 32 * bj + 4 * n);
#pragma unroll
        for (int ai = 0; ai < 2; ++ai) {
            f32x4 r[4][2][2];
#pragma unroll
            for (int m = 0; m < 4; ++m)
#pragma unroll
                for (int bj = 0; bj < 2; ++bj) { const size_t off = (size_t)(row0 + ai * HALF + m * 16) * DM + col0 + 32 * bj;
                    r[m][bj][0] = *(const f32x4*)(base + off); r[m][bj][1] = *(const f32x4*)(base + off + 4); }
            asm volatile("" ::: "memory");
#pragma unroll
            for (int m = 0; m < 4; ++m) { const int row = row0 + ai * HALF + m * 16; float ss = 0.f;
#pragma unroll
                for (int bj = 0; bj < 2; ++bj) { const size_t off = (size_t)row * DM + col0 + 32 * bj;
                    const f32x4 a = r[m][bj][0] + acc[ai][bj][m][0], b = r[m][bj][1] + acc[ai][bj][m][1];
                    ss += (a[0] * a[0] + a[1] * a[1]) + (a[2] * a[2] + a[3] * a[3]) + (b[0] * b[0] + b[1] * b[1]) + (b[2] * b[2] + b[3] * b[3]);
                    *(f32x4*)(Xo + off) = a; *(f32x4*)(Xo + off + 4) = b; *(u32x4*)(Xg + off) = pack8(a * gv[bj][0], b * gv[bj][1]); }
                ss += __shfl_xor(ss, 16); ss += __shfl_xor(ss, 32);
                if (fq == 0) atomicAdd(SS + row, ss); }
            asm volatile("" ::: "memory");
        }
    }
};

struct EpiGateUp {
    static constexpr bool PERM = true, AFTER_DRAIN = false;
    const float* SS; bf16_t* HID;
    __device__ __forceinline__ void operator()(const f32x4 (&acc)[2][2][4][2], const Unit& u, int, int, int, int) const {
        PG8_LANEPOS;
        const int row0 = u.pm * BM + wr * 64 + fr, col0 = u.pn * 128 + wc * 32 + 8 * fq;
        float sv[2][4];
#pragma unroll
        for (int ai = 0; ai < 2; ++ai)
#pragma unroll
            for (int m = 0; m < 4; ++m) sv[ai][m] = SS[row0 + ai * HALF + m * 16];
        asm volatile("" ::: "memory");
#pragma unroll
        for (int ai = 0; ai < 2; ++ai)
#pragma unroll
            for (int m = 0; m < 4; ++m) { const int row = row0 + ai * HALF + m * 16;
                const float r = __builtin_amdgcn_rsqf(sv[ai][m] * (1.0f / DM) + EPS);
                const f32x4 g0 = acc[ai][0][m][0] * r, g1 = acc[ai][0][m][1] * r, u0 = acc[ai][1][m][0] * r, u1 = acc[ai][1][m][1] * r;
                *(u32x4*)(HID + (size_t)row * DFF + col0) = pack8(silu4(g0) * u0, silu4(g1) * u1); }
    }
};

struct EpiFinal {
    static constexpr bool PERM = true, AFTER_DRAIN = false;
    const float* SS; const bf16_t* T; const float* y; float* yo;
    __device__ __forceinline__ void operator()(const f32x4 (&acc)[2][2][4][2], const Unit& u, int, int, int, int) const {
        PG8_LANEPOS;
        const int row0 = u.pm * BM + wr * 64 + fr, col0 = u.pn * BM + wc * 64 + 8 * fq;
#pragma unroll
        for (int ai = 0; ai < 2; ++ai)
#pragma unroll
            for (int mp = 0; mp < 2; ++mp) {
                f32x4 yv[2][2][2]; u32x4 tv[2][2]; float sv[2];
#pragma unroll
                for (int mm = 0; mm < 2; ++mm) { const int row = row0 + ai * HALF + (2 * mp + mm) * 16; sv[mm] = SS[row];
#pragma unroll
                    for (int bj = 0; bj < 2; ++bj) { const size_t off = (size_t)row * DM + col0 + 32 * bj;
                        yv[mm][bj][0] = *(const f32x4*)(y + off); yv[mm][bj][1] = *(const f32x4*)(y + off + 4); tv[mm][bj] = *(const u32x4*)(T + off); } }
                asm volatile("" ::: "memory");
#pragma unroll
                for (int mm = 0; mm < 2; ++mm) { const int m = 2 * mp + mm, row = row0 + ai * HALF + m * 16;
                    const float r = __builtin_amdgcn_rsqf(sv[mm] * (1.0f / DM) + EPS);
#pragma unroll
                    for (int bj = 0; bj < 2; ++bj) { const size_t off = (size_t)row * DM + col0 + 32 * bj;
                        const f32x4 a = yv[mm][bj][0] + sig4(acc[ai][bj][m][0] * r) * bf4_lo(tv[mm][bj], 0), b = yv[mm][bj][1] + sig4(acc[ai][bj][m][1] * r) * bf4_lo(tv[mm][bj], 1);
                        *(f32x4*)(yo + off) = a; *(f32x4*)(yo + off + 4) = b; } }
                asm volatile("" ::: "memory");
            }
    }
};

}
struct Args { const float* in[23]; float* out; unsigned char* ws; int ph_lo, ph_hi, li, fc; };

__device__ __forceinline__ void transpose_item(const float* src, int ldw, bf16_t* dst, int ldk, LAS float* scr, int lane) {
    float tv[32];
#pragma unroll
    for (int i = 0; i < 32; ++i) tv[i] = src[(size_t)(2 * i + (lane >> 5)) * ldw + (lane & 31)];
#pragma unroll
    for (int i = 0; i < 32; ++i) scr[(2 * i + (lane >> 5)) * 33 + (lane & 31)] = tv[i];
    LDS_WAIT(); asm volatile("" ::: "memory");
    const int c = lane & 7;
#pragma unroll
    for (int j = 0; j < 4; ++j) { const int n = (lane >> 3) + 8 * j; const LAS float* s = scr + (8 * c) * 33 + n;
        v4u o; o.x = pk2(s[0 * 33], s[1 * 33]); o.y = pk2(s[2 * 33], s[3 * 33]); o.z = pk2(s[4 * 33], s[5 * 33]); o.w = pk2(s[6 * 33], s[7 * 33]);
        *(v4u*)(dst + (size_t)n * ldk + 8 * c) = o; }
    LDS_WAIT(); asm volatile("" ::: "memory");
}

__device__ __forceinline__ int perm_col0(int g32) { const int pn = g32 >> 3, bj = (g32 >> 2) & 1, wc = g32 & 3; return 256 * pn + 64 * wc + 32 * bj; }

constexpr int LW_I_O = (DM / 32) * (2048 / 64), LW_I_GU = (2 * DFF / 32) * (DM / 64), LW_I_DN = (DM / 32) * (DFF / 64), LW_I_PG = (DM / 32) * (DM / 64);
constexpr int LW_ITEMS = LW_I_O + LW_I_GU + LW_I_DN + LW_I_PG;
__device__ __forceinline__ void late_weight_item(const Args& a, int it, LAS float* scr, int lane) {
    unsigned char* ws = a.ws;
    const float *w_o = a.in[15], *w_g = a.in[17], *w_u = a.in[18], *w_d = a.in[19], *w_pg = a.in[22];
    bf16_t *WO = (bf16_t*)(ws + WS_WO), *WGU = (bf16_t*)(ws + WS_WGU), *WDN = (bf16_t*)(ws + WS_WDN), *WPG = (bf16_t*)(ws + WS_WPG);
    int r = it;
    if (r < LW_I_O) { const int g32 = r / 32, kb = r % 32; transpose_item(w_o + (size_t)((kb * 64) % DM) * DM + perm_col0(g32), DM, WO + (size_t)g32 * 32 * 2048 + kb * 64, 2048, scr, lane); return; } r -= LW_I_O;
    if (r < LW_I_GU) { const int g32 = r / (DM / 64), kb = r % (DM / 64); const int pn = g32 >> 3, bj = (g32 >> 2) & 1, wc = g32 & 3;
        transpose_item((bj ? w_u : w_g) + (size_t)kb * 64 * DFF + 128 * pn + 32 * wc, DFF, WGU + (size_t)g32 * 32 * DM + kb * 64, DM, scr, lane); return; } r -= LW_I_GU;
    if (r < LW_I_DN) { const int g32 = r / (DFF / 64), kb = r % (DFF / 64); transpose_item(w_d + (size_t)kb * 64 * DM + perm_col0(g32), DM, WDN + (size_t)g32 * 32 * DFF + kb * 64, DFF, scr, lane); return; } r -= LW_I_DN;
    { const int g32 = r / (DM / 64), kb = r % (DM / 64); transpose_item(w_pg + (size_t)kb * 64 * DM + perm_col0(g32), DM, WPG + (size_t)g32 * 32 * DM + kb * 64, DM, scr, lane); }
}

__device__ __forceinline__ void p0_prologue(const Args& a, LAS unsigned char* lds, int gw, int NGW, int lane) {
    unsigned char* ws = a.ws;
    LAS float* scr = (LAS float*)(lds + (threadIdx.x >> 6) * 16384);
    const float *w_in = a.in[7], *w_ple = a.in[21];
    bf16_t *WIN = (bf16_t*)(ws + WS_WIN), *WPL = (bf16_t*)(ws + WS_WPL);
    constexpr int I_IN = (NIN / 32) * (DM / 64), I_PL = (DM / 32) * (PLE / 64);
    constexpr int NITEMS = I_IN + I_PL;
    for (int it = gw; it < NITEMS; it += NGW) {
        int r = it;
        if (r < I_IN) { const int g32 = r / (DM / 64), kb = r % (DM / 64); transpose_item(w_in + (size_t)kb * 64 * NIN + perm_col0(g32), NIN, WIN + (size_t)g32 * 32 * DM + kb * 64, DM, scr, lane); continue; } r -= I_IN;
        { const int g32 = r / (PLE / 64), kb = r % (PLE / 64); transpose_item(w_ple + (size_t)kb * 64 * DM + perm_col0(g32), DM, WPL + (size_t)g32 * 32 * PLE + kb * 64, PLE, scr, lane); }
    }
    const float *xp = a.in[0], *xs = a.in[1], *g = a.in[8]; bf16_t* H = (bf16_t*)(ws + WS_H);
    for (int row0 = gw; row0 < M; row0 += 2 * NGW) {
        const int row1 = row0 + NGW; const bool has1 = row1 < M;
        const f32x4* x0 = (const f32x4*)(row0 < MP ? xp + (size_t)row0 * DM : xs + (size_t)(row0 - MP) * DM);
        const f32x4* x1 = (const f32x4*)(!has1 ? (const float*)x0 : row1 < MP ? xp + (size_t)row1 * DM : xs + (size_t)(row1 - MP) * DM);
        f32x4 v[4], u[4]; float s = 0.f, t = 0.f;
#pragma unroll
        for (int j = 0; j < 4; ++j) { v[j] = x0[lane + 64 * j]; u[j] = x1[lane + 64 * j]; }
#pragma unroll
        for (int j = 0; j < 4; ++j) { s += (v[j][0] * v[j][0] + v[j][1] * v[j][1]) + (v[j][2] * v[j][2] + v[j][3] * v[j][3]); t += (u[j][0] * u[j][0] + u[j][1] * u[j][1]) + (u[j][2] * u[j][2] + u[j][3] * u[j][3]); }
#pragma unroll
        for (int o = 1; o < 64; o <<= 1) { s += __shfl_xor(s, o); t += __shfl_xor(t, o); }
        const float r = rsqrtf(s * (1.0f / DM) + EPS), q = rsqrtf(t * (1.0f / DM) + EPS);
#pragma unroll
        for (int j = 0; j < 4; ++j) { const f32x4 gg = ((const f32x4*)g)[lane + 64 * j];
            v2u o; o.x = pk2(v[j][0] * r * gg[0], v[j][1] * r * gg[1]); o.y = pk2(v[j][2] * r * gg[2], v[j][3] * r * gg[3]);
            ((v2u*)(H + (size_t)row0 * DM))[lane + 64 * j] = o;
            if (has1) { v2u w; w.x = pk2(u[j][0] * q * gg[0], u[j][1] * q * gg[1]); w.y = pk2(u[j][2] * q * gg[2], u[j][3] * q * gg[3]);
                ((v2u*)(H + (size_t)row1 * DM))[lane + 64 * j] = w; } }
    }
    { const float *pp = a.in[5], *ps = a.in[6]; bf16_t* PB = (bf16_t*)(ws + WS_PB);
      const size_t n4 = (size_t)M * PLE / 4, np4 = (size_t)MP * PLE / 4;
      const size_t st = (size_t)NGW * 64;
      for (size_t i0 = (size_t)gw * 64 + lane; i0 < n4; i0 += 4 * st) {
          f32x4 v[4];
#pragma unroll
          for (int k = 0; k < 4; ++k) { const size_t i = i0 + k * st; v[k] = i < np4 ? ((const f32x4*)pp)[i] : i < n4 ? ((const f32x4*)ps)[i - np4] : (f32x4){0.f, 0.f, 0.f, 0.f}; }
#pragma unroll
          for (int k = 0; k < 4; ++k) { const size_t i = i0 + k * st; if (i < n4) { v2u o; o.x = pk2(v[k][0], v[k][1]); o.y = pk2(v[k][2], v[k][3]); ((v2u*)PB)[i] = o; } }
      } }
    { float* SS = (float*)(ws + WS_SS);
      for (int i = gw * 64 + lane; i < 65536; i += NGW * 64) SS[i] = 0.f; }
    { const float *lq = a.in[11], *lk = a.in[12], *gq = a.in[9], *gk = a.in[10]; float* sc = (float*)(ws + WS_SC);
      if (gw == 0) {
          float s0 = lq[lane] * lk[lane], s1 = lq[64 + lane] * lk[64 + lane], mq = fabsf(gq[lane]), mk = fabsf(gk[lane]);
#pragma unroll
          for (int o = 1; o < 64; o <<= 1) { s0 += __shfl_xor(s0, o); s1 += __shfl_xor(s1, o); mq = fmaxf(mq, __shfl_xor(mq, o)); mk = fmaxf(mk, __shfl_xor(mk, o)); }
          if (lane == 0) { sc[0] = expf(s0) - expf(s1) + LAM_INIT; sc[1] = 8.0f * LOG2E * mq * mk * 1.01f; }
      }
    }
}
namespace att {
typedef short v4i16_t __attribute__((ext_vector_type(4)));
typedef float f32x2_t __attribute__((ext_vector_type(2)));
typedef __bf16 bf16x2_t __attribute__((ext_vector_type(2)));
__device__ __forceinline__ unsigned cvtpk(float lo, float hi) { f32x2_t v = {lo, hi}; bf16x2_t b = __builtin_convertvector(v, bf16x2_t); return __builtin_bit_cast(unsigned, b); }
__device__ __forceinline__ s16x4 vtr(const LAS unsigned char* p) { return __builtin_bit_cast(s16x4, __builtin_amdgcn_ds_read_tr16_b64_v4i16((LAS v4i16_t*)p)); }
__device__ __forceinline__ void glds16(const void* gsrc, unsigned lds_dst) { unsigned keep;
    asm volatile("s_mov_b32 %0, m0\n\ts_mov_b32 m0, %2\n\ts_nop 0\n\tglobal_load_lds_dwordx4 %1, off\n\ts_mov_b32 m0, %0" : "=&s"(keep) : "v"(gsrc), "s"(lds_dst) : "memory"); }
__device__ __forceinline__ int crow(int r, int hi) { return (r & 3) + 8 * (r >> 2) + 4 * hi; }
__device__ __forceinline__ int koff(int row, int ch) { return 256 * row + 16 * (ch ^ (((row & 3) << 2) | ((row >> 2) & 3))); }
constexpr int L_K = 0, L_V = 32768, L_WS = 132096;
constexpr int L_CONST = 131520;

template <bool SAMPLE, int ABL = 0>
__device__ __forceinline__ void attn_unit(const Args& a, LAS unsigned char* lds, int b, int h, int qb, bf16_t* mixbase = nullptr, gu32* qhead = nullptr) {
    unsigned char* ws = a.ws;
    const bf16_t *Q = (const bf16_t*)(ws + WS_Q), *Kb = (const bf16_t*)(ws + WS_KB), *Vb = (const bf16_t*)(ws + WS_VB), *GA = (const bf16_t*)(ws + WS_GA);
    bf16_t* MIX = mixbase ? mixbase : (bf16_t*)(ws + WS_MIX);
    const float *cK = a.in[2], *cV = a.in[3];
    const LAS float* cst = (const LAS float*)(lds + L_CONST);
    int tid_ = threadIdx.x; asm volatile("" : "+v"(tid_));
    const int tid = tid_, lane = tid & 63, r32 = lane & 31, hi = lane >> 5;
    const int wave = __builtin_amdgcn_readfirstlane(tid >> 6), rb = wave >> 1, map = wave & 1;
    const int row0 = SAMPLE ? MP + b * DT : b * SEQ + qb * 128;
    const int NT = SAMPLE ? (PAST / 64 + 1) : 2 * qb + 2;
    const int tlast = SAMPLE ? NT - 1 : 2 * qb + (rb >> 1);
    const bool wactive = SAMPLE ? (rb == 0) : true;
    const float lam = cst[128], shift = cst[129];

    const int lw = (wave - 2) & 3;
    auto ldraw = [&](f32x4 (&r)[16], int t) {
        const size_t row0c = (size_t)(b * PAST + 64 * t + 16 * lw + hi) * NH + h;
        const float* kp = cK + row0c * 128 + 4 * r32;
        const float* vp = cV + row0c * 128 + 4 * r32;
#pragma unroll
        for (int n = 0; n < 8; ++n) {
            r[n] = __builtin_nontemporal_load((const f32x4*)(kp + (size_t)(2 * n) * NH * 128));
            r[8 + n] = __builtin_nontemporal_load((const f32x4*)(vp + (size_t)(2 * n) * NH * 128));
        }
    };
    auto wrraw = [&](const f32x4 (&r)[16], int buf) {
#pragma unroll
        for (int n = 0; n < 8; ++n) {
            const int key = 16 * lw + 2 * n + hi;
            *(LAS v2u*)(lds + buf * 32768 + koff(key, r32 >> 1) + 8 * (r32 & 1)) = (v2u){cvtpk(r[n][0], r[n][1]), cvtpk(r[n][2], r[n][3])};
            *(LAS v2u*)(lds + buf * 32768 + 16384 + ((r32 >> 3) * 4 + lw) * 1024 + (2 * n + hi) * 64 + (r32 & 7) * 8) = (v2u){cvtpk(r[8 + n][0], r[8 + n][1]), cvtpk(r[8 + n][2], r[8 + n][3])};
        }
    };

    bf16x8 qf[4];
    const bf16_t* qp = Q + (size_t)(row0 + (SAMPLE ? 0 : 32 * rb) + r32) * DM + h * 128 + map * 64 + 8 * hi;
    if constexpr (SAMPLE) {
#pragma unroll
        for (int d0 = 0; d0 < 4; ++d0) qf[d0] = *(const bf16x8*)(qp + 16 * d0);
    }
    f32x16 o[4];
#pragma unroll
    for (int d = 0; d < 4; ++d)
#pragma unroll
        for (int r = 0; r < 16; ++r) o[d][r] = 0.f;
    float l_reg = 0.f;
    f32x16 negs;
#pragma unroll
    for (int r = 0; r < 16; ++r) negs[r] = -shift;
    const int vp0 = ((lane >> 4) & 1) * 32 + (lane & 3) * 8 + (4 * hi + ((lane & 15) >> 2)) * 64;

    __syncthreads();
    if constexpr (!SAMPLE) {
        const int lds0 = (int)(size_t)lds;
        auto dma_tile = [&](int t, int slot_off) {
#pragma unroll
            for (int i = 0; i < 2; ++i) {
                const int kid = tid + 512 * i, key = kid >> 4, cl = kid & 15;
                const int csrc = cl ^ (((key & 3) << 2) | ((key >> 2) & 3));
                const int pz = wave + 8 * i, vkey = 16 * (pz & 3) + (lane >> 2), vd = 32 * (pz >> 2) + 8 * (lane & 3);
                const bf16_t* ksrc = Kb + (size_t)(b * SEQ + 64 * t + key) * DM + h * 128 + 8 * csrc;
                const bf16_t* vsrc = Vb + (size_t)(b * SEQ + 64 * t + vkey) * DM + h * 128 + vd;
                glds16(ksrc, (unsigned)__builtin_amdgcn_readfirstlane(lds0 + slot_off + wave * 1024 + i * 8192));
                glds16(vsrc, (unsigned)__builtin_amdgcn_readfirstlane(lds0 + slot_off + 16384 + (wave + 8 * i) * 1024));
            }
        };
        dma_tile(0, 0); dma_tile(1, 32768);
#pragma unroll
        for (int d0 = 0; d0 < 4; ++d0) qf[d0] = *(const bf16x8*)(qp + 16 * d0);
        asm volatile("" : "+v"(qf[0]), "+v"(qf[1]), "+v"(qf[2]), "+v"(qf[3]));
        int s_cur = 0, s_n1 = 32768, s_n2 = 65536;
        for (int t = 0; t < NT; ++t) {
            if (!(ABL & 16)) {
            if (t + 1 < NT) asm volatile("s_waitcnt vmcnt(4) lgkmcnt(0)\n\ts_barrier" ::: "memory");
            else asm volatile("s_waitcnt vmcnt(0) lgkmcnt(0)\n\ts_barrier" ::: "memory");
            }
            if (t > tlast) { if (t + 2 < NT) dma_tile(t + 2, s_n2); }
            if (t <= tlast) {
                const LAS unsigned char* Kt = lds + s_cur;
                const LAS unsigned char* Vt = lds + s_cur + 16384 + vp0;
#define MFMA32(A_, B_, C_) __builtin_amdgcn_mfma_f32_32x32x16_bf16(A_, B_, C_, 0, 0, 0)
#define VLD(dst, ks) do { _Pragma("unroll") for (int db = 0; db < 4; ++db) { if (!(ABL & 8)) { const s16x4 lo_ = vtr(Vt + db * 4096 + (ks) * 1024), hh_ = vtr(Vt + db * 4096 + (ks) * 1024 + 512); \
                          dst[db] = (bf16x8){lo_[0], lo_[1], lo_[2], lo_[3], hh_[0], hh_[1], hh_[2], hh_[3]}; } else dst[db] = qf[db]; } } while (0)
#define SGB(mask, n) __builtin_amdgcn_sched_group_barrier(mask, n, 0)
#define PVM(P_, V_, O_) do { if (!(ABL & 2)) O_ = MFMA32(__builtin_bit_cast(bf16x8, P_), V_, O_); else asm volatile("" :: "v"(P_), "v"(V_)); } while (0)
                bf16x8 ka[4], kb[4], va[4], vb[4];
#pragma unroll
                for (int d0 = 0; d0 < 4; ++d0) { const int c = map * 8 + 2 * d0 + hi; ka[d0] = *(const LAS bf16x8*)(Kt + koff(r32, c)); kb[d0] = *(const LAS bf16x8*)(Kt + koff(32 + r32, c)); }
                VLD(va, 0);
                f32x16 p0 = negs, p1 = negs;
                __builtin_amdgcn_s_setprio(1);
#pragma unroll
                for (int d0 = 0; d0 < 4; ++d0) { if (!(ABL & 4)) { p0 = MFMA32(ka[d0], qf[d0], p0); p1 = MFMA32(kb[d0], qf[d0], p1); } else { asm volatile("" :: "v"(ka[d0]), "v"(kb[d0])); } }
                __builtin_amdgcn_sched_barrier(0);
                if (!(ABL & 32)) { if (t + 2 < NT) dma_tile(t + 2, s_n2); }
                __builtin_amdgcn_sched_barrier(0);
                float s0 = 0.f, s1 = 0.f;
#pragma unroll
                for (int r = 0; r < 16; ++r) { if (!(ABL & 1)) p0[r] = __builtin_amdgcn_exp2f(p0[r]); s0 += p0[r]; }
                v4u pw0 = (v4u){cvtpk(p0[0], p0[1]), cvtpk(p0[2], p0[3]), cvtpk(p0[4], p0[5]), cvtpk(p0[6], p0[7])};
                v4u pw1 = (v4u){cvtpk(p0[8], p0[9]), cvtpk(p0[10], p0[11]), cvtpk(p0[12], p0[13]), cvtpk(p0[14], p0[15])};
                VLD(vb, 1);
                __builtin_amdgcn_sched_barrier(0);
#pragma unroll
                for (int db = 0; db < 4; ++db) PVM(pw0, va[db], o[db]);
#pragma unroll
                for (int r = 0; r < 16; ++r) { if (!(ABL & 1)) p1[r] = __builtin_amdgcn_exp2f(p1[r]); s1 += p1[r]; }
                v4u pw2 = (v4u){cvtpk(p1[0], p1[1]), cvtpk(p1[2], p1[3]), cvtpk(p1[4], p1[5]), cvtpk(p1[6], p1[7])};
                v4u pw3 = (v4u){cvtpk(p1[8], p1[9]), cvtpk(p1[10], p1[11]), cvtpk(p1[12], p1[13]), cvtpk(p1[14], p1[15])};
                VLD(va, 2);
#pragma unroll
                for (int db = 0; db < 4; ++db) PVM(pw1, vb[db], o[db]);
#pragma unroll
                for (int i = 0; i < 8; ++i) { SGB(0x8, 1); SGB(0x2, 5); SGB(0x100, 1); }
                __builtin_amdgcn_sched_barrier(0);
                VLD(vb, 3);
#pragma unroll
                for (int db = 0; db < 4; ++db) PVM(pw2, va[db], o[db]);
#pragma unroll
                for (int db = 0; db < 4; ++db) PVM(pw3, vb[db], o[db]);
                __builtin_amdgcn_s_setprio(0);
                l_reg += s0 + s1;
#undef MFMA32
#undef VLD
#undef SGB
#undef PVM
            }
            { const int tmp = s_cur; s_cur = s_n1; s_n1 = s_n2; s_n2 = tmp; }
        }
        asm volatile("s_waitcnt lgkmcnt(0)\n\ts_barrier" ::: "memory");
    } else {
        auto tile = [&](int slot, auto half_) {
            constexpr bool halftile = decltype(half_)::value;
            if (wactive) {
                const LAS unsigned char* Kt = lds + slot * 32768;
                const LAS unsigned char* Vt = lds + slot * 32768 + 16384 + vp0;
                f32x16 p0 = negs, p1 = negs;
#pragma unroll
                for (int d0 = 0; d0 < 4; ++d0) {
                    const int c = map * 8 + 2 * d0 + hi;
                    p0 = __builtin_amdgcn_mfma_f32_32x32x16_bf16(*(const LAS bf16x8*)(Kt + koff(r32, c)), qf[d0], p0, 0, 0, 0);
                    if (!halftile) p1 = __builtin_amdgcn_mfma_f32_32x32x16_bf16(*(const LAS bf16x8*)(Kt + koff(32 + r32, c)), qf[d0], p1, 0, 0, 0);
                }
                float s = 0.f;
#pragma unroll
                for (int r = 0; r < 16; ++r) { p0[r] = __builtin_amdgcn_exp2f(p0[r]); s += p0[r]; }
                if (!halftile) {
#pragma unroll
                    for (int r = 0; r < 16; ++r) { p1[r] = __builtin_amdgcn_exp2f(p1[r]); s += p1[r]; }
                }
                l_reg += s;
                v4u pw[4];
                pw[0] = (v4u){cvtpk(p0[0], p0[1]), cvtpk(p0[2], p0[3]), cvtpk(p0[4], p0[5]), cvtpk(p0[6], p0[7])};
                pw[1] = (v4u){cvtpk(p0[8], p0[9]), cvtpk(p0[10], p0[11]), cvtpk(p0[12], p0[13]), cvtpk(p0[14], p0[15])};
                pw[2] = (v4u){cvtpk(p1[0], p1[1]), cvtpk(p1[2], p1[3]), cvtpk(p1[4], p1[5]), cvtpk(p1[6], p1[7])};
                pw[3] = (v4u){cvtpk(p1[8], p1[9]), cvtpk(p1[10], p1[11]), cvtpk(p1[12], p1[13]), cvtpk(p1[14], p1[15])};
#pragma unroll
                for (int db = 0; db < 4; ++db)
#pragma unroll
                    for (int ks = 0; ks < 4; ++ks) {
                        if (ks < 2 || !halftile) {
                            const s16x4 lo = vtr(Vt + db * 4096 + ks * 1024), hh = vtr(Vt + db * 4096 + ks * 1024 + 512);
                            const bf16x8 vf = (bf16x8){lo[0], lo[1], lo[2], lo[3], hh[0], hh[1], hh[2], hh[3]};
                            o[db] = __builtin_amdgcn_mfma_f32_32x32x16_bf16(__builtin_bit_cast(bf16x8, pw[ks]), vf, o[db], 0, 0, 0);
                        }
                    }
            }
        };
        constexpr int NC = PAST / 64;
        if (wave < 2) {
            __syncthreads();
#pragma unroll 1
            for (int t = 0; t < NC; t += 2) { tile(0, std::false_type{}); __syncthreads(); tile(1, std::false_type{}); __syncthreads(); }
            tile(2, std::true_type{});
        } else if (wave < 6) {
            f32x4 ra[16], rb[16];
            { v4u nk[4], nv[4];
              const int ltid = tid - 128;
#pragma unroll
              for (int i = 0; i < 4; ++i) {
                  const int kid = ltid + 256 * i, key = kid >> 4, c = kid & 15;
                  const int pz = lw + 4 * i, vkey = 16 * (pz & 3) + (lane >> 2), vd = 32 * (pz >> 2) + 8 * (lane & 3);
                  nk[i] = *(const v4u*)(Kb + (size_t)(MP + b * DT + (key & 31)) * DM + h * 128 + 8 * c);
                  nv[i] = *(const v4u*)(Vb + (size_t)(MP + b * DT + (vkey & 31)) * DM + h * 128 + vd);
              }
              ldraw(ra, 0); ldraw(rb, 1);
#pragma unroll
              for (int i = 0; i < 4; ++i) {
                  const int kid = ltid + 256 * i;
                  *(LAS v4u*)(lds + 2 * 32768 + koff(kid >> 4, kid & 15)) = nk[i];
                  *(LAS v4u*)(lds + 2 * 32768 + 16384 + (lw + 4 * i) * 1024 + lane * 16) = nv[i];
              } }
            wrraw(ra, 0); ldraw(ra, 2);
            __syncthreads();
#pragma unroll 1
            for (int t = 0; t < NC - 4; t += 2) {
                wrraw(rb, 1); ldraw(rb, t + 3); __syncthreads();
                wrraw(ra, 0); ldraw(ra, t + 4); __syncthreads();
            }
            wrraw(rb, 1); ldraw(rb, NC - 1); __syncthreads();
            wrraw(ra, 0); __syncthreads();
            wrraw(rb, 1); __syncthreads();
            __syncthreads();
        } else {
            __syncthreads();
#pragma unroll 1
            for (int t = 0; t < NC; ++t) __syncthreads();
        }
        __syncthreads();
    }
    unsigned nxt_unit = 0u;
    if (qhead && tid == 0) nxt_unit = __hip_atomic_fetch_add(qhead, 1u, __ATOMIC_RELAXED, __HIP_MEMORY_SCOPE_AGENT);
    LAS float* wsf = (LAS float*)(lds + L_WS) + wave * 64;
    l_reg += __shfl_xor(l_reg, 32);
    if (hi == 0) wsf[r32] = (map == 0 ? 1.0f : -lam) / l_reg;
    LDS_WAIT();
    LAS float* Tw = (LAS float*)(lds + rb * 16896) + hi * 528 + r32;
    const int rowo = row0 + (SAMPLE ? 0 : 32 * rb) + r32;
    v4u gaw[8];
#pragma unroll
    for (int i = 0; i < 8; ++i) gaw[i] = (v4u){0u, 0u, 0u, 0u};
    if (wactive && map == 0) { const bf16_t* gap = GA + (size_t)rowo * DM + h * 128 + 64 * hi;
#pragma unroll
        for (int i = 0; i < 8; ++i) gaw[i] = *(const v4u*)(gap + 8 * i); }
    if (wactive) {
#pragma unroll
        for (int r = 0; r < 16; ++r) { const float inv = wsf[crow(r, hi)];
#pragma unroll
            for (int db = 0; db < 4; ++db) o[db][r] *= inv; }
    }
    if (wactive && map == 1) {
#pragma unroll
        for (int db = 0; db < 4; ++db)
#pragma unroll
            for (int r = 0; r < 16; ++r) Tw[crow(r, 0) * 132 + 32 * db] = o[db][r];
    }
    __syncthreads();
    if (wactive && map == 0) {
#pragma unroll
        for (int db = 0; db < 4; ++db) {
#pragma unroll
            for (int r = 0; r < 16; ++r) o[db][r] += Tw[crow(r, 0) * 132 + 32 * db];
#pragma unroll
            for (int r = 0; r < 16; ++r) Tw[crow(r, 0) * 132 + 32 * db] = o[db][r];
            asm volatile("" ::: "memory");
        }
        f32x4 gsv[16];
        { const LAS float* gs = cst + 64 * hi;
#pragma unroll
          for (int i = 0; i < 16; ++i) gsv[i] = *(const LAS f32x4*)(gs + 4 * i); }
        LDS_WAIT();
        const LAS float* Tr = (const LAS float*)(lds + rb * 16896) + r32 * 132 + 64 * hi;
        float ss = 0.f;
#pragma unroll
        for (int i = 0; i < 16; ++i) { const f32x4 v = *(const LAS f32x4*)(Tr + 4 * i); ss += (v[0] * v[0] + v[1] * v[1]) + (v[2] * v[2] + v[3] * v[3]); }
        ss += __shfl_xor(ss, 32);
        const float rn = __builtin_amdgcn_rsqf(ss * (1.0f / 128.0f) + EPS) * (1.0f - LAM_INIT);
        bf16_t* mp = MIX + (size_t)rowo * 2048 + h * 128 + 64 * hi;
#pragma unroll
        for (int i = 0; i < 8; ++i) {
            const f32x4 v0 = *(const LAS f32x4*)(Tr + 8 * i), v1 = *(const LAS f32x4*)(Tr + 8 * i + 4);
            const v4u gw = gaw[i];
            const f32x4 a0 = (f32x4){__uint_as_float(gw.x << 16), __uint_as_float(gw.x & 0xffff0000u), __uint_as_float(gw.y << 16), __uint_as_float(gw.y & 0xffff0000u)};
            const f32x4 a1 = (f32x4){__uint_as_float(gw.z << 16), __uint_as_float(gw.z & 0xffff0000u), __uint_as_float(gw.w << 16), __uint_as_float(gw.w & 0xffff0000u)};
            const f32x4 r0 = v0 * rn * gsv[2 * i] * a0, r1 = v1 * rn * gsv[2 * i + 1] * a1;
            *(v4u*)(mp + 8 * i) = (v4u){cvtpk(r0[0], r0[1]), cvtpk(r0[2], r0[3]), cvtpk(r1[0], r1[1]), cvtpk(r1[2], r1[3])};
        }
    }
    if (qhead && tid == 0) ((volatile LAS unsigned*)(lds + MISC_OFF))[12] = nxt_unit;
}
}
namespace ret {
using att::cvtpk; using att::vtr;
__device__ __forceinline__ int ioff(int row, int ch) { return 256 * row + 16 * (ch ^ (((row & 3) << 2) | ((row >> 2) & 3))); }
__device__ __forceinline__ v4u scale8(const v4u w, float s) {
    v4u o;
    o.x = cvtpk(__uint_as_float(w.x << 16) * s, __uint_as_float(w.x & 0xffff0000u) * s); o.y = cvtpk(__uint_as_float(w.y << 16) * s, __uint_as_float(w.y & 0xffff0000u) * s);
    o.z = cvtpk(__uint_as_float(w.z << 16) * s, __uint_as_float(w.z & 0xffff0000u) * s); o.w = cvtpk(__uint_as_float(w.w << 16) * s, __uint_as_float(w.w & 0xffff0000u) * s);
    return o;
}
__device__ __forceinline__ bf16x8 mk8(const s16x4 a, const s16x4 b) { return (bf16x8){a[0], a[1], a[2], a[3], b[0], b[1], b[2], b[3]}; }
__device__ __forceinline__ bf16x8 mk8u(const v2u a, const v2u b) { const v4u w = (v4u){a.x, a.y, b.x, b.y}; return __builtin_bit_cast(bf16x8, w); }

template <bool SAMPLE>
__device__ __forceinline__ void ret_unit(const Args& a, LAS unsigned char* lds, int b, int h) {
    unsigned char* ws = a.ws;
    const bf16_t *QR = (const bf16_t*)(ws + WS_QR), *KR = (const bf16_t*)(ws + WS_KR), *VR = (const bf16_t*)(ws + WS_VR), *GS = (const bf16_t*)(ws + WS_GS), *GR = (const bf16_t*)(ws + WS_GR);
    bf16_t* MIX = (bf16_t*)(ws + WS_MIX);
    const float* grn = a.in[14];
    constexpr int T = SAMPLE ? DT : 64, NCH = SAMPLE ? 1 : 64;
    constexpr int IMG = 32768, P_IN = 65536, P_O = 81920;
    int tid_ = threadIdx.x; asm volatile("" : "+v"(tid_));
    const int tid = tid_, lane = tid & 63, l15 = lane & 15, fq = lane >> 4;
    const int w = __builtin_amdgcn_readfirstlane(tid >> 6);
    const float lg2 = log1pf(-exp2f(-5.0f - (float)h)) * LOG2E;
    const float cd = __builtin_amdgcn_exp2f(lg2 * (float)T);
    const float ginvT = __builtin_amdgcn_exp2f(-lg2 * (float)T);

    f32x4 S[4];
    { const float* sp = a.in[4] + ((size_t)(b * NH + h) * 64) * 128 + 16 * w + l15;
#pragma unroll
      for (int blk = 0; blk < 4; ++blk)
#pragma unroll
          for (int r = 0; r < 4; ++r) S[blk][r] = SAMPLE ? sp[(size_t)(16 * blk + 4 * fq + r) * 128] : 0.f; }

    const int stok = tid >> 3, sc8 = tid & 7;
    v4u qreg, kreg, vreg[2], gsr[2], grr[2];
    auto stage_load = [&](int c) {
        const int row = (SAMPLE ? MP + b * DT : b * SEQ + c * 64) + (SAMPLE ? (stok & 31) : stok);
        qreg = *(const v4u*)(QR + (size_t)row * 512 + h * 64 + 8 * sc8);
        kreg = *(const v4u*)(KR + (size_t)row * 512 + h * 64 + 8 * sc8);
        vreg[0] = *(const v4u*)(VR + (size_t)row * DM + h * 128 + 16 * sc8);
        vreg[1] = *(const v4u*)(VR + (size_t)row * DM + h * 128 + 16 * sc8 + 8);
    };
    auto gate_load = [&](int c) {
        const int row = (SAMPLE ? MP + b * DT : b * SEQ + c * 64) + (SAMPLE ? (stok & 31) : stok);
        gsr[0] = *(const v4u*)(GS + (size_t)row * DM + h * 128 + 16 * sc8); gsr[1] = *(const v4u*)(GS + (size_t)row * DM + h * 128 + 16 * sc8 + 8);
        grr[0] = *(const v4u*)(GR + (size_t)row * DM + h * 128 + 16 * sc8); grr[1] = *(const v4u*)(GR + (size_t)row * DM + h * 128 + 16 * sc8 + 8);
    };
    const float qd = __builtin_amdgcn_exp2f(lg2 * (float)(stok + 1)), kd = __builtin_amdgcn_exp2f(lg2 * (float)(T - 1 - stok));
    auto stage_write = [&](int buf) {
        const bool valid = stok < T;
        const v4u z = (v4u){0u, 0u, 0u, 0u};
        LAS unsigned char* im = lds + buf * IMG;
        *(LAS v4u*)(im + ioff(stok, sc8)) = valid ? scale8(qreg, qd) : z;
        *(LAS v4u*)(im + ioff(stok, 8 + sc8)) = valid ? scale8(kreg, kd) : z;
        *(LAS v4u*)(im + 16384 + ioff(stok, 2 * sc8)) = valid ? vreg[0] : z;
        *(LAS v4u*)(im + 16384 + ioff(stok, 2 * sc8 + 1)) = valid ? vreg[1] : z;
    };
    const int tq = (lane & 15) >> 2, tp = lane & 3;
    int vrel[2][2], krow[2][2];
#pragma unroll
    for (int s = 0; s < 2; ++s)
#pragma unroll
        for (int hf = 0; hf < 2; ++hf) { const int row = 32 * s + 8 * fq + tq + 4 * hf;
            vrel[s][hf] = 16384 + ioff(row, 2 * w + (tp >> 1)) + 8 * (tp & 1);
            krow[s][hf] = row; }
    f32x4 n0, n1, n2, n3;
    { const float* gp = grn + h * 128 + 16 * sc8; n0 = *(const f32x4*)gp; n1 = *(const f32x4*)(gp + 4); n2 = *(const f32x4*)(gp + 8); n3 = *(const f32x4*)(gp + 12); }
    stage_load(0);
    __syncthreads();
    stage_write(0);
    if (NCH > 1) stage_load(1);
    gate_load(0);
    LBAR();
    for (int c = 0; c < NCH; ++c) {
        const int row0 = SAMPLE ? MP + b * DT : b * SEQ + c * 64;
        const LAS unsigned char* im = lds + (c & 1) * IMG;
#pragma unroll
        for (int bi = 0; bi < 2; ++bi) {
            const int blk = 2 * w + bi, ib = blk >> 2, jb = blk & 3;
            f32x4 d = (f32x4){0.f, 0.f, 0.f, 0.f};
            if (jb <= ib) {
#pragma unroll
                for (int s = 0; s < 2; ++s) {
                    const bf16x8 kf = *(const LAS bf16x8*)(im + ioff(16 * jb + l15, 8 + 4 * s + fq));
                    const bf16x8 qf = *(const LAS bf16x8*)(im + ioff(16 * ib + l15, 4 * s + fq));
                    d = __builtin_amdgcn_mfma_f32_16x16x32_bf16(kf, qf, d, 0, 0, 0);
                }
                const int ti = 16 * ib + l15, tj0 = 16 * jb + 4 * fq;
#pragma unroll
                for (int r = 0; r < 4; ++r) d[r] = (ti - (tj0 + r) >= 0) ? d[r] * ginvT : 0.f;
            }
            *(LAS v2u*)(lds + P_IN + ioff(16 * ib + l15, 2 * jb + (fq >> 1)) + 8 * (fq & 1)) = (v2u){cvtpk(d[0], d[1]), cvtpk(d[2], d[3])};
        }
        bf16x8 vf[2];
#pragma unroll
        for (int s = 0; s < 2; ++s) vf[s] = mk8(vtr(im + vrel[s][0]), vtr(im + vrel[s][1]));
        f32x4 o[4];
        { bf16x8 sf[2];
#pragma unroll
          for (int s = 0; s < 2; ++s) { const v4u wv = (v4u){cvtpk(S[2 * s][0], S[2 * s][1]), cvtpk(S[2 * s][2], S[2 * s][3]), cvtpk(S[2 * s + 1][0], S[2 * s + 1][1]), cvtpk(S[2 * s + 1][2], S[2 * s + 1][3])};
              sf[s] = __builtin_bit_cast(bf16x8, wv); }
#pragma unroll
          for (int tb = 0; tb < 4; ++tb) { o[tb] = (f32x4){0.f, 0.f, 0.f, 0.f};
#pragma unroll
              for (int s = 0; s < 2; ++s) {
                  const int row = 16 * tb + l15;
                  const v2u q0 = *(const LAS v2u*)(im + ioff(row, 4 * s + (fq >> 1)) + 8 * (fq & 1));
                  const v2u q1 = *(const LAS v2u*)(im + ioff(row, 4 * s + 2 + (fq >> 1)) + 8 * (fq & 1));
                  o[tb] = __builtin_amdgcn_mfma_f32_16x16x32_bf16(mk8u(q0, q1), sf[s], o[tb], 0, 0, 0);
              } } }
#pragma unroll
        for (int blk = 0; blk < 4; ++blk) { S[blk] = S[blk] * cd;
#pragma unroll
            for (int s = 0; s < 2; ++s) {
                const bf16x8 kdf = mk8(vtr(im + ioff(krow[s][0], 8 + 2 * blk + (tp >> 1)) + 8 * (tp & 1)), vtr(im + ioff(krow[s][1], 8 + 2 * blk + (tp >> 1)) + 8 * (tp & 1)));
                S[blk] = __builtin_amdgcn_mfma_f32_16x16x32_bf16(kdf, vf[s], S[blk], 0, 0, 0);
            } }
        if (c + 1 < NCH) { stage_write((c + 1) & 1); if (c + 2 < NCH) stage_load(c + 2); }
        LBAR();
#pragma unroll
        for (int tb = 0; tb < 4; ++tb)
#pragma unroll
            for (int s = 0; s < 2; ++s) {
                const bf16x8 inf = *(const LAS bf16x8*)(lds + P_IN + ioff(16 * tb + l15, 4 * s + fq));
                o[tb] = __builtin_amdgcn_mfma_f32_16x16x32_bf16(inf, vf[s], o[tb], 0, 0, 0);
            }
        { LAS float* Os = (LAS float*)(lds + P_O) + (4 * fq) * 132 + 16 * w + l15;
#pragma unroll
          for (int tb = 0; tb < 4; ++tb)
#pragma unroll
              for (int r = 0; r < 4; ++r) Os[(16 * tb + r) * 132] = o[tb][r]; }
        LBAR();
        { const int tok = tid >> 3, seg = tid & 7;
          const LAS float* Or = (const LAS float*)(lds + P_O) + tok * 132 + 16 * seg;
          f32x4 v[4]; float ss = 0.f;
#pragma unroll
          for (int i = 0; i < 4; ++i) { v[i] = *(const LAS f32x4*)(Or + 4 * i); ss += (v[i][0] * v[i][0] + v[i][1] * v[i][1]) + (v[i][2] * v[i][2] + v[i][3] * v[i][3]); }
          ss += __shfl_xor(ss, 1); ss += __shfl_xor(ss, 2); ss += __shfl_xor(ss, 4);
          const float rn = __builtin_amdgcn_rsqf(ss * (1.0f / 128.0f) + EPS);
          if (tok < T) {
              const size_t row = (size_t)(row0 + tok); const int cc = h * 128 + 16 * seg;
              const v4u gs0 = gsr[0], gs1 = gsr[1], gr0 = grr[0], gr1 = grr[1];
#define BF4(wd, hf) ((f32x4){__uint_as_float(((hf) ? (wd).z : (wd).x) << 16), __uint_as_float(((hf) ? (wd).z : (wd).x) & 0xffff0000u), __uint_as_float(((hf) ? (wd).w : (wd).y) << 16), __uint_as_float(((hf) ? (wd).w : (wd).y) & 0xffff0000u)})
              const f32x4 r0 = v[0] * rn * n0 * BF4(gs0, 0) * BF4(gr0, 0), r1 = v[1] * rn * n1 * BF4(gs0, 1) * BF4(gr0, 1);
              const f32x4 r2 = v[2] * rn * n2 * BF4(gs1, 0) * BF4(gr1, 0), r3 = v[3] * rn * n3 * BF4(gs1, 1) * BF4(gr1, 1);
#undef BF4
              bf16_t* mp = MIX + row * 2048 + 1024 + cc;
              *(v4u*)mp = (v4u){cvtpk(r0[0], r0[1]), cvtpk(r0[2], r0[3]), cvtpk(r1[0], r1[1]), cvtpk(r1[2], r1[3])};
              *(v4u*)(mp + 8) = (v4u){cvtpk(r2[0], r2[1]), cvtpk(r2[2], r2[3]), cvtpk(r3[0], r3[1]), cvtpk(r3[2], r3[3])};
          }
          if (c + 1 < NCH) gate_load(c + 1); }
    }
    { float* op = a.out + (SAMPLE ? O_NRS : O_NRP) + ((size_t)(b * NH + h) * 64) * 128 + 16 * w + l15;
#pragma unroll
      for (int blk = 0; blk < 4; ++blk)
#pragma unroll
          for (int r = 0; r < 4; ++r) op[(size_t)(16 * blk + 4 * fq + r) * 128] = S[blk][r]; }
}
}
__device__ __forceinline__ int p2_pop(gu32* qhead, volatile LAS unsigned* MISC) {
    __syncthreads();
    if (threadIdx.x == 0) MISC[12] = __hip_atomic_fetch_add(qhead, 1u, __ATOMIC_RELAXED, __HIP_MEMORY_SCOPE_AGENT);
    __syncthreads();
    return (int)MISC[12];
}
__device__ __forceinline__ void p2_mixers(const Args& a, LAS unsigned char* lds, int rep) {
    constexpr int E_RP = 32, E_AP = E_RP + 1024, E_AS = E_AP + 256, E_RS = E_AS + 256, E_LW = E_RS + LW_ITEMS / 32;
    gu32* qhead = (gu32*)(a.ws + WS_CTL) + CW_QUEUE + 64 * rep;
    volatile LAS unsigned* MISC = (volatile LAS unsigned*)(lds + MISC_OFF);
    { LAS float* cst = (LAS float*)(lds + att::L_CONST);
      if (threadIdx.x < 128) cst[threadIdx.x] = a.in[13][threadIdx.x];
      if (threadIdx.x < 2) cst[128 + threadIdx.x] = ((const float*)(a.ws + WS_SC))[threadIdx.x];
      __syncthreads(); }
#ifdef PROBE_P2SUB
    if (rep == 1) {
        int r = p2_pop(qhead, MISC);
        if (PROBE_P2SUB == 1) while (r < 32) { ret::ret_unit<false>(a, lds, r >> 3, r & 7); r = p2_pop(qhead, MISC); }
#ifndef PROBE_ABL
#define PROBE_ABL 0
#endif
        if (PROBE_P2SUB == 2) while (r < 1024) { const int qb = 31 - (r >> 5), bh = r & 31; att::attn_unit<false, PROBE_ABL>(a, lds, bh >> 3, bh & 7, qb, (bf16_t*)(a.ws + WS_NS1)); r = p2_pop(qhead, MISC); }
        if (PROBE_P2SUB == 3) while (r < 256) { att::attn_unit<true>(a, lds, r >> 3, r & 7, 0); r = p2_pop(qhead, MISC); }
        if (PROBE_P2SUB == 5) while (r < 32) { att::attn_unit<true>(a, lds, r >> 3, r & 7, 0); r = p2_pop(qhead, MISC); }
        if (PROBE_P2SUB == 4) while (r < 256) { ret::ret_unit<true>(a, lds, r >> 3, r & 7); r = p2_pop(qhead, MISC); }
        return;
    }
#endif
    constexpr int F_RP = 32, F_AP = F_RP + 1024, F_LW = F_AP + LW_ITEMS / 32, F_RS = F_LW + 256, F_AS = F_RS + 256;
    int r = p2_pop(qhead, MISC);
    while (r < F_RP) { ret::ret_unit<false>(a, lds, r >> 3, r & 7); r = p2_pop(qhead, MISC); }
    asm volatile("" ::: "memory");
    while (r < F_AP) { const int pu = r - F_RP, qb = 31 - (pu >> 5), bh = pu & 31; att::attn_unit<false>(a, lds, bh >> 3, bh & 7, qb, nullptr, qhead); __syncthreads(); r = (int)MISC[12]; }
    asm volatile("" ::: "memory");
    {
        const int lw_wave = __builtin_amdgcn_readfirstlane(threadIdx.x >> 6);
        LAS float* scr = (LAS float*)(lds + lw_wave * 16384);
        while (r < F_LW) { const int u = r - F_AP;
            if (rep == 0) {
#pragma unroll 1
                for (int i = 0; i < 4; ++i) late_weight_item(a, u * 32 + i * 8 + lw_wave, scr, threadIdx.x & 63); }
            r = p2_pop(qhead, MISC); }
    }
    asm volatile("" ::: "memory");
    while (r < F_RS) { const int u = r - F_LW; ret::ret_unit<true>(a, lds, u >> 3, u & 7); r = p2_pop(qhead, MISC); }
    asm volatile("" ::: "memory");
    while (r < F_AS) { const int g = r - F_RS; att::attn_unit<true>(a, lds, g >> 3, g & 7, 0); r = p2_pop(qhead, MISC); }
}
namespace sg {
__device__ __forceinline__ int logical_col(int p) { return (p & ~255) + 64 * ((p >> 5) & 3) + 32 * ((p >> 7) & 1) + (p & 31); }

template <class Epi>
__device__ __forceinline__ void sgemm_phase(LAS unsigned char* lds, const bf16_t* A  , const bf16_t* Wt, int K, int bx, int G, const Epi& E) {
    int t_ = threadIdx.x; asm volatile("" : "+v"(t_));
    const int tid = t_, lane = tid & 63, l15 = lane & 15, fq = lane >> 4, w = __builtin_amdgcn_readfirstlane(tid >> 6), wr = w >> 1, wc = w & 1;
    const int lds0 = (int)(size_t)lds;
    const int nkb = K / 128;
    for (int tile = bx; tile < 256; tile += G) {
        const int r0 = (tile >> 4) * 64, c0 = (tile & 15) * 64;
        auto dma_blk = [&](int kb, int slot_off) {
#pragma unroll
            for (int i = 0; i < 2; ++i) {
                const int kid = tid + 512 * i, row = kid >> 4, cl = kid & 15, csrc = cl ^ (((row & 3) << 2) | ((row >> 2) & 3));
                att::glds16(A + (size_t)(r0 + row) * K + kb * 128 + 8 * csrc, (unsigned)__builtin_amdgcn_readfirstlane(lds0 + slot_off + w * 1024 + i * 8192));
                att::glds16(Wt + (size_t)(c0 + row) * K + kb * 128 + 8 * csrc, (unsigned)__builtin_amdgcn_readfirstlane(lds0 + slot_off + 16384 + w * 1024 + i * 8192));
            }
        };
        f32x4 acc[2] = {(f32x4){0.f, 0.f, 0.f, 0.f}, (f32x4){0.f, 0.f, 0.f, 0.f}};
        asm volatile("s_waitcnt lgkmcnt(0)\n\ts_barrier" ::: "memory");
        dma_blk(0, 0); dma_blk(1, 32768);
        int s_cur = 0, s_n1 = 32768, s_n2 = 65536;
        for (int kb = 0; kb < nkb; ++kb) {
            if (kb + 1 < nkb) asm volatile("s_waitcnt vmcnt(4) lgkmcnt(0)\n\ts_barrier" ::: "memory");
            else asm volatile("s_waitcnt vmcnt(0) lgkmcnt(0)\n\ts_barrier" ::: "memory");
            if (kb + 2 < nkb) dma_blk(kb + 2, s_n2);
            const LAS unsigned char* Ai = lds + s_cur; const LAS unsigned char* Bi = lds + s_cur + 16384;
#pragma unroll
            for (int st = 0; st < 4; ++st) {
                const bf16x8 fa = *(const LAS bf16x8*)(Ai + ret::ioff(16 * wr + l15, 4 * st + fq));
                const bf16x8 fb0 = *(const LAS bf16x8*)(Bi + ret::ioff(32 * wc + l15, 4 * st + fq));
                const bf16x8 fb1 = *(const LAS bf16x8*)(Bi + ret::ioff(32 * wc + 16 + l15, 4 * st + fq));
                acc[0] = __builtin_amdgcn_mfma_f32_16x16x32_bf16(fb0, fa, acc[0], 0, 0, 0);
                acc[1] = __builtin_amdgcn_mfma_f32_16x16x32_bf16(fb1, fa, acc[1], 0, 0, 0);
            }
            { const int tmp = s_cur; s_cur = s_n1; s_n1 = s_n2; s_n2 = tmp; }
        }
        const int row = MP + r0 + 16 * wr + l15, p0 = c0 + 32 * wc + 4 * fq;
        E(row, logical_col(p0), acc[0], logical_col(p0 + 16), acc[1], fq);
    }
    asm volatile("s_waitcnt lgkmcnt(0)\n\ts_barrier" ::: "memory");
}

struct EpiStoreBf16 {
    bf16_t* O;
    __device__ __forceinline__ void operator()(int row, int c0, const f32x4 a0, int c1, const f32x4 a1, int) const {
        *(v2u*)(O + (size_t)row * DM + c0) = (v2u){att::cvtpk(a0[0], a0[1]), att::cvtpk(a0[2], a0[3])};
        *(v2u*)(O + (size_t)row * DM + c1) = (v2u){att::cvtpk(a1[0], a1[1]), att::cvtpk(a1[2], a1[3])};
    }
};
struct EpiResid {
    const float* base; float* Xo; bf16_t* Xg; const float* g; float* SS;
    __device__ __forceinline__ void operator()(int row, int c0, const f32x4 a0, int c1, const f32x4 a1, int fq) const {
        const size_t o0 = (size_t)row * DM + c0, o1 = (size_t)row * DM + c1;
        const f32x4 x0 = *(const f32x4*)(base + o0) + a0, x1 = *(const f32x4*)(base + o1) + a1;
        float ss = (x0[0] * x0[0] + x0[1] * x0[1]) + (x0[2] * x0[2] + x0[3] * x0[3]) + (x1[0] * x1[0] + x1[1] * x1[1]) + (x1[2] * x1[2] + x1[3] * x1[3]);
        *(f32x4*)(Xo + o0) = x0; *(f32x4*)(Xo + o1) = x1;
        const f32x4 g0 = *(const f32x4*)(g + c0), g1 = *(const f32x4*)(g + c1), y0 = x0 * g0, y1 = x1 * g1;
        *(v2u*)(Xg + o0) = (v2u){att::cvtpk(y0[0], y0[1]), att::cvtpk(y0[2], y0[3])};
        *(v2u*)(Xg + o1) = (v2u){att::cvtpk(y1[0], y1[1]), att::cvtpk(y1[2], y1[3])};
        ss += __shfl_xor(ss, 16); ss += __shfl_xor(ss, 32);
        if (fq == 0) atomicAdd(SS + row, ss);
    }
};
struct EpiFinal {
    const float* SS; const bf16_t* T; const float* y; float* yo;
    __device__ __forceinline__ void operator()(int row, int c0, const f32x4 a0, int c1, const f32x4 a1, int) const {
        const float r = __builtin_amdgcn_rsqf(SS[row] * (1.0f / DM) + EPS);
        const size_t o0 = (size_t)row * DM + c0, o1 = (size_t)row * DM + c1;
        const v2u t0 = *(const v2u*)(T + o0), t1 = *(const v2u*)(T + o1);
        const f32x4 tf0 = (f32x4){__uint_as_float(t0.x << 16), __uint_as_float(t0.x & 0xffff0000u), __uint_as_float(t0.y << 16), __uint_as_float(t0.y & 0xffff0000u)};
        const f32x4 tf1 = (f32x4){__uint_as_float(t1.x << 16), __uint_as_float(t1.x & 0xffff0000u), __uint_as_float(t1.y << 16), __uint_as_float(t1.y & 0xffff0000u)};
        *(f32x4*)(yo + o0) = *(const f32x4*)(y + o0) + pg8::sig4(a0 * r) * tf0;
        *(f32x4*)(yo + o1) = *(const f32x4*)(y + o1) + pg8::sig4(a1 * r) * tf1;
    }
};
}
#ifndef PG8_SP2
#define PG8_SP2 true
#endif
#ifndef PG8_ALIGN
#define PG8_ALIGN true
#endif
__global__ void __launch_bounds__(NTHREADS, 2) fwd(Args args) {
    extern __shared__ __attribute__((aligned(16))) unsigned char lds_raw[];
    LAS unsigned char* lds = (LAS unsigned char*)lds_raw;
    volatile LAS unsigned* MISC = (volatile LAS unsigned*)(lds + MISC_OFF);
    const int tid = threadIdx.x, lane = tid & 63, wave = __builtin_amdgcn_readfirstlane(tid >> 6);
    const int G = gridDim.x, bx = blockIdx.x;
    const int vcu = (G % 8 == 0) ? (bx % 8) * (G / 8) + bx / 8 : bx;
    gu32* ctl = (gu32*)(args.ws + WS_CTL);
    for (int u = tid; u < (LDS_BYTES - LDSCTL_OFF) / 4; u += NTHREADS) ((LAS unsigned*)(lds + LDSCTL_OFF))[u] = 0u;
    __syncthreads();
    const int lo = args.ph_lo, hi = args.ph_hi;
    const bool multi = (hi - lo) > 1;
    XcdBarrier bar; bar.bar = (unsigned*)ctl + CW_BAR + args.li * XCD_BAR_WORDS; bar.x = 0; bar.st = nullptr;
    if (multi) bar = xcd_barrier_post((unsigned*)ctl + CW_BAR + args.li * XCD_BAR_WORDS, MISC + 8);
#ifndef PHASE_MASK
#define PHASE_MASK 0x7f
#endif
#define WSB(T_, off) ((T_*)(args.ws + (off)))
#define IN(k) (((PHASE_MASK >> (k)) & 1) && lo <= (k) && (k) < hi)
#define SEAM(k) do { if (IN(k) && IN((k) + 1)) xcd_barrier(bar); } while (0)
#ifndef PROBE_REP
#define PROBE_REP (-1)
#endif
#define PHASE(k, ...) do { if (IN(k)) { { constexpr int rep = 0; (void)rep; __VA_ARGS__ } if (PROBE_REP == (k)) { xcd_barrier(bar); { constexpr int rep = 1; (void)rep; __VA_ARGS__ } } } } while (0)
    PHASE(0, { p0_prologue(args, lds, vcu * NWAVES + wave, G * NWAVES, lane); });
    SEAM(0);
    PHASE(1, {
        { pg8::Gemm g{WSB(bf16_t, WS_H), WSB(const bf16_t, WS_WIN), M, NIN, DM}; pg8::StaticOrder S; S.init(M, NIN, G, bx);
          pg8::EpiInProj E{args.in[9], args.in[10], args.out, args.ws, args.fc};
          pg8::gemm_phase<pg8::EpiInProj, pg8::StaticOrder, PG8_ALIGN, PG8_SP2>(lds + RING_OFF, g, S, E); }
        asm volatile("" ::: "memory");
        if (G != 256 || bx >= 128) {
          pg8::Gemm g{WSB(bf16_t, WS_PB), WSB(const bf16_t, WS_WPL), MP, DM, PLE}; pg8::StaticOrder S; S.init(MP, DM, G == 256 ? 128 : G, G == 256 ? (bx & 127) : bx);
          pg8::EpiStoreBf16 E{WSB(bf16_t, WS_T)};
          pg8::gemm_phase<pg8::EpiStoreBf16, pg8::StaticOrder, PG8_ALIGN, PG8_SP2>(lds + RING_OFF, g, S, E); }
        { sg::EpiStoreBf16 E{WSB(bf16_t, WS_T)}; sg::sgemm_phase(lds + RING_OFF, WSB(const bf16_t, WS_PB) + (size_t)MP * PLE, WSB(const bf16_t, WS_WPL), PLE, bx, G, E); }
    });
    SEAM(1);
    PHASE(2, { p2_mixers(args, lds, rep); });
    SEAM(2);
    PHASE(3, {
        { pg8::Gemm g{WSB(bf16_t, WS_MIX), WSB(const bf16_t, WS_WO), MP, DM, 2048}; pg8::StaticOrder S; S.init(MP, DM, G, bx);
          pg8::EpiResid E{args.in[0], args.in[1], WSB(float, WS_X1), WSB(bf16_t, WS_X1G), args.in[16], WSB(float, WS_SS + rep * 256 * 1024)};
          pg8::gemm_phase<pg8::EpiResid, pg8::StaticOrder, PG8_ALIGN, PG8_SP2>(lds + RING_OFF, g, S, E); }
        { sg::EpiResid E{args.in[1] - (size_t)MP * DM, WSB(float, WS_X1), WSB(bf16_t, WS_X1G), args.in[16], WSB(float, WS_SS + rep * 256 * 1024)};
          sg::sgemm_phase(lds + RING_OFF, WSB(const bf16_t, WS_MIX) + (size_t)MP * 2048, WSB(const bf16_t, WS_WO), 2048, bx, G, E); }
    });
    SEAM(3);
    PHASE(4, {
        pg8::Gemm g{WSB(bf16_t, WS_X1G), WSB(const bf16_t, WS_WGU), M, 2 * DFF, DM}; pg8::StaticOrder S; S.init(M, 2 * DFF, G, bx);
        pg8::EpiGateUp E{WSB(const float, WS_SS), WSB(bf16_t, WS_HID)};
        pg8::gemm_phase<pg8::EpiGateUp, pg8::StaticOrder, PG8_ALIGN, PG8_SP2>(lds + RING_OFF, g, S, E);
    });
    SEAM(4);
    PHASE(5, {
        { pg8::Gemm g{WSB(bf16_t, WS_HID), WSB(const bf16_t, WS_WDN), MP, DM, DFF}; pg8::StaticOrder S; S.init(MP, DM, G, bx);
          pg8::EpiResid E{WSB(const float, WS_X1), WSB(const float, WS_X1) + (size_t)MP * DM, args.out + O_Y, WSB(bf16_t, WS_X2G), args.in[20], WSB(float, WS_SS + 128 * 1024 + rep * 256 * 1024)};
          pg8::gemm_phase<pg8::EpiResid, pg8::StaticOrder, PG8_ALIGN, PG8_SP2>(lds + RING_OFF, g, S, E); }
        { sg::EpiResid E{WSB(const float, WS_X1), args.out + O_Y, WSB(bf16_t, WS_X2G), args.in[20], WSB(float, WS_SS + 128 * 1024 + rep * 256 * 1024)};
          sg::sgemm_phase(lds + RING_OFF, WSB(const bf16_t, WS_HID) + (size_t)MP * DFF, WSB(const bf16_t, WS_WDN), DFF, bx, G, E); }
    });
    SEAM(5);
#ifndef PROBE_P6SUB
#define PROBE_P6SUB 3
#endif
    if (PROBE_REP == 6 && IN(6)) {
        if (PROBE_P6SUB & 1) { pg8::Gemm g{WSB(bf16_t, WS_X2G), WSB(const bf16_t, WS_WPG), MP, DM, DM}; pg8::StaticOrder S; S.init(MP, DM, G, bx);
          pg8::EpiFinal E{WSB(const float, WS_SS + 128 * 1024), WSB(const bf16_t, WS_T), args.out + O_Y, WSB(float, WS_NS1)};
          pg8::gemm_phase<pg8::EpiFinal, pg8::StaticOrder, PG8_ALIGN, PG8_SP2>(lds + RING_OFF, g, S, E); }
        if (PROBE_P6SUB & 2) { sg::EpiFinal E{WSB(const float, WS_SS + 128 * 1024), WSB(const bf16_t, WS_T), args.out + O_Y, WSB(float, WS_NS1)};
          sg::sgemm_phase(lds + RING_OFF, WSB(const bf16_t, WS_X2G) + (size_t)MP * DM, WSB(const bf16_t, WS_WPG), DM, bx, G, E); }
        xcd_barrier(bar);
    }
    if (IN(6)) {
        { pg8::Gemm g{WSB(bf16_t, WS_X2G), WSB(const bf16_t, WS_WPG), MP, DM, DM}; pg8::StaticOrder S; S.init(MP, DM, G, bx);
          pg8::EpiFinal E{WSB(const float, WS_SS + 128 * 1024), WSB(const bf16_t, WS_T), args.out + O_Y, args.out + O_Y};
          pg8::gemm_phase<pg8::EpiFinal, pg8::StaticOrder, PG8_ALIGN, PG8_SP2>(lds + RING_OFF, g, S, E); }
        { sg::EpiFinal E{WSB(const float, WS_SS + 128 * 1024), WSB(const bf16_t, WS_T), args.out + O_Y, args.out + O_Y};
          sg::sgemm_phase(lds + RING_OFF, WSB(const bf16_t, WS_X2G) + (size_t)MP * DM, WSB(const bf16_t, WS_WPG), DM, bx, G, E); }
    }
#undef PHASE
#undef IN
#undef SEAM
}
extern "C" void kernel_launch(void* const* d_in, const int* in_sizes, int n_in, void* d_out, int out_size, void* d_ws, size_t ws_size, hipStream_t stream) {
    static int grid = 0;
    if (grid == 0) {
        if (n_in != 23 || out_size != (int)O_END || ws_size < WS_END) { fprintf(stderr, "kernel_launch: unexpected sizes n_in %d out %d ws %zu\n", n_in, out_size, ws_size); grid = -1; return; }
        int dev = 0, cus = 0;
        if (hipGetDevice(&dev) != hipSuccess || hipDeviceGetAttribute(&cus, hipDeviceAttributeMultiprocessorCount, dev) != hipSuccess) { grid = -1; return; }
        if (hipFuncSetAttribute((const void*)fwd, hipFuncAttributeMaxDynamicSharedMemorySize, LDS_BYTES) != hipSuccess) { fprintf(stderr, "kernel_launch: hipFuncSetAttribute failed\n"); grid = -1; return; }
        grid = cus;
    }
    if (grid < 0) return;
    Args a{};
    for (int i = 0; i < 23; ++i) a.in[i] = (const float*)d_in[i];
    a.out = (float*)d_out; a.ws = (unsigned char*)d_ws; a.ph_lo = 0; a.ph_hi = 7; a.li = 0; a.fc = -1;
    (void)hipMemsetAsync((unsigned char*)d_ws + WS_CTL, 0, CTL_ZERO_BYTES, stream);
#ifdef PROBE_LAUNCH_BASE
    a.ph_hi = 2; hipLaunchKernelGGL(fwd, dim3(grid), dim3(NTHREADS), LDS_BYTES, stream, a);
    a.ph_lo = 2; a.ph_hi = 7; a.li = 2; hipLaunchKernelGGL(fwd, dim3(grid), dim3(NTHREADS), LDS_BYTES, stream, a);
#elif defined(PROBE_LAUNCH_P1)
    a.ph_hi = 2; hipLaunchKernelGGL(fwd, dim3(grid), dim3(NTHREADS), LDS_BYTES, stream, a);
    a.ph_lo = 1; a.ph_hi = 2; a.li = 1; a.fc = PROBE_LAUNCH_P1; hipLaunchKernelGGL(fwd, dim3(grid), dim3(NTHREADS), LDS_BYTES, stream, a);
    a.ph_lo = 2; a.ph_hi = 7; a.li = 2; a.fc = -1; hipLaunchKernelGGL(fwd, dim3(grid), dim3(NTHREADS), LDS_BYTES, stream, a);
#else
    hipLaunchKernelGGL(fwd, dim3(grid), dim3(NTHREADS), LDS_BYTES, stream, a);
#endif
}
```

```cpp
#include <hip/hip_runtime.h>
#include <cstdint>
#include <cstdio>
#include <type_traits>

typedef unsigned short bf16_t;

constexpr int DM = 1024, SEQ = 4096, NB = 4, MP = NB * SEQ;
constexpr int DB = 32, DT = 32, MS = DB * DT, PAST = 2048;
constexpr int M = MP + MS;
constexpr int NIN = 8192, DFF = 2816, PLE = 256, NH = 8;
constexpr float EPS = 1e-6f;
constexpr float LAM_INIT = 0.2f;
constexpr float LOG2E = 1.4426950408889634f;
constexpr float QSCALE = 0.125f * LOG2E;

constexpr size_t O_Y = 0, O_NKP = 17825792, O_NVP = 34603008, O_NRP = 51380224, O_NKS = 51642368, O_NVS = 52690944, O_NRS = 53739520, O_END = 55836672;

constexpr size_t MiB = 1u << 20;
constexpr size_t WS_CTL = 0;
constexpr size_t WS_SC = 512 * 1024;
constexpr size_t WS_ROPE = 1 * MiB;
constexpr size_t WS_WIN = 4 * MiB;
constexpr size_t WS_WO = 20 * MiB;
constexpr size_t WS_WGU = 24 * MiB;
constexpr size_t WS_WDN = 35 * MiB;
constexpr size_t WS_WPG = 41 * MiB;
constexpr size_t WS_WPL = 43 * MiB;
constexpr size_t WS_H = 44 * MiB;
constexpr size_t WS_PB = 78 * MiB;
constexpr size_t WS_Q = 87 * MiB;
constexpr size_t WS_KB = 121 * MiB;
constexpr size_t WS_VB = 155 * MiB;
constexpr size_t WS_QR = 189 * MiB;
constexpr size_t WS_KR = 206 * MiB;
constexpr size_t WS_VR = 223 * MiB;
constexpr size_t WS_GS = 257 * MiB;
constexpr size_t WS_GA = 291 * MiB;
constexpr size_t WS_GR = 325 * MiB;
constexpr size_t WS_MIX = 359 * MiB;
constexpr size_t WS_X1 = 427 * MiB;
constexpr size_t WS_X1G = 495 * MiB;
constexpr size_t WS_SS = 529 * MiB;
constexpr size_t WS_HID = 530 * MiB;
constexpr size_t WS_X2G = 624 * MiB;
constexpr size_t WS_T = 658 * MiB;
constexpr size_t WS_NS1 = 692 * MiB;
constexpr size_t WS_NS2 = 828 * MiB;
constexpr size_t WS_END = 964 * MiB;

__device__ __forceinline__ float bf2f(bf16_t v) { return __uint_as_float((unsigned)v << 16); }
__device__ __forceinline__ bf16_t f2bf(float f) { unsigned u = __float_as_uint(f); return (bf16_t)((u + 0x7fffu + ((u >> 16) & 1u)) >> 16); }
__device__ __forceinline__ unsigned pk2(float lo, float hi) { return (unsigned)f2bf(lo) | ((unsigned)f2bf(hi) << 16); }
__device__ __forceinline__ float sigmoidf_(float x) { return 1.0f / (1.0f + __expf(-x)); }
__device__ __forceinline__ float siluf_(float x) { return x / (1.0f + __expf(-x)); }

struct Ptrs {
    const float* in[23];
    float* out;
    unsigned char* ws;
};
namespace pg8 {
#define PG8_LAS __attribute__((address_space(3)))
typedef unsigned short bf16_t;
typedef short bf16x8 __attribute__((ext_vector_type(8)));
typedef float f32x4 __attribute__((ext_vector_type(4)));
typedef unsigned u32x4 __attribute__((ext_vector_type(4)));
constexpr int BM = 256, BK = 64, HALF = 128, HTB = HALF * BK * 2  , STAGE_BYTES = 8 * HTB, NXCD = 8, WGM = 8;

__host__ __device__ __forceinline__ int lds_byte(int r, int c) { const int st = (r >> 4) * 2 + (c >> 5), rr = r & 15, cc = c & 31, ob = rr * 64 + cc * 2; return st * 1024 + (ob ^ (((ob >> 9) & 1) << 5)); }
__host__ __device__ __forceinline__ void stage_rc(int b, int& R, int& C) { const int st = b / 1024, sb = b % 1024, swz = sb ^ (((sb >> 9) & 1) << 5); R = (st >> 1) * 16 + swz / 64; C = (st & 1) * 32 + (swz % 64) / 2; }
__host__ __device__ __forceinline__ int perm32(int rho) { const int n = rho >> 4, i = rho & 15; return 8 * (i >> 2) + 4 * n + (i & 3); }

struct Unit { int pm, pn; };
struct Gemm { const bf16_t* A; const bf16_t* Bt; int M, N, K; };

struct StaticOrder {
    int nM, nN, nwg, G, c;
    __host__ __device__ void init(int M, int N, int G_, int c_) { nM = M / BM; nN = N / BM; nwg = nM * nN; G = G_; c = c_; }
    __host__ __device__ bool next(int i, Unit& u) const {
        const long L = (long)i * G + c; if (L >= nwg) return false;
        int wgid = (int)L; { const int q = nwg / NXCD, r = nwg % NXCD, xcd = wgid % NXCD, off = wgid / NXCD; wgid = (xcd < r ? xcd * (q + 1) : r * (q + 1) + (xcd - r) * q) + off; }
        const int nig = WGM * nN, gid = wgid / nig, fm = gid * WGM, gsz = (nM - fm) < WGM ? (nM - fm) : WGM;
        u.pm = fm + ((wgid % nig) % gsz); u.pn = (wgid % nig) / gsz; return true;
    }
    __device__ __forceinline__ void a_ready(const Unit&) const {}
    __device__ __forceinline__ void done(const Unit&) const {}
};
__device__ __forceinline__ unsigned cvt_pk_bf16(float lo, float hi) { unsigned r; asm volatile("v_cvt_pk_bf16_f32 %0, %1, %2" : "=v"(r) : "v"(lo), "v"(hi)); return r; }
typedef float f32x2 __attribute__((ext_vector_type(2)));
template <class Epi, class Sched, bool ALIGN_EPI = false, bool SP2 = false>
__device__ __forceinline__ void gemm_phase(PG8_LAS unsigned char* lds, const Gemm g, const Sched& S, const Epi& E) {
    const int tid = threadIdx.x, wid = __builtin_amdgcn_readfirstlane(tid >> 6), lane = tid & 63, wr = wid >> 2, wc = wid & 3, fr = lane & 15, fq = lane >> 4;
    const int K = g.K, nt = K / BK;
    unsigned voffA[2], voffB[2];
#pragma unroll
    for (int i = 0; i < 2; ++i) { int R, C; stage_rc(tid * 16 + i * 8192, R, C); const int Rb = Epi::PERM ? ((R & ~31) + perm32(R & 31)) : R;
        voffA[i] = (unsigned)(R * K + C) * 2u; voffB[i] = (unsigned)(Rb * K + C) * 2u; }
    const size_t kstep = (size_t)(BK * 2);
    const size_t hstep = (size_t)HALF * K * 2;
    const size_t tstep = 2 * hstep;
    const unsigned ldsw = (unsigned)wid * 1024u;
    const int aoff = lds_byte(wr * 64 + fr, fq * 8), boff = lds_byte(wc * 32 + fr, fq * 8);
#define PG8_SA(b, h) (((b) * 2 + (h)) * HTB)
#define PG8_SB(b, h) ((4 + (b) * 2 + (h)) * HTB)
#define PG8_STAGE(bufoff, gbase, voff) do { _Pragma("unroll") for (int _i = 0; _i < 2; ++_i) \
        __builtin_amdgcn_global_load_lds((const unsigned*)((const char*)(gbase) + (voff)[_i]), (PG8_LAS unsigned*)(lds + (bufoff) + ldsw + _i * 8192), 16, 0, 0); } while (0)
#define PG8_LDA(dst, b, h) do { _Pragma("unroll") for (int m = 0; m < 4; ++m) _Pragma("unroll") for (int k = 0; k < 2; ++k) dst[m][k] = *(const PG8_LAS bf16x8*)(lds + PG8_SA(b, h) + aoff + m * 2048 + k * 1024); } while (0)
#define PG8_LDB(dst, b, h) do { _Pragma("unroll") for (int n = 0; n < 2; ++n) _Pragma("unroll") for (int k = 0; k < 2; ++k) dst[n][k] = *(const PG8_LAS bf16x8*)(lds + PG8_SB(b, h) + boff + n * 2048 + k * 1024); } while (0)
#define PG8_MMA(ai, bj, At, Bt) do { __builtin_amdgcn_s_setprio(1); _Pragma("unroll") for (int m = 0; m < 4; ++m) _Pragma("unroll") for (int n = 0; n < 2; ++n) _Pragma("unroll") for (int k = 0; k < 2; ++k) \
        acc[ai][bj][m][n] = __builtin_amdgcn_mfma_f32_16x16x32_bf16(Bt[n][k], At[m][k], acc[ai][bj][m][n], 0, 0, 0); __builtin_amdgcn_s_setprio(0); } while (0)
#define PG8_WAIT_V(n) asm volatile("s_waitcnt vmcnt(" #n ")" ::: "memory")
#define PG8_WAIT_L(n) asm volatile("s_waitcnt lgkmcnt(" #n ")" ::: "memory")
#define PG8_BAR __builtin_amdgcn_s_barrier()
#define PG8_SCHED __builtin_amdgcn_sched_barrier(0)
    Unit cur, nxt; int ui = 0;
    if (!S.next(0, cur)) return;
    f32x4 acc[2][2][4][2];
#pragma unroll
    for (int a = 0; a < 2; ++a)
#pragma unroll
        for (int b = 0; b < 2; ++b)
#pragma unroll
            for (int m = 0; m < 4; ++m)
#pragma unroll
                for (int n = 0; n < 2; ++n) acc[a][b][m][n] = (f32x4){0.f, 0.f, 0.f, 0.f};
    bf16x8 At[4][2], B0[2][2], B1[2][2];
    const char* cA = (const char*)g.A + (size_t)cur.pm * tstep; const char* cB = (const char*)g.Bt + (size_t)cur.pn * tstep;
    S.a_ready(cur);
    if constexpr (SP2) {
        PG8_STAGE(PG8_SB(0, 0), cB, voffB); PG8_STAGE(PG8_SB(0, 1), cB + hstep, voffB); PG8_STAGE(PG8_SA(0, 0), cA, voffA); PG8_STAGE(PG8_SA(0, 1), cA + hstep, voffA);
        if (wr == 1) PG8_BAR;
        PG8_WAIT_V(2); PG8_BAR;
        PG8_STAGE(PG8_SB(1, 0), cB + kstep, voffB); PG8_STAGE(PG8_SA(1, 0), cA + kstep, voffA); PG8_STAGE(PG8_SB(1, 1), cB + hstep + kstep, voffB);
        PG8_WAIT_V(6); PG8_BAR;
    } else {
        PG8_STAGE(PG8_SB(0, 0), cB, voffB); PG8_STAGE(PG8_SA(0, 0), cA, voffA); PG8_STAGE(PG8_SB(0, 1), cB + hstep, voffB); PG8_STAGE(PG8_SA(0, 1), cA + hstep, voffA);
        if (wr == 1) PG8_BAR;
        PG8_WAIT_V(4); PG8_BAR;
        PG8_STAGE(PG8_SB(1, 0), cB + kstep, voffB); PG8_STAGE(PG8_SA(1, 0), cA + kstep, voffA); PG8_STAGE(PG8_SB(1, 1), cB + hstep + kstep, voffB);
        PG8_WAIT_V(6); PG8_BAR;
    }
    for (;;) {
        const bool has_next = S.next(ui + 1, nxt);
        const char* nA = has_next ? (const char*)g.A + (size_t)nxt.pm * tstep : cA; const char* nB = has_next ? (const char*)g.Bt + (size_t)nxt.pn * tstep : cB;
        for (int t = 0; t < nt; t += 2) {
            const bool last = (t == nt - 2);
            const char* a1 = cA + (size_t)(t + 1) * kstep;
            const char* a2 = last ? nA : cA + (size_t)(t + 2) * kstep; const char* b2 = last ? nB : cB + (size_t)(t + 2) * kstep;
            const char* a3 = a2 + kstep; const char* b3 = b2 + kstep;
            if (last && has_next) S.a_ready(nxt);
            if constexpr (SP2) {
            PG8_LDB(B0, 0, 0); PG8_LDB(B1, 0, 1); PG8_SCHED; PG8_LDA(At, 0, 0); PG8_STAGE(PG8_SA(1, 1), a1 + hstep, voffA);
            PG8_WAIT_V(8); PG8_WAIT_L(0); PG8_BAR; PG8_MMA(0, 0, At, B0); PG8_MMA(0, 1, At, B1); PG8_BAR; PG8_SCHED;
            PG8_LDA(At, 0, 1); PG8_STAGE(PG8_SB(0, 0), b2, voffB); PG8_STAGE(PG8_SB(0, 1), b2 + hstep, voffB); PG8_STAGE(PG8_SA(0, 0), a2, voffA);
            PG8_WAIT_V(8); PG8_WAIT_L(0); PG8_BAR; PG8_MMA(1, 0, At, B0); PG8_MMA(1, 1, At, B1); PG8_BAR; PG8_SCHED;
            PG8_LDB(B0, 1, 0); PG8_LDB(B1, 1, 1); PG8_SCHED; PG8_LDA(At, 1, 0); PG8_STAGE(PG8_SA(0, 1), a2 + hstep, voffA);
            PG8_WAIT_V(8); PG8_WAIT_L(0); PG8_BAR; PG8_MMA(0, 0, At, B0); PG8_MMA(0, 1, At, B1); PG8_BAR; PG8_SCHED;
            PG8_LDA(At, 1, 1); PG8_STAGE(PG8_SB(1, 0), b3, voffB); PG8_STAGE(PG8_SB(1, 1), b3 + hstep, voffB); PG8_STAGE(PG8_SA(1, 0), a3, voffA);
            PG8_WAIT_V(8); PG8_WAIT_L(0); PG8_BAR; PG8_MMA(1, 0, At, B0); PG8_MMA(1, 1, At, B1); PG8_BAR; PG8_SCHED;
            } else {
            PG8_LDB(B0, 0, 0); PG8_SCHED; PG8_LDA(At, 0, 0); PG8_STAGE(PG8_SA(1, 1), a1 + hstep, voffA);
            PG8_WAIT_L(8); PG8_BAR; PG8_WAIT_L(0); PG8_MMA(0, 0, At, B0); PG8_BAR; PG8_SCHED;
            PG8_LDB(B1, 0, 1); PG8_STAGE(PG8_SB(0, 0), b2, voffB);
            PG8_BAR; PG8_WAIT_L(0); PG8_MMA(0, 1, At, B1); PG8_BAR;
            PG8_LDA(At, 0, 1); PG8_STAGE(PG8_SA(0, 0), a2, voffA);
            PG8_BAR; PG8_WAIT_L(0); PG8_MMA(1, 0, At, B0); PG8_BAR; PG8_SCHED;
            PG8_STAGE(PG8_SB(0, 1), b2 + hstep, voffB);
            PG8_WAIT_V(6); PG8_BAR; PG8_MMA(1, 1, At, B1); PG8_BAR;
            PG8_LDB(B0, 1, 0); PG8_SCHED; PG8_LDA(At, 1, 0); PG8_STAGE(PG8_SA(0, 1), a2 + hstep, voffA);
            PG8_WAIT_L(8); PG8_BAR; PG8_WAIT_L(0); PG8_MMA(0, 0, At, B0); PG8_BAR; PG8_SCHED;
            PG8_LDB(B1, 1, 1); PG8_STAGE(PG8_SB(1, 0), b3, voffB);
            PG8_BAR; PG8_WAIT_L(0); PG8_MMA(0, 1, At, B1); PG8_BAR;
            PG8_LDA(At, 1, 1); PG8_STAGE(PG8_SA(1, 0), a3, voffA);
            PG8_BAR; PG8_WAIT_L(0); PG8_MMA(1, 0, At, B0); PG8_BAR; PG8_SCHED;
            PG8_STAGE(PG8_SB(1, 1), b3 + hstep, voffB);
            PG8_WAIT_V(6); PG8_BAR; PG8_MMA(1, 1, At, B1); PG8_BAR;
            }
        }
        if constexpr (ALIGN_EPI) { if (wr == 0) PG8_BAR; }
        if constexpr (!Epi::AFTER_DRAIN) { E(acc, cur, wr, wc, fr, fq); S.done(cur); }
        if (!has_next) break;
#pragma unroll
        for (int a = 0; a < 2; ++a)
#pragma unroll
            for (int b = 0; b < 2; ++b)
#pragma unroll
                for (int m = 0; m < 4; ++m)
#pragma unroll
                    for (int n = 0; n < 2; ++n) acc[a][b][m][n] = (f32x4){0.f, 0.f, 0.f, 0.f};
        cur = nxt; cA = nA; cB = nB; ++ui;
        if constexpr (ALIGN_EPI) { if (wr == 1) PG8_BAR; }
    }
    PG8_WAIT_V(0);
    if constexpr (!ALIGN_EPI) { if (wr == 0) PG8_BAR; }
    PG8_BAR;
    if constexpr (Epi::AFTER_DRAIN) { E.fused(acc, cur, wr, wc, fr, fq, lds, wid, lane); S.done(cur); }
#undef PG8_SA
#undef PG8_SB
#undef PG8_STAGE
#undef PG8_LDA
#undef PG8_LDB
#undef PG8_MMA
#undef PG8_WAIT_V
#undef PG8_WAIT_L
#undef PG8_BAR
#undef PG8_SCHED
}
}
#define GAS __attribute__((address_space(1)))
#define LAS __attribute__((address_space(3)))
typedef unsigned v4u __attribute__((ext_vector_type(4)));
typedef unsigned v2u __attribute__((ext_vector_type(2)));
typedef float f32x4 __attribute__((ext_vector_type(4)));
typedef float f32x16 __attribute__((ext_vector_type(16)));
typedef short bf16x8 __attribute__((ext_vector_type(8)));
typedef short s16x4 __attribute__((ext_vector_type(4)));
typedef GAS unsigned gu32;
#define LDS_WAIT() asm volatile("s_waitcnt lgkmcnt(0)" ::: "memory")
#define VM_WAIT() asm volatile("s_waitcnt vmcnt(0)" ::: "memory")
#define LBAR() asm volatile("s_waitcnt lgkmcnt(0)\n\ts_barrier" ::: "memory")

constexpr int NWAVES = 8, NTHREADS = 512;
constexpr int RING_OFF = 0, RING_BYTES = 131072;
constexpr int LDSCTL_OFF = RING_BYTES, MISC_OFF = LDSCTL_OFF + 320;
constexpr int LDS_BYTES = 147456;
constexpr int CW_BAR = 4096;
constexpr int CW_QUEUE = 1024;
constexpr size_t CTL_ZERO_BYTES = 64 * 1024;

#define XB_TMO      128
#define XB_XCNT(j)  (256  + 64 * (j))
#define XB_XSUB(j)  (1280 + 64 * (j))
#define XB_XGEN(j)  (2304 + 64 * (j))
#define XB_TOP      3328
#define XB_TOPGEN   3392
#define XCD_BAR_WORDS 3456
#define XB_SPIN_CAP (1u << 18)

__device__ __forceinline__ unsigned xb_ld(unsigned* p)              { return __hip_atomic_load(p, __ATOMIC_RELAXED, __HIP_MEMORY_SCOPE_AGENT); }
__device__ __forceinline__ unsigned xb_add(unsigned* p, unsigned v) { return __hip_atomic_fetch_add(p, v, __ATOMIC_RELAXED, __HIP_MEMORY_SCOPE_AGENT); }
__device__ __forceinline__ unsigned xb_xcc_id() { return (unsigned)__builtin_amdgcn_s_getreg((3 << 11) | 20) & 0xFu; }
#define XB_SPIN(cond, bar) do { unsigned _sp = 0; while (cond) { __builtin_amdgcn_s_sleep(1); \
    if ((++_sp & 255u) == 0u) { if (xb_ld(&(bar)[XB_TMO])) break; if (_sp > XB_SPIN_CAP) { atomicAdd(&(bar)[XB_TMO], 1u); break; } } } } while (0)

struct XcdBarrier {
    unsigned* bar; unsigned x;
    volatile LAS unsigned* st;
};

__device__ __forceinline__ XcdBarrier xcd_barrier_post(unsigned* bar, volatile LAS unsigned* st) {
    XcdBarrier b; b.bar = bar; b.x = xb_xcc_id(); b.st = st;
    if (threadIdx.x == 0) (void)xb_add(&bar[XB_XCNT(b.x)], 1u);
    return b;
}
__device__ __forceinline__ void xcd_barrier_complete(unsigned* bar, unsigned x, unsigned& nloc, unsigned& nx) {
    const unsigned G = gridDim.x * gridDim.y * gridDim.z;
    unsigned sum, cnt, mine, sp = 0u;
    for (;;) {
        sum = 0u; cnt = 0u; mine = 0u;
#pragma unroll
        for (unsigned j = 0; j < 16; ++j) { const unsigned c = xb_ld(&bar[XB_XCNT(j)]); sum += c; cnt += (c > 0u) ? 1u : 0u; mine = (j == x) ? c : mine; }
        if (sum == G) break;
        __builtin_amdgcn_s_sleep(1);
        if ((++sp & 255u) == 0u) { if (xb_ld(&bar[XB_TMO])) break; if (sp > XB_SPIN_CAP) { atomicAdd(&bar[XB_TMO], 1u); break; } }
    }
    nloc = mine > 0u ? mine : 1u; nx = cnt > 0u ? cnt : 1u;
}

__device__ __forceinline__ void xcd_barrier(const XcdBarrier& b) {
    asm volatile("s_waitcnt vmcnt(0)" ::: "memory");
    __syncthreads();
    if (threadIdx.x == 0) {
        unsigned* bar = b.bar;
        __builtin_amdgcn_s_waitcnt(0);
        unsigned nloc = b.st[0], nx = b.st[1];
        if (nloc == 0u) { xcd_barrier_complete(bar, b.x, nloc, nx); b.st[0] = nloc; b.st[1] = nx; }
        const unsigned old = xb_add(&bar[XB_XSUB(b.x)], 1u);
        const unsigned gen = old / nloc;
        if (old + 1u == (gen + 1u) * nloc) {
            __builtin_amdgcn_fence(__ATOMIC_RELEASE, "agent");
            asm volatile("s_waitcnt vmcnt(0)" ::: "memory");
            const unsigned og = xb_add(&bar[XB_TOP], 1u);
            const unsigned tg = og / nx;
            if (og + 1u == (tg + 1u) * nx) xb_add(&bar[XB_TOPGEN], 1u);
            else XB_SPIN(xb_ld(&bar[XB_TOPGEN]) == tg, bar);
            __builtin_amdgcn_fence(__ATOMIC_ACQUIRE, "agent");
            xb_add(&bar[XB_XGEN(b.x)], 1u);
            asm volatile("s_waitcnt vmcnt(0)" ::: "memory");
        } else {
            XB_SPIN(xb_ld(&bar[XB_XGEN(b.x)]) == gen, bar);
            __builtin_amdgcn_fence(__ATOMIC_ACQUIRE, "agent");
            asm volatile("s_waitcnt vmcnt(0)" ::: "memory");
        }
    }
    __syncthreads();
}
namespace pg8 {
#define PG8_LANEPOS int t_ = threadIdx.x; asm volatile("" : "+v"(t_)); const int wid_ = __builtin_amdgcn_readfirstlane(t_ >> 6), wr = wid_ >> 2, wc = wid_ & 3, fr = t_ & 15, fq = (t_ >> 4) & 3

__device__ __forceinline__ u32x4 pack8(const f32x4 a, const f32x4 b) { u32x4 w; w.x = cvt_pk_bf16(a[0], a[1]); w.y = cvt_pk_bf16(a[2], a[3]); w.z = cvt_pk_bf16(b[0], b[1]); w.w = cvt_pk_bf16(b[2], b[3]); return w; }
__device__ __forceinline__ float fsig(float x) { return __builtin_amdgcn_rcpf(1.0f + __builtin_amdgcn_exp2f(-LOG2E * x)); }
__device__ __forceinline__ f32x4 sig4(const f32x4 v) { return (f32x4){fsig(v[0]), fsig(v[1]), fsig(v[2]), fsig(v[3])}; }
__device__ __forceinline__ f32x4 silu4(const f32x4 v) { return (f32x4){v[0] * fsig(v[0]), v[1] * fsig(v[1]), v[2] * fsig(v[2]), v[3] * fsig(v[3])}; }
__device__ __forceinline__ f32x4 bf4_lo(const u32x4 w, int half) {
    const unsigned a = half ? w.z : w.x, b = half ? w.w : w.y;
    return (f32x4){__uint_as_float(a << 16), __uint_as_float(a & 0xffff0000u), __uint_as_float(b << 16), __uint_as_float(b & 0xffff0000u)};
}

struct EpiInProj {
    static constexpr bool PERM = true, AFTER_DRAIN = false;
    const float* gq; const float* gk; float* out; unsigned char* ws; int force_cat;
    __device__ __forceinline__ void operator()(const f32x4 (&acc)[2][2][4][2], const Unit& u, int, int, int, int) const {
        PG8_LANEPOS;
        const int pn = u.pn, cat = force_cat >= 0 ? force_cat : (pn >> 2);
        const int row0 = u.pm * BM + wr * 64 + fr;
        const int lc0 = (pn & 3) * 256 + wc * 64 + 8 * fq;
        const bool smp = u.pm >= (MP / BM);
        bf16_t* const Q = (bf16_t*)(ws + WS_Q); bf16_t* const Kb = (bf16_t*)(ws + WS_KB);
        if (cat == 0 || cat == 1) {
            const float* g = cat == 0 ? gq : gk; f32x4 gv[2][2];
#pragma unroll
            for (int bj = 0; bj < 2; ++bj)
#pragma unroll
                for (int n = 0; n < 2; ++n) { gv[bj][n] = *(const f32x4*)(g + 32 * bj + 8 * fq + 4 * n); if (cat == 0) gv[bj][n] = gv[bj][n] * QSCALE; }
            float* ok = smp ? out + O_NKS - (size_t)MP * DM : out + O_NKP;
            float rs[2][4];
#pragma unroll
            for (int ai = 0; ai < 2; ++ai)
#pragma unroll
                for (int m = 0; m < 4; ++m) { float ss = 0.f;
#pragma unroll
                    for (int bj = 0; bj < 2; ++bj)
#pragma unroll
                        for (int n = 0; n < 2; ++n) { const f32x4 v = acc[ai][bj][m][n]; ss += (v[0] * v[0] + v[1] * v[1]) + (v[2] * v[2] + v[3] * v[3]); }
                    rs[ai][m] = ss; }
#pragma unroll
            for (int ai = 0; ai < 2; ++ai)
#pragma unroll
                for (int m = 0; m < 4; ++m) rs[ai][m] += __shfl_xor(rs[ai][m], 16);
#pragma unroll
            for (int ai = 0; ai < 2; ++ai)
#pragma unroll
                for (int m = 0; m < 4; ++m) rs[ai][m] += __shfl_xor(rs[ai][m], 32);
#pragma unroll
            for (int ai = 0; ai < 2; ++ai)
#pragma unroll
                for (int m = 0; m < 4; ++m) { const int row = row0 + ai * HALF + m * 16;
                    const float r = __builtin_amdgcn_rsqf(rs[ai][m] * (1.0f / 64.0f) + EPS);
#pragma unroll
                    for (int bj = 0; bj < 2; ++bj) { const f32x4 a = acc[ai][bj][m][0] * r * gv[bj][0], b = acc[ai][bj][m][1] * r * gv[bj][1];
                        const size_t off = (size_t)row * DM + lc0 + 32 * bj;
                        if (cat == 0) { *(u32x4*)(Q + off) = pack8(a, b); }
                        else { *(f32x4*)(ok + off) = a; *(f32x4*)(ok + off + 4) = b; *(u32x4*)(Kb + off) = pack8(a, b); } } }
        } else if (cat == 2 || cat == 8) {
            float* ov = cat == 8 ? (float*)(ws + WS_NS2) : smp ? out + O_NVS - (size_t)MP * DM : out + O_NVP;
            bf16_t* const Vb = (bf16_t*)(ws + (cat == 8 ? WS_NS1 : WS_VB));
#pragma unroll
            for (int ai = 0; ai < 2; ++ai)
#pragma unroll
                for (int m = 0; m < 4; ++m) { const int row = row0 + ai * HALF + m * 16;
#pragma unroll
                    for (int bj = 0; bj < 2; ++bj) { const f32x4 a = acc[ai][bj][m][0], b = acc[ai][bj][m][1]; const size_t off = (size_t)row * DM + lc0 + 32 * bj;
                        *(f32x4*)(ov + off) = a; *(f32x4*)(ov + off + 4) = b; *(u32x4*)(Vb + off) = pack8(a, b); } }
        } else if (cat == 3) {
            const int g64 = (pn - 12) * 4 + wc, hh = g64 & 7; const bool isk = g64 >= 8;
            bf16_t* dst = (bf16_t*)(ws + (isk ? WS_KR : WS_QR)); const float sc = isk ? 0.125f : 1.0f;
            f32x4 rv[2];
#pragma unroll
            for (int n = 0; n < 2; ++n)
#pragma unroll
                for (int e = 0; e < 4; ++e) rv[n][e] = __builtin_amdgcn_exp2f(-(float)(8 * fq + 4 * n + e) * (13.287712379549449f / 32.0f));
#pragma unroll
            for (int ai = 0; ai < 2; ++ai)
#pragma unroll
                for (int m = 0; m < 4; ++m) { const int row = row0 + ai * HALF + m * 16;
                    const float pos = (float)(smp ? PAST + ((row - MP) & 31) : (row & 4095));
                    f32x4 o1[2], o2[2];
#pragma unroll
                    for (int n = 0; n < 2; ++n) { f32x4 cs, sn;
#pragma unroll
                        for (int e = 0; e < 4; ++e) { const float ang = pos * rv[n][e]; const float fr = __builtin_amdgcn_fractf(ang * 0.15915494309189535f);
                            cs[e] = __builtin_amdgcn_cosf(fr); sn[e] = __builtin_amdgcn_sinf(fr); }
                        const f32x4 x1 = acc[ai][0][m][n], x2 = acc[ai][1][m][n];
                        o1[n] = (x1 * cs - x2 * sn) * sc; o2[n] = (x1 * sn + x2 * cs) * sc; }
                    const size_t off = (size_t)row * 512 + hh * 64 + 8 * fq;
                    *(u32x4*)(dst + off) = pack8(o1[0], o1[1]); *(u32x4*)(dst + off + 32) = pack8(o2[0], o2[1]); }
        } else {
            bf16_t* dst = (bf16_t*)(ws + (force_cat >= 0 ? WS_NS1 : cat == 4 ? WS_VR : cat == 5 ? WS_GS : cat == 6 ? WS_GA : WS_GR));
#pragma unroll
            for (int ai = 0; ai < 2; ++ai)
#pragma unroll
                for (int m = 0; m < 4; ++m) { const int row = row0 + ai * HALF + m * 16;
#pragma unroll
                    for (int bj = 0; bj < 2; ++bj) { f32x4 a = acc[ai][bj][m][0], b = acc[ai][bj][m][1];
                        if (cat == 5) { a = silu4(a); b = silu4(b); } else if (cat >= 6) { a = sig4(a); b = sig4(b); }
                        *(u32x4*)(dst + (size_t)row * DM + lc0 + 32 * bj) = pack8(a, b); } }
        }
    }
};

struct EpiStoreBf16 {
    static constexpr bool PERM = true, AFTER_DRAIN = false;
    bf16_t* O;
    __device__ __forceinline__ void operator()(const f32x4 (&acc)[2][2][4][2], const Unit& u, int, int, int, int) const {
        PG8_LANEPOS;
        const int row0 = u.pm * BM + wr * 64 + fr, col0 = u.pn * BM + wc * 64 + 8 * fq;
#pragma unroll
        for (int ai = 0; ai < 2; ++ai)
#pragma unroll
            for (int m = 0; m < 4; ++m)
#pragma unroll
                for (int bj = 0; bj < 2; ++bj) *(u32x4*)(O + (size_t)(row0 + ai * HALF + m * 16) * DM + col0 + 32 * bj) = pack8(acc[ai][bj][m][0], acc[ai][bj][m][1]);
    }
};

struct EpiResid {
    static constexpr bool PERM = true, AFTER_DRAIN = false;
    const float* base0; const float* base1;
    float* Xo; bf16_t* Xg; const float* g; float* SS;
    __device__ __forceinline__ void operator()(const f32x4 (&acc)[2][2][4][2], const Unit& u, int, int, int, int) const {
        PG8_LANEPOS;
        const int row0 = u.pm * BM + wr * 64 + fr, col0 = u.pn * BM + wc * 64 + 8 * fq;
        const float* base = u.pm >= (MP / BM) ? base1 - (size_t)MP * DM : base0;
        f32x4 gv[2][2];
#pragma unroll
        for (int bj = 0; bj < 2; ++bj)
#pragma unroll
            for (int n = 0; n < 2; ++n) gv[bj][n] = *(const f32x4*)(g + col0 + 32 * bj + 4 * n);
#pragma unroll
        for (int ai = 0; ai < 2; ++ai) {
            f32x4 r[4][2][2];
#pragma unroll
            for (int m = 0; m < 4; ++m)
#pragma unroll
                for (int bj = 0; bj < 2; ++bj) { const size_t off = (size_t)(row0 + ai * HALF + m * 16) * DM + col0 + 32 * bj;
                    r[m][bj][0] = *(const f32x4*)(base + off); r[m][bj][1] = *(const f32x4*)(base + off + 4); }
            asm volatile("" ::: "memory");
#pragma unroll
            for (int m = 0; m < 4; ++m) { const int row = row0 + ai * HALF + m * 16; float ss = 0.f;
#pragma unroll
                for (int bj = 0; bj < 2; ++bj) { const size_t off = (size_t)row * DM + col0 + 32 * bj;
                    const f32x4 a = r[m][bj][0] + acc[ai][bj][m][0], b = r[m][bj][1] + acc[ai][bj][m][1];
                    ss += (a[0] * a[0] + a[1] * a[1]) + (a[2] * a[2] + a[3] * a[3]) + (b[0] * b[0] + b[1] * b[1]) + (b[2] * b[2] + b[3] * b[3]);
                    *(f32x4*)(Xo + off) = a; *(f32x4*)(Xo + off + 4) = b; *(u32x4*)(Xg + off) = pack8(a * gv[bj][0], b * gv[bj][1]); }
                ss += __shfl_xor(ss, 16); ss += __shfl_xor(ss, 32);
                if (fq == 0) atomicAdd(SS + row, ss); }
            asm volatile("" ::: "memory");
        }
    }
};

struct EpiGateUp {
    static constexpr bool PERM = true, AFTER_DRAIN = false;
    const float* SS; bf16_t* HID;
    __device__ __forceinline__ void operator()(const f32x4 (&acc)[2][2][4][2], const Unit& u, int, int, int, int) const {
        PG8_LANEPOS;
        const int row0 = u.pm * BM + wr * 64 + fr, col0 = u.pn * 128 + wc * 32 + 8 * fq;
        float sv[2][4];
#pragma unroll
        for (int ai = 0; ai < 2; ++ai)
#pragma unroll
            for (int m = 0; m < 4; ++m) sv[ai][m] = SS[row0 + ai * HALF + m * 16];
        asm volatile("" ::: "memory");
#pragma unroll
        for (int ai = 0; ai < 2; ++ai)
#pragma unroll
            for (int m = 0; m < 4; ++m) { const int row = row0 + ai * HALF + m * 16;
                const float r = __builtin_amdgcn_rsqf(sv[ai][m] * (1.0f / DM) + EPS);
                const f32x4 g0 = acc[ai][0][m][0] * r, g1 = acc[ai][0][m][1] * r, u0 = acc[ai][1][m][0] * r, u1 = acc[ai][1][m][1] * r;
                *(u32x4*)(HID + (size_t)row * DFF + col0) = pack8(silu4(g0) * u0, silu4(g1) * u1); }
    }
};

struct EpiFinal {
    static constexpr bool PERM = true, AFTER_DRAIN = false;
    const float* SS; const bf16_t* T; const float* y; float* yo;
    __device__ __forceinline__ void operator()(const f32x4 (&acc)[2][2][4][2], const Unit& u, int, int, int, int) const {
        PG8_LANEPOS;
        const int row0 = u.pm * BM + wr * 64 + fr, col0 = u.pn * BM + wc * 64 + 8 * fq;
#pragma unroll
        for (int ai = 0; ai < 2; ++ai)
#pragma unroll
            for (int mp = 0; mp < 2; ++mp) {
                f32x4 yv[2][2][2]; u32x4 tv[2][2]; float sv[2];
#pragma unroll
                for (int mm = 0; mm < 2; ++mm) { const int row = row0 + ai * HALF + (2 * mp + mm) * 16; sv[mm] = SS[row];
#pragma unroll
                    for (int bj = 0; bj < 2; ++bj) { const size_t off = (size_t)row * DM + col0 + 32 * bj;
                        yv[mm][bj][0] = *(const f32x4*)(y + off); yv[mm][bj][1] = *(const f32x4*)(y + off + 4); tv[mm][bj] = *(const u32x4*)(T + off); } }
                asm volatile("" ::: "memory");
#pragma unroll
                for (int mm = 0; mm < 2; ++mm) { const int m = 2 * mp + mm, row = row0 + ai * HALF + m * 16;
                    const float r = __builtin_amdgcn_rsqf(sv[mm] * (1.0f / DM) + EPS);
#pragma unroll
                    for (int bj = 0; bj < 2; ++bj) { const size_t off = (size_t)row * DM + col0 + 32 * bj;
                        const f32x4 a = yv[mm][bj][0] + sig4(acc[ai][bj][m][0] * r) * bf4_lo(tv[mm][bj], 0), b = yv[mm][bj][1] + sig4(acc[ai][bj][m][1] * r) * bf4_lo(tv[mm][bj], 1);
                        *(f32x4*)(yo + off) = a; *(f32x4*)(yo + off + 4) = b; } }
                asm volatile("" ::: "memory");
            }
    }
};

}
struct Args { const float* in[23]; float* out; unsigned char* ws; int ph_lo, ph_hi, li, fc; };

__device__ __forceinline__ void transpose_item(const float* src, int ldw, bf16_t* dst, int ldk, LAS float* scr, int lane) {
    float tv[32];
#pragma unroll
    for (int i = 0; i < 32; ++i) tv[i] = src[(size_t)(2 * i + (lane >> 5)) * ldw + (lane & 31)];
#pragma unroll
    for (int i = 0; i < 32; ++i) scr[(2 * i + (lane >> 5)) * 33 + (lane & 31)] = tv[i];
    LDS_WAIT(); asm volatile("" ::: "memory");
    const int c = lane & 7;
#pragma unroll
    for (int j = 0; j < 4; ++j) { const int n = (lane >> 3) + 8 * j; const LAS float* s = scr + (8 * c) * 33 + n;
        v4u o; o.x = pk2(s[0 * 33], s[1 * 33]); o.y = pk2(s[2 * 33], s[3 * 33]); o.z = pk2(s[4 * 33], s[5 * 33]); o.w = pk2(s[6 * 33], s[7 * 33]);
        *(v4u*)(dst + (size_t)n * ldk + 8 * c) = o; }
    LDS_WAIT(); asm volatile("" ::: "memory");
}

__device__ __forceinline__ int perm_col0(int g32) { const int pn = g32 >> 3, bj = (g32 >> 2) & 1, wc = g32 & 3; return 256 * pn + 64 * wc + 32 * bj; }

constexpr int LW_I_O = (DM / 32) * (2048 / 64), LW_I_GU = (2 * DFF / 32) * (DM / 64), LW_I_DN = (DM / 32) * (DFF / 64), LW_I_PG = (DM / 32) * (DM / 64);
constexpr int LW_ITEMS = LW_I_O + LW_I_GU + LW_I_DN + LW_I_PG;
__device__ __forceinline__ void late_weight_item(const Args& a, int it, LAS float* scr, int lane) {
    unsigned char* ws = a.ws;
    const float *w_o = a.in[15], *w_g = a.in[17], *w_u = a.in[18], *w_d = a.in[19], *w_pg = a.in[22];
    bf16_t *WO = (bf16_t*)(ws + WS_WO), *WGU = (bf16_t*)(ws + WS_WGU), *WDN = (bf16_t*)(ws + WS_WDN), *WPG = (bf16_t*)(ws + WS_WPG);
    int r = it;
    if (r < LW_I_O) { const int g32 = r / 32, kb = r % 32; transpose_item(w_o + (size_t)((kb * 64) % DM) * DM + perm_col0(g32), DM, WO + (size_t)g32 * 32 * 2048 + kb * 64, 2048, scr, lane); return; } r -= LW_I_O;
    if (r < LW_I_GU) { const int g32 = r / (DM / 64), kb = r % (DM / 64); const int pn = g32 >> 3, bj = (g32 >> 2) & 1, wc = g32 & 3;
        transpose_item((bj ? w_u : w_g) + (size_t)kb * 64 * DFF + 128 * pn + 32 * wc, DFF, WGU + (size_t)g32 * 32 * DM + kb * 64, DM, scr, lane); return; } r -= LW_I_GU;
    if (r < LW_I_DN) { const int g32 = r / (DFF / 64), kb = r % (DFF / 64); transpose_item(w_d + (size_t)kb * 64 * DM + perm_col0(g32), DM, WDN + (size_t)g32 * 32 * DFF + kb * 64, DFF, scr, lane); return; } r -= LW_I_DN;
    { const int g32 = r / (DM / 64), kb = r % (DM / 64); transpose_item(w_pg + (size_t)kb * 64 * DM + perm_col0(g32), DM, WPG + (size_t)g32 * 32 * DM + kb * 64, DM, scr, lane); }
}

__device__ __forceinline__ void p0_prologue(const Args& a, LAS unsigned char* lds, int gw, int NGW, int lane) {
    unsigned char* ws = a.ws;
    LAS float* scr = (LAS float*)(lds + (threadIdx.x >> 6) * 16384);
    const float *w_in = a.in[7], *w_ple = a.in[21];
    bf16_t *WIN = (bf16_t*)(ws + WS_WIN), *WPL = (bf16_t*)(ws + WS_WPL);
    constexpr int I_IN = (NIN / 32) * (DM / 64), I_PL = (DM / 32) * (PLE / 64);
    constexpr int NITEMS = I_IN + I_PL;
    for (int it = gw; it < NITEMS; it += NGW) {
        int r = it;
        if (r < I_IN) { const int g32 = r / (DM / 64), kb = r % (DM / 64); transpose_item(w_in + (size_t)kb * 64 * NIN + perm_col0(g32), NIN, WIN + (size_t)g32 * 32 * DM + kb * 64, DM, scr, lane); continue; } r -= I_IN;
        { const int g32 = r / (PLE / 64), kb = r % (PLE / 64); transpose_item(w_ple + (size_t)kb * 64 * DM + perm_col0(g32), DM, WPL + (size_t)g32 * 32 * PLE + kb * 64, PLE, scr, lane); }
    }
    const float *xp = a.in[0], *xs = a.in[1], *g = a.in[8]; bf16_t* H = (bf16_t*)(ws + WS_H);
    for (int row0 = gw; row0 < M; row0 += 2 * NGW) {
        const int row1 = row0 + NGW; const bool has1 = row1 < M;
        const f32x4* x0 = (const f32x4*)(row0 < MP ? xp + (size_t)row0 * DM : xs + (size_t)(row0 - MP) * DM);
        const f32x4* x1 = (const f32x4*)(!has1 ? (const float*)x0 : row1 < MP ? xp + (size_t)row1 * DM : xs + (size_t)(row1 - MP) * DM);
        f32x4 v[4], u[4]; float s = 0.f, t = 0.f;
#pragma unroll
        for (int j = 0; j < 4; ++j) { v[j] = x0[lane + 64 * j]; u[j] = x1[lane + 64 * j]; }
#pragma unroll
        for (int j = 0; j < 4; ++j) { s += (v[j][0] * v[j][0] + v[j][1] * v[j][1]) + (v[j][2] * v[j][2] + v[j][3] * v[j][3]); t += (u[j][0] * u[j][0] + u[j][1] * u[j][1]) + (u[j][2] * u[j][2] + u[j][3] * u[j][3]); }
#pragma unroll
        for (int o = 1; o < 64; o <<= 1) { s += __shfl_xor(s, o); t += __shfl_xor(t, o); }
        const float r = rsqrtf(s * (1.0f / DM) + EPS), q = rsqrtf(t * (1.0f / DM) + EPS);
#pragma unroll
        for (int j = 0; j < 4; ++j) { const f32x4 gg = ((const f32x4*)g)[lane + 64 * j];
            v2u o; o.x = pk2(v[j][0] * r * gg[0], v[j][1] * r * gg[1]); o.y = pk2(v[j][2] * r * gg[2], v[j][3] * r * gg[3]);
            ((v2u*)(H + (size_t)row0 * DM))[lane + 64 * j] = o;
            if (has1) { v2u w; w.x = pk2(u[j][0] * q * gg[0], u[j][1] * q * gg[1]); w.y = pk2(u[j][2] * q * gg[2], u[j][3] * q * gg[3]);
                ((v2u*)(H + (size_t)row1 * DM))[lane + 64 * j] = w; } }
    }
    { const float *pp = a.in[5], *ps = a.in[6]; bf16_t* PB = (bf16_t*)(ws + WS_PB);
      const size_t n4 = (size_t)M * PLE / 4, np4 = (size_t)MP * PLE / 4;
      const size_t st = (size_t)NGW * 64;
      for (size_t i0 = (size_t)gw * 64 + lane; i0 < n4; i0 += 4 * st) {
          f32x4 v[4];
#pragma unroll
          for (int k = 0; k < 4; ++k) { const size_t i = i0 + k * st; v[k] = i < np4 ? ((const f32x4*)pp)[i] : i < n4 ? ((const f32x4*)ps)[i - np4] : (f32x4){0.f, 0.f, 0.f, 0.f}; }
#pragma unroll
          for (int k = 0; k < 4; ++k) { const size_t i = i0 + k * st; if (i < n4) { v2u o; o.x = pk2(v[k][0], v[k][1]); o.y = pk2(v[k][2], v[k][3]); ((v2u*)PB)[i] = o; } }
      } }
    { float* SS = (float*)(ws + WS_SS);
      for (int i = gw * 64 + lane; i < 65536; i += NGW * 64) SS[i] = 0.f; }
    { const float *lq = a.in[11], *lk = a.in[12], *gq = a.in[9], *gk = a.in[10]; float* sc = (float*)(ws + WS_SC);
      if (gw == 0) {
          float s0 = lq[lane] * lk[lane], s1 = lq[64 + lane] * lk[64 + lane], mq = fabsf(gq[lane]), mk = fabsf(gk[lane]);
#pragma unroll
          for (int o = 1; o < 64; o <<= 1) { s0 += __shfl_xor(s0, o); s1 += __shfl_xor(s1, o); mq = fmaxf(mq, __shfl_xor(mq, o)); mk = fmaxf(mk, __shfl_xor(mk, o)); }
          if (lane == 0) { sc[0] = expf(s0) - expf(s1) + LAM_INIT; sc[1] = 8.0f * LOG2E * mq * mk * 1.01f; }
      }
    }
}
namespace att {
typedef short v4i16_t __attribute__((ext_vector_type(4)));
typedef float f32x2_t __attribute__((ext_vector_type(2)));
typedef __bf16 bf16x2_t __attribute__((ext_vector_type(2)));
__device__ __forceinline__ unsigned cvtpk(float lo, float hi) { f32x2_t v = {lo, hi}; bf16x2_t b = __builtin_convertvector(v, bf16x2_t); return __builtin_bit_cast(unsigned, b); }
__device__ __forceinline__ s16x4 vtr(const LAS unsigned char* p) { return __builtin_bit_cast(s16x4, __builtin_amdgcn_ds_read_tr16_b64_v4i16((LAS v4i16_t*)p)); }
__device__ __forceinline__ void glds16(const void* gsrc, unsigned lds_dst) { unsigned keep;
    asm volatile("s_mov_b32 %0, m0\n\ts_mov_b32 m0, %2\n\ts_nop 0\n\tglobal_load_lds_dwordx4 %1, off\n\ts_mov_b32 m0, %0" : "=&s"(keep) : "v"(gsrc), "s"(lds_dst) : "memory"); }
__device__ __forceinline__ int crow(int r, int hi) { return (r & 3) + 8 * (r >> 2) + 4 * hi; }
__device__ __forceinline__ int koff(int row, int ch) { return 256 * row + 16 * (ch ^ (((row & 3) << 2) | ((row >> 2) & 3))); }
constexpr int L_K = 0, L_V = 32768, L_WS = 132096;
constexpr int L_CONST = 131520;

template <bool SAMPLE, int ABL = 0>
__device__ __forceinline__ void attn_unit(const Args& a, LAS unsigned char* lds, int b, int h, int qb, bf16_t* mixbase = nullptr, gu32* qhead = nullptr) {
    unsigned char* ws = a.ws;
    const bf16_t *Q = (const bf16_t*)(ws + WS_Q), *Kb = (const bf16_t*)(ws + WS_KB), *Vb = (const bf16_t*)(ws + WS_VB), *GA = (const bf16_t*)(ws + WS_GA);
    bf16_t* MIX = mixbase ? mixbase : (bf16_t*)(ws + WS_MIX);
    const float *cK = a.in[2], *cV = a.in[3];
    const LAS float* cst = (const LAS float*)(lds + L_CONST);
    int tid_ = threadIdx.x; asm volatile("" : "+v"(tid_));
    const int tid = tid_, lane = tid & 63, r32 = lane & 31, hi = lane >> 5;
    const int wave = __builtin_amdgcn_readfirstlane(tid >> 6), rb = wave >> 1, map = wave & 1;
    const int row0 = SAMPLE ? MP + b * DT : b * SEQ + qb * 128;
    const int NT = SAMPLE ? (PAST / 64 + 1) : 2 * qb + 2;
    const int tlast = SAMPLE ? NT - 1 : 2 * qb + (rb >> 1);
    const bool wactive = SAMPLE ? (rb == 0) : true;
    const float lam = cst[128], shift = cst[129];

    const int lw = (wave - 2) & 3;
    auto ldraw = [&](f32x4 (&r)[16], int t) {
        const size_t row0c = (size_t)(b * PAST + 64 * t + 16 * lw + hi) * NH + h;
        const float* kp = cK + row0c * 128 + 4 * r32;
        const float* vp = cV + row0c * 128 + 4 * r32;
#pragma unroll
        for (int n = 0; n < 8; ++n) {
            r[n] = __builtin_nontemporal_load((const f32x4*)(kp + (size_t)(2 * n) * NH * 128));
            r[8 + n] = __builtin_nontemporal_load((const f32x4*)(vp + (size_t)(2 * n) * NH * 128));
        }
    };
    auto wrraw = [&](const f32x4 (&r)[16], int buf) {
#pragma unroll
        for (int n = 0; n < 8; ++n) {
            const int key = 16 * lw + 2 * n + hi;
            *(LAS v2u*)(lds + buf * 32768 + koff(key, r32 >> 1) + 8 * (r32 & 1)) = (v2u){cvtpk(r[n][0], r[n][1]), cvtpk(r[n][2], r[n][3])};
            *(LAS v2u*)(lds + buf * 32768 + 16384 + ((r32 >> 3) * 4 + lw) * 1024 + (2 * n + hi) * 64 + (r32 & 7) * 8) = (v2u){cvtpk(r[8 + n][0], r[8 + n][1]), cvtpk(r[8 + n][2], r[8 + n][3])};
        }
    };

    bf16x8 qf[4];
    const bf16_t* qp = Q + (size_t)(row0 + (SAMPLE ? 0 : 32 * rb) + r32) * DM + h * 128 + map * 64 + 8 * hi;
    if constexpr (SAMPLE) {
#pragma unroll
        for (int d0 = 0; d0 < 4; ++d0) qf[d0] = *(const bf16x8*)(qp + 16 * d0);
    }
    f32x16 o[4];
#pragma unroll
    for (int d = 0; d < 4; ++d)
#pragma unroll
        for (int r = 0; r < 16; ++r) o[d][r] = 0.f;
    float l_reg = 0.f;
    f32x16 negs;
#pragma unroll
    for (int r = 0; r < 16; ++r) negs[r] = -shift;
    const int vp0 = ((lane >> 4) & 1) * 32 + (lane & 3) * 8 + (4 * hi + ((lane & 15) >> 2)) * 64;

    __syncthreads();
    if constexpr (!SAMPLE) {
        const int lds0 = (int)(size_t)lds;
        auto dma_tile = [&](int t, int slot_off) {
#pragma unroll
            for (int i = 0; i < 2; ++i) {
                const int kid = tid + 512 * i, key = kid >> 4, cl = kid & 15;
                const int csrc = cl ^ (((key & 3) << 2) | ((key >> 2) & 3));
                const int pz = wave + 8 * i, vkey = 16 * (pz & 3) + (lane >> 2), vd = 32 * (pz >> 2) + 8 * (lane & 3);
                const bf16_t* ksrc = Kb + (size_t)(b * SEQ + 64 * t + key) * DM + h * 128 + 8 * csrc;
                const bf16_t* vsrc = Vb + (size_t)(b * SEQ + 64 * t + vkey) * DM + h * 128 + vd;
                glds16(ksrc, (unsigned)__builtin_amdgcn_readfirstlane(lds0 + slot_off + wave * 1024 + i * 8192));
                glds16(vsrc, (unsigned)__builtin_amdgcn_readfirstlane(lds0 + slot_off + 16384 + (wave + 8 * i) * 1024));
            }
        };
        dma_tile(0, 0); dma_tile(1, 32768);
#pragma unroll
        for (int d0 = 0; d0 < 4; ++d0) qf[d0] = *(const bf16x8*)(qp + 16 * d0);
        asm volatile("" : "+v"(qf[0]), "+v"(qf[1]), "+v"(qf[2]), "+v"(qf[3]));
        int s_cur = 0, s_n1 = 32768, s_n2 = 65536;
        for (int t = 0; t < NT; ++t) {
            if (!(ABL & 16)) {
            if (t + 1 < NT) asm volatile("s_waitcnt vmcnt(4) lgkmcnt(0)\n\ts_barrier" ::: "memory");
            else asm volatile("s_waitcnt vmcnt(0) lgkmcnt(0)\n\ts_barrier" ::: "memory");
            }
            if (t > tlast) { if (t + 2 < NT) dma_tile(t + 2, s_n2); }
            if (t <= tlast) {
                const LAS unsigned char* Kt = lds + s_cur;
                const LAS unsigned char* Vt = lds + s_cur + 16384 + vp0;
#define MFMA32(A_, B_, C_) __builtin_amdgcn_mfma_f32_32x32x16_bf16(A_, B_, C_, 0, 0, 0)
#define VLD(dst, ks) do { _Pragma("unroll") for (int db = 0; db < 4; ++db) { if (!(ABL & 8)) { const s16x4 lo_ = vtr(Vt + db * 4096 + (ks) * 1024), hh_ = vtr(Vt + db * 4096 + (ks) * 1024 + 512); \
                          dst[db] = (bf16x8){lo_[0], lo_[1], lo_[2], lo_[3], hh_[0], hh_[1], hh_[2], hh_[3]}; } else dst[db] = qf[db]; } } while (0)
#define SGB(mask, n) __builtin_amdgcn_sched_group_barrier(mask, n, 0)
#define PVM(P_, V_, O_) do { if (!(ABL & 2)) O_ = MFMA32(__builtin_bit_cast(bf16x8, P_), V_, O_); else asm volatile("" :: "v"(P_), "v"(V_)); } while (0)
                bf16x8 ka[4], kb[4], va[4], vb[4];
#pragma unroll
                for (int d0 = 0; d0 < 4; ++d0) { const int c = map * 8 + 2 * d0 + hi; ka[d0] = *(const LAS bf16x8*)(Kt + koff(r32, c)); kb[d0] = *(const LAS bf16x8*)(Kt + koff(32 + r32, c)); }
                VLD(va, 0);
                f32x16 p0 = negs, p1 = negs;
                __builtin_amdgcn_s_setprio(1);
#pragma unroll
                for (int d0 = 0; d0 < 4; ++d0) { if (!(ABL & 4)) { p0 = MFMA32(ka[d0], qf[d0], p0); p1 = MFMA32(kb[d0], qf[d0], p1); } else { asm volatile("" :: "v"(ka[d0]), "v"(kb[d0])); } }
                __builtin_amdgcn_sched_barrier(0);
                if (!(ABL & 32)) { if (t + 2 < NT) dma_tile(t + 2, s_n2); }
                __builtin_amdgcn_sched_barrier(0);
                float s0 = 0.f, s1 = 0.f;
#pragma unroll
                for (int r = 0; r < 16; ++r) { if (!(ABL & 1)) p0[r] = __builtin_amdgcn_exp2f(p0[r]); s0 += p0[r]; }
                v4u pw0 = (v4u){cvtpk(p0[0], p0[1]), cvtpk(p0[2], p0[3]), cvtpk(p0[4], p0[5]), cvtpk(p0[6], p0[7])};
                v4u pw1 = (v4u){cvtpk(p0[8], p0[9]), cvtpk(p0[10], p0[11]), cvtpk(p0[12], p0[13]), cvtpk(p0[14], p0[15])};
                VLD(vb, 1);
                __builtin_amdgcn_sched_barrier(0);
#pragma unroll
                for (int db = 0; db < 4; ++db) PVM(pw0, va[db], o[db]);
#pragma unroll
                for (int r = 0; r < 16; ++r) { if (!(ABL & 1)) p1[r] = __builtin_amdgcn_exp2f(p1[r]); s1 += p1[r]; }
                v4u pw2 = (v4u){cvtpk(p1[0], p1[1]), cvtpk(p1[2], p1[3]), cvtpk(p1[4], p1[5]), cvtpk(p1[6], p1[7])};
                v4u pw3 = (v4u){cvtpk(p1[8], p1[9]), cvtpk(p1[10], p1[11]), cvtpk(p1[12], p1[13]), cvtpk(p1[14], p1[15])};
                VLD(va, 2);
#pragma unroll
                for (int db = 0; db < 4; ++db) PVM(pw1, vb[db], o[db]);
#pragma unroll
                for (int i = 0; i < 8; ++i) { SGB(0x8, 1); SGB(0x2, 5); SGB(0x100, 1); }
                __builtin_amdgcn_sched_barrier(0);
                VLD(vb, 3);
#pragma unroll
                for (int db = 0; db < 4; ++db) PVM(pw2, va[db], o[db]);
#pragma unroll
                for (int db = 0; db < 4; ++db) PVM(pw3, vb[db], o[db]);
                __builtin_amdgcn_s_setprio(0);
                l_reg += s0 + s1;
#undef MFMA32
#undef VLD
#undef SGB
#undef PVM
            }
            { const int tmp = s_cur; s_cur = s_n1; s_n1 = s_n2; s_n2 = tmp; }
        }
        asm volatile("s_waitcnt lgkmcnt(0)\n\ts_barrier" ::: "memory");
    } else {
        auto tile = [&](int slot, auto half_) {
            constexpr bool halftile = decltype(half_)::value;
            if (wactive) {
                const LAS unsigned char* Kt = lds + slot * 32768;
                const LAS unsigned char* Vt = lds + slot * 32768 + 16384 + vp0;
                f32x16 p0 = negs, p1 = negs;
#pragma unroll
                for (int d0 = 0; d0 < 4; ++d0) {
                    const int c = map * 8 + 2 * d0 + hi;
                    p0 = __builtin_amdgcn_mfma_f32_32x32x16_bf16(*(const LAS bf16x8*)(Kt + koff(r32, c)), qf[d0], p0, 0, 0, 0);
                    if (!halftile) p1 = __builtin_amdgcn_mfma_f32_32x32x16_bf16(*(const LAS bf16x8*)(Kt + koff(32 + r32, c)), qf[d0], p1, 0, 0, 0);
                }
                float s = 0.f;
#pragma unroll
                for (int r = 0; r < 16; ++r) { p0[r] = __builtin_amdgcn_exp2f(p0[r]); s += p0[r]; }
                if (!halftile) {
#pragma unroll
                    for (int r = 0; r < 16; ++r) { p1[r] = __builtin_amdgcn_exp2f(p1[r]); s += p1[r]; }
                }
                l_reg += s;
                v4u pw[4];
                pw[0] = (v4u){cvtpk(p0[0], p0[1]), cvtpk(p0[2], p0[3]), cvtpk(p0[4], p0[5]), cvtpk(p0[6], p0[7])};
                pw[1] = (v4u){cvtpk(p0[8], p0[9]), cvtpk(p0[10], p0[11]), cvtpk(p0[12], p0[13]), cvtpk(p0[14], p0[15])};
                pw[2] = (v4u){cvtpk(p1[0], p1[1]), cvtpk(p1[2], p1[3]), cvtpk(p1[4], p1[5]), cvtpk(p1[6], p1[7])};
                pw[3] = (v4u){cvtpk(p1[8], p1[9]), cvtpk(p1[10], p1[11]), cvtpk(p1[12], p1[13]), cvtpk(p1[14], p1[15])};
#pragma unroll
                for (int db = 0; db < 4; ++db)
#pragma unroll
                    for (int ks = 0; ks < 4; ++ks) {
                        if (ks < 2 || !halftile) {
                            const s16x4 lo = vtr(Vt + db * 4096 + ks * 1024), hh = vtr(Vt + db * 4096 + ks * 1024 + 512);
                            const bf16x8 vf = (bf16x8){lo[0], lo[1], lo[2], lo[3], hh[0], hh[1], hh[2], hh[3]};
                            o[db] = __builtin_amdgcn_mfma_f32_32x32x16_bf16(__builtin_bit_cast(bf16x8, pw[ks]), vf, o[db], 0, 0, 0);
                        }
                    }
            }
        };
        constexpr int NC = PAST / 64;
        if (wave < 2) {
            __syncthreads();
#pragma unroll 1
            for (int t = 0; t < NC; t += 2) { tile(0, std::false_type{}); __syncthreads(); tile(1, std::false_type{}); __syncthreads(); }
            tile(2, std::true_type{});
        } else if (wave < 6) {
            f32x4 ra[16], rb[16];
            { v4u nk[4], nv[4];
              const int ltid = tid - 128;
#pragma unroll
              for (int i = 0; i < 4; ++i) {
                  const int kid = ltid + 256 * i, key = kid >> 4, c = kid & 15;
                  const int pz = lw + 4 * i, vkey = 16 * (pz & 3) + (lane >> 2), vd = 32 * (pz >> 2) + 8 * (lane & 3);
                  nk[i] = *(const v4u*)(Kb + (size_t)(MP + b * DT + (key & 31)) * DM + h * 128 + 8 * c);
                  nv[i] = *(const v4u*)(Vb + (size_t)(MP + b * DT + (vkey & 31)) * DM + h * 128 + vd);
              }
              ldraw(ra, 0); ldraw(rb, 1);
#pragma unroll
              for (int i = 0; i < 4; ++i) {
                  const int kid = ltid + 256 * i;
                  *(LAS v4u*)(lds + 2 * 32768 + koff(kid >> 4, kid & 15)) = nk[i];
                  *(LAS v4u*)(lds + 2 * 32768 + 16384 + (lw + 4 * i) * 1024 + lane * 16) = nv[i];
              } }
            wrraw(ra, 0); ldraw(ra, 2);
            __syncthreads();
#pragma unroll 1
            for (int t = 0; t < NC - 4; t += 2) {
                wrraw(rb, 1); ldraw(rb, t + 3); __syncthreads();
                wrraw(ra, 0); ldraw(ra, t + 4); __syncthreads();
            }
            wrraw(rb, 1); ldraw(rb, NC - 1); __syncthreads();
            wrraw(ra, 0); __syncthreads();
            wrraw(rb, 1); __syncthreads();
            __syncthreads();
        } else {
            __syncthreads();
#pragma unroll 1
            for (int t = 0; t < NC; ++t) __syncthreads();
        }
        __syncthreads();
    }
    unsigned nxt_unit = 0u;
    if (qhead && tid == 0) nxt_unit = __hip_atomic_fetch_add(qhead, 1u, __ATOMIC_RELAXED, __HIP_MEMORY_SCOPE_AGENT);
    LAS float* wsf = (LAS float*)(lds + L_WS) + wave * 64;
    l_reg += __shfl_xor(l_reg, 32);
    if (hi == 0) wsf[r32] = (map == 0 ? 1.0f : -lam) / l_reg;
    LDS_WAIT();
    LAS float* Tw = (LAS float*)(lds + rb * 16896) + hi * 528 + r32;
    const int rowo = row0 + (SAMPLE ? 0 : 32 * rb) + r32;
    v4u gaw[8];
#pragma unroll
    for (int i = 0; i < 8; ++i) gaw[i] = (v4u){0u, 0u, 0u, 0u};
    if (wactive && map == 0) { const bf16_t* gap = GA + (size_t)rowo * DM + h * 128 + 64 * hi;
#pragma unroll
        for (int i = 0; i < 8; ++i) gaw[i] = *(const v4u*)(gap + 8 * i); }
    if (wactive) {
#pragma unroll
        for (int r = 0; r < 16; ++r) { const float inv = wsf[crow(r, hi)];
#pragma unroll
            for (int db = 0; db < 4; ++db) o[db][r] *= inv; }
    }
    if (wactive && map == 1) {
#pragma unroll
        for (int db = 0; db < 4; ++db)
#pragma unroll
            for (int r = 0; r < 16; ++r) Tw[crow(r, 0) * 132 + 32 * db] = o[db][r];
    }
    __syncthreads();
    if (wactive && map == 0) {
#pragma unroll
        for (int db = 0; db < 4; ++db) {
#pragma unroll
            for (int r = 0; r < 16; ++r) o[db][r] += Tw[crow(r, 0) * 132 + 32 * db];
#pragma unroll
            for (int r = 0; r < 16; ++r) Tw[crow(r, 0) * 132 + 32 * db] = o[db][r];
            asm volatile("" ::: "memory");
        }
        f32x4 gsv[16];
        { const LAS float* gs = cst + 64 * hi;
#pragma unroll
          for (int i = 0; i < 16; ++i) gsv[i] = *(const LAS f32x4*)(gs + 4 * i); }
        LDS_WAIT();
        const LAS float* Tr = (const LAS float*)(lds + rb * 16896) + r32 * 132 + 64 * hi;
        float ss = 0.f;
#pragma unroll
        for (int i = 0; i < 16; ++i) { const f32x4 v = *(const LAS f32x4*)(Tr + 4 * i); ss += (v[0] * v[0] + v[1] * v[1]) + (v[2] * v[2] + v[3] * v[3]); }
        ss += __shfl_xor(ss, 32);
        const float rn = __builtin_amdgcn_rsqf(ss * (1.0f / 128.0f) + EPS) * (1.0f - LAM_INIT);
        bf16_t* mp = MIX + (size_t)rowo * 2048 + h * 128 + 64 * hi;
#pragma unroll
        for (int i = 0; i < 8; ++i) {
            const f32x4 v0 = *(const LAS f32x4*)(Tr + 8 * i), v1 = *(const LAS f32x4*)(Tr + 8 * i + 4);
            const v4u gw = gaw[i];
            const f32x4 a0 = (f32x4){__uint_as_float(gw.x << 16), __uint_as_float(gw.x & 0xffff0000u), __uint_as_float(gw.y << 16), __uint_as_float(gw.y & 0xffff0000u)};
            const f32x4 a1 = (f32x4){__uint_as_float(gw.z << 16), __uint_as_float(gw.z & 0xffff0000u), __uint_as_float(gw.w << 16), __uint_as_float(gw.w & 0xffff0000u)};
            const f32x4 r0 = v0 * rn * gsv[2 * i] * a0, r1 = v1 * rn * gsv[2 * i + 1] * a1;
            *(v4u*)(mp + 8 * i) = (v4u){cvtpk(r0[0], r0[1]), cvtpk(r0[2], r0[3]), cvtpk(r1[0], r1[1]), cvtpk(r1[2], r1[3])};
        }
    }
    if (qhead && tid == 0) ((volatile LAS unsigned*)(lds + MISC_OFF))[12] = nxt_unit;
}
}
namespace ret {
using att::cvtpk; using att::vtr;
__device__ __forceinline__ int ioff(int row, int ch) { return 256 * row + 16 * (ch ^ (((row & 3) << 2) | ((row >> 2) & 3))); }
__device__ __forceinline__ v4u scale8(const v4u w, float s) {
    v4u o;
    o.x = cvtpk(__uint_as_float(w.x << 16) * s, __uint_as_float(w.x & 0xffff0000u) * s); o.y = cvtpk(__uint_as_float(w.y << 16) * s, __uint_as_float(w.y & 0xffff0000u) * s);
    o.z = cvtpk(__uint_as_float(w.z << 16) * s, __uint_as_float(w.z & 0xffff0000u) * s); o.w = cvtpk(__uint_as_float(w.w << 16) * s, __uint_as_float(w.w & 0xffff0000u) * s);
    return o;
}
__device__ __forceinline__ bf16x8 mk8(const s16x4 a, const s16x4 b) { return (bf16x8){a[0], a[1], a[2], a[3], b[0], b[1], b[2], b[3]}; }
__device__ __forceinline__ bf16x8 mk8u(const v2u a, const v2u b) { const v4u w = (v4u){a.x, a.y, b.x, b.y}; return __builtin_bit_cast(bf16x8, w); }

template <bool SAMPLE>
__device__ __forceinline__ void ret_unit(const Args& a, LAS unsigned char* lds, int b, int h) {
    unsigned char* ws = a.ws;
    const bf16_t *QR = (const bf16_t*)(ws + WS_QR), *KR = (const bf16_t*)(ws + WS_KR), *VR = (const bf16_t*)(ws + WS_VR), *GS = (const bf16_t*)(ws + WS_GS), *GR = (const bf16_t*)(ws + WS_GR);
    bf16_t* MIX = (bf16_t*)(ws + WS_MIX);
    const float* grn = a.in[14];
    constexpr int T = SAMPLE ? DT : 64, NCH = SAMPLE ? 1 : 64;
    constexpr int IMG = 32768, P_IN = 65536, P_O = 81920;
    int tid_ = threadIdx.x; asm volatile("" : "+v"(tid_));
    const int tid = tid_, lane = tid & 63, l15 = lane & 15, fq = lane >> 4;
    const int w = __builtin_amdgcn_readfirstlane(tid >> 6);
    const float lg2 = log1pf(-exp2f(-5.0f - (float)h)) * LOG2E;
    const float cd = __builtin_amdgcn_exp2f(lg2 * (float)T);
    const float ginvT = __builtin_amdgcn_exp2f(-lg2 * (float)T);

    f32x4 S[4];
    { const float* sp = a.in[4] + ((size_t)(b * NH + h) * 64) * 128 + 16 * w + l15;
#pragma unroll
      for (int blk = 0; blk < 4; ++blk)
#pragma unroll
          for (int r = 0; r < 4; ++r) S[blk][r] = SAMPLE ? sp[(size_t)(16 * blk + 4 * fq + r) * 128] : 0.f; }

    const int stok = tid >> 3, sc8 = tid & 7;
    v4u qreg, kreg, vreg[2], gsr[2], grr[2];
    auto stage_load = [&](int c) {
        const int row = (SAMPLE ? MP + b * DT : b * SEQ + c * 64) + (SAMPLE ? (stok & 31) : stok);
        qreg = *(const v4u*)(QR + (size_t)row * 512 + h * 64 + 8 * sc8);
        kreg = *(const v4u*)(KR + (size_t)row * 512 + h * 64 + 8 * sc8);
        vreg[0] = *(const v4u*)(VR + (size_t)row * DM + h * 128 + 16 * sc8);
        vreg[1] = *(const v4u*)(VR + (size_t)row * DM + h * 128 + 16 * sc8 + 8);
    };
    auto gate_load = [&](int c) {
        const int row = (SAMPLE ? MP + b * DT : b * SEQ + c * 64) + (SAMPLE ? (stok & 31) : stok);
        gsr[0] = *(const v4u*)(GS + (size_t)row * DM + h * 128 + 16 * sc8); gsr[1] = *(const v4u*)(GS + (size_t)row * DM + h * 128 + 16 * sc8 + 8);
        grr[0] = *(const v4u*)(GR + (size_t)row * DM + h * 128 + 16 * sc8); grr[1] = *(const v4u*)(GR + (size_t)row * DM + h * 128 + 16 * sc8 + 8);
    };
    const float qd = __builtin_amdgcn_exp2f(lg2 * (float)(stok + 1)), kd = __builtin_amdgcn_exp2f(lg2 * (float)(T - 1 - stok));
    auto stage_write = [&](int buf) {
        const bool valid = stok < T;
        const v4u z = (v4u){0u, 0u, 0u, 0u};
        LAS unsigned char* im = lds + buf * IMG;
        *(LAS v4u*)(im + ioff(stok, sc8)) = valid ? scale8(qreg, qd) : z;
        *(LAS v4u*)(im + ioff(stok, 8 + sc8)) = valid ? scale8(kreg, kd) : z;
        *(LAS v4u*)(im + 16384 + ioff(stok, 2 * sc8)) = valid ? vreg[0] : z;
        *(LAS v4u*)(im + 16384 + ioff(stok, 2 * sc8 + 1)) = valid ? vreg[1] : z;
    };
    const int tq = (lane & 15) >> 2, tp = lane & 3;
    int vrel[2][2], krow[2][2];
#pragma unroll
    for (int s = 0; s < 2; ++s)
#pragma unroll
        for (int hf = 0; hf < 2; ++hf) { const int row = 32 * s + 8 * fq + tq + 4 * hf;
            vrel[s][hf] = 16384 + ioff(row, 2 * w + (tp >> 1)) + 8 * (tp & 1);
            krow[s][hf] = row; }
    f32x4 n0, n1, n2, n3;
    { const float* gp = grn + h * 128 + 16 * sc8; n0 = *(const f32x4*)gp; n1 = *(const f32x4*)(gp + 4); n2 = *(const f32x4*)(gp + 8); n3 = *(const f32x4*)(gp + 12); }
    stage_load(0);
    __syncthreads();
    stage_write(0);
    if (NCH > 1) stage_load(1);
    gate_load(0);
    LBAR();
    for (int c = 0; c < NCH; ++c) {
        const int row0 = SAMPLE ? MP + b * DT : b * SEQ + c * 64;
        const LAS unsigned char* im = lds + (c & 1) * IMG;
#pragma unroll
        for (int bi = 0; bi < 2; ++bi) {
            const int blk = 2 * w + bi, ib = blk >> 2, jb = blk & 3;
            f32x4 d = (f32x4){0.f, 0.f, 0.f, 0.f};
            if (jb <= ib) {
#pragma unroll
                for (int s = 0; s < 2; ++s) {
                    const bf16x8 kf = *(const LAS bf16x8*)(im + ioff(16 * jb + l15, 8 + 4 * s + fq));
                    const bf16x8 qf = *(const LAS bf16x8*)(im + ioff(16 * ib + l15, 4 * s + fq));
                    d = __builtin_amdgcn_mfma_f32_16x16x32_bf16(kf, qf, d, 0, 0, 0);
                }
                const int ti = 16 * ib + l15, tj0 = 16 * jb + 4 * fq;
#pragma unroll
                for (int r = 0; r < 4; ++r) d[r] = (ti - (tj0 + r) >= 0) ? d[r] * ginvT : 0.f;
            }
            *(LAS v2u*)(lds + P_IN + ioff(16 * ib + l15, 2 * jb + (fq >> 1)) + 8 * (fq & 1)) = (v2u){cvtpk(d[0], d[1]), cvtpk(d[2], d[3])};
        }
        bf16x8 vf[2];
#pragma unroll
        for (int s = 0; s < 2; ++s) vf[s] = mk8(vtr(im + vrel[s][0]), vtr(im + vrel[s][1]));
        f32x4 o[4];
        { bf16x8 sf[2];
#pragma unroll
          for (int s = 0; s < 2; ++s) { const v4u wv = (v4u){cvtpk(S[2 * s][0], S[2 * s][1]), cvtpk(S[2 * s][2], S[2 * s][3]), cvtpk(S[2 * s + 1][0], S[2 * s + 1][1]), cvtpk(S[2 * s + 1][2], S[2 * s + 1][3])};
              sf[s] = __builtin_bit_cast(bf16x8, wv); }
#pragma unroll
          for (int tb = 0; tb < 4; ++tb) { o[tb] = (f32x4){0.f, 0.f, 0.f, 0.f};
#pragma unroll
              for (int s = 0; s < 2; ++s) {
                  const int row = 16 * tb + l15;
                  const v2u q0 = *(const LAS v2u*)(im + ioff(row, 4 * s + (fq >> 1)) + 8 * (fq & 1));
                  const v2u q1 = *(const LAS v2u*)(im + ioff(row, 4 * s + 2 + (fq >> 1)) + 8 * (fq & 1));
                  o[tb] = __builtin_amdgcn_mfma_f32_16x16x32_bf16(mk8u(q0, q1), sf[s], o[tb], 0, 0, 0);
              } } }
#pragma unroll
        for (int blk = 0; blk < 4; ++blk) { S[blk] = S[blk] * cd;
#pragma unroll
            for (int s = 0; s < 2; ++s) {
                const bf16x8 kdf = mk8(vtr(im + ioff(krow[s][0], 8 + 2 * blk + (tp >> 1)) + 8 * (tp & 1)), vtr(im + ioff(krow[s][1], 8 + 2 * blk + (tp >> 1)) + 8 * (tp & 1)));
                S[blk] = __builtin_amdgcn_mfma_f32_16x16x32_bf16(kdf, vf[s], S[blk], 0, 0, 0);
            } }
        if (c + 1 < NCH) { stage_write((c + 1) & 1); if (c + 2 < NCH) stage_load(c + 2); }
        LBAR();
#pragma unroll
        for (int tb = 0; tb < 4; ++tb)
#pragma unroll
            for (int s = 0; s < 2; ++s) {
                const bf16x8 inf = *(const LAS bf16x8*)(lds + P_IN + ioff(16 * tb + l15, 4 * s + fq));
                o[tb] = __builtin_amdgcn_mfma_f32_16x16x32_bf16(inf, vf[s], o[tb], 0, 0, 0);
            }
        { LAS float* Os = (LAS float*)(lds + P_O) + (4 * fq) * 132 + 16 * w + l15;
#pragma unroll
          for (int tb = 0; tb < 4; ++tb)
#pragma unroll
              for (int r = 0; r < 4; ++r) Os[(16 * tb + r) * 132] = o[tb][r]; }
        LBAR();
        { const int tok = tid >> 3, seg = tid & 7;
          const LAS float* Or = (const LAS float*)(lds + P_O) + tok * 132 + 16 * seg;
          f32x4 v[4]; float ss = 0.f;
#pragma unroll
          for (int i = 0; i < 4; ++i) { v[i] = *(const LAS f32x4*)(Or + 4 * i); ss += (v[i][0] * v[i][0] + v[i][1] * v[i][1]) + (v[i][2] * v[i][2] + v[i][3] * v[i][3]); }
          ss += __shfl_xor(ss, 1); ss += __shfl_xor(ss, 2); ss += __shfl_xor(ss, 4);
          const float rn = __builtin_amdgcn_rsqf(ss * (1.0f / 128.0f) + EPS);
          if (tok < T) {
              const size_t row = (size_t)(row0 + tok); const int cc = h * 128 + 16 * seg;
              const v4u gs0 = gsr[0], gs1 = gsr[1], gr0 = grr[0], gr1 = grr[1];
#define BF4(wd, hf) ((f32x4){__uint_as_float(((hf) ? (wd).z : (wd).x) << 16), __uint_as_float(((hf) ? (wd).z : (wd).x) & 0xffff0000u), __uint_as_float(((hf) ? (wd).w : (wd).y) << 16), __uint_as_float(((hf) ? (wd).w : (wd).y) & 0xffff0000u)})
              const f32x4 r0 = v[0] * rn * n0 * BF4(gs0, 0) * BF4(gr0, 0), r1 = v[1] * rn * n1 * BF4(gs0, 1) * BF4(gr0, 1);
              const f32x4 r2 = v[2] * rn * n2 * BF4(gs1, 0) * BF4(gr1, 0), r3 = v[3] * rn * n3 * BF4(gs1, 1) * BF4(gr1, 1);
#undef BF4
              bf16_t* mp = MIX + row * 2048 + 1024 + cc;
              *(v4u*)mp = (v4u){cvtpk(r0[0], r0[1]), cvtpk(r0[2], r0[3]), cvtpk(r1[0], r1[1]), cvtpk(r1[2], r1[3])};
              *(v4u*)(mp + 8) = (v4u){cvtpk(r2[0], r2[1]), cvtpk(r2[2], r2[3]), cvtpk(r3[0], r3[1]), cvtpk(r3[2], r3[3])};
          }
          if (c + 1 < NCH) gate_load(c + 1); }
    }
    { float* op = a.out + (SAMPLE ? O_NRS : O_NRP) + ((size_t)(b * NH + h) * 64) * 128 + 16 * w + l15;
#pragma unroll
      for (int blk = 0; blk < 4; ++blk)
#pragma unroll
          for (int r = 0; r < 4; ++r) op[(size_t)(16 * blk + 4 * fq + r) * 128] = S[blk][r]; }
}
}
__device__ __forceinline__ int p2_pop(gu32* qhead, volatile LAS unsigned* MISC) {
    __syncthreads();
    if (threadIdx.x == 0) MISC[12] = __hip_atomic_fetch_add(qhead, 1u, __ATOMIC_RELAXED, __HIP_MEMORY_SCOPE_AGENT);
    __syncthreads();
    return (int)MISC[12];
}
__device__ __forceinline__ void p2_mixers(const Args& a, LAS unsigned char* lds, int rep) {
    constexpr int E_RP = 32, E_AP = E_RP + 1024, E_AS = E_AP + 256, E_RS = E_AS + 256, E_LW = E_RS + LW_ITEMS / 32;
    gu32* qhead = (gu32*)(a.ws + WS_CTL) + CW_QUEUE + 64 * rep;
    volatile LAS unsigned* MISC = (volatile LAS unsigned*)(lds + MISC_OFF);
    { LAS float* cst = (LAS float*)(lds + att::L_CONST);
      if (threadIdx.x < 128) cst[threadIdx.x] = a.in[13][threadIdx.x];
      if (threadIdx.x < 2) cst[128 + threadIdx.x] = ((const float*)(a.ws + WS_SC))[threadIdx.x];
      __syncthreads(); }
#ifdef PROBE_P2SUB
    if (rep == 1) {
        int r = p2_pop(qhead, MISC);
        if (PROBE_P2SUB == 1) while (r < 32) { ret::ret_unit<false>(a, lds, r >> 3, r & 7); r = p2_pop(qhead, MISC); }
#ifndef PROBE_ABL
#define PROBE_ABL 0
#endif
        if (PROBE_P2SUB == 2) while (r < 1024) { const int qb = 31 - (r >> 5), bh = r & 31; att::attn_unit<false, PROBE_ABL>(a, lds, bh >> 3, bh & 7, qb, (bf16_t*)(a.ws + WS_NS1)); r = p2_pop(qhead, MISC); }
        if (PROBE_P2SUB == 3) while (r < 256) { att::attn_unit<true>(a, lds, r >> 3, r & 7, 0); r = p2_pop(qhead, MISC); }
        if (PROBE_P2SUB == 5) while (r < 32) { att::attn_unit<true>(a, lds, r >> 3, r & 7, 0); r = p2_pop(qhead, MISC); }
        if (PROBE_P2SUB == 4) while (r < 256) { ret::ret_unit<true>(a, lds, r >> 3, r & 7); r = p2_pop(qhead, MISC); }
        return;
    }
#endif
#ifndef P2_R
#define P2_R 3
#endif
    constexpr int F_RP = 32, F_MIX = F_RP + 1280, F_LW = F_MIX + LW_ITEMS / 32, F_RS = F_LW + 256;
    constexpr int MIXED = 256 * (P2_R + 1);
    int r = p2_pop(qhead, MISC);
    while (r < F_RP) { ret::ret_unit<false>(a, lds, r >> 3, r & 7); r = p2_pop(qhead, MISC); }
    asm volatile("" ::: "memory");
    while (r < F_MIX) {
        while (r < F_MIX && !((r - F_RP) < MIXED && (r - F_RP) % (P2_R + 1) == P2_R)) {
            const int u = r - F_RP, pu = u < MIXED ? (u / (P2_R + 1)) * P2_R + u % (P2_R + 1) : u - 256, qb = 31 - (pu >> 5), bh = pu & 31;
            att::attn_unit<false>(a, lds, bh >> 3, bh & 7, qb, nullptr, qhead); __syncthreads(); r = (int)MISC[12]; }
        asm volatile("" ::: "memory");
        while (r < F_MIX && (r - F_RP) < MIXED && (r - F_RP) % (P2_R + 1) == P2_R) { const int g = (r - F_RP) / (P2_R + 1); att::attn_unit<true>(a, lds, g >> 3, g & 7, 0); r = p2_pop(qhead, MISC); }
        asm volatile("" ::: "memory");
    }
    {
        const int lw_wave = __builtin_amdgcn_readfirstlane(threadIdx.x >> 6);
        LAS float* scr = (LAS float*)(lds + lw_wave * 16384);
        while (r < F_LW) { const int u = r - F_MIX;
            if (rep == 0) {
#pragma unroll 1
                for (int i = 0; i < 4; ++i) late_weight_item(a, u * 32 + i * 8 + lw_wave, scr, threadIdx.x & 63); }
            r = p2_pop(qhead, MISC); }
    }
    asm volatile("" ::: "memory");
    while (r < F_RS) { const int u = r - F_LW; ret::ret_unit<true>(a, lds, u >> 3, u & 7); r = p2_pop(qhead, MISC); }
}
namespace sg {
__device__ __forceinline__ int logical_col(int p) { return (p & ~255) + 64 * ((p >> 5) & 3) + 32 * ((p >> 7) & 1) + (p & 31); }

template <class Epi>
__device__ __forceinline__ void sgemm_phase(LAS unsigned char* lds, const bf16_t* A  , const bf16_t* Wt, int K, int bx, int G, const Epi& E) {
    int t_ = threadIdx.x; asm volatile("" : "+v"(t_));
    const int tid = t_, lane = tid & 63, l15 = lane & 15, fq = lane >> 4, w = __builtin_amdgcn_readfirstlane(tid >> 6), wr = w >> 1, wc = w & 1;
    const int lds0 = (int)(size_t)lds;
    const int nkb = K / 128;
    for (int tile = bx; tile < 256; tile += G) {
        const int r0 = (tile >> 4) * 64, c0 = (tile & 15) * 64;
        auto dma_blk = [&](int kb, int slot_off) {
#pragma unroll
            for (int i = 0; i < 2; ++i) {
                const int kid = tid + 512 * i, row = kid >> 4, cl = kid & 15, csrc = cl ^ (((row & 3) << 2) | ((row >> 2) & 3));
                att::glds16(A + (size_t)(r0 + row) * K + kb * 128 + 8 * csrc, (unsigned)__builtin_amdgcn_readfirstlane(lds0 + slot_off + w * 1024 + i * 8192));
                att::glds16(Wt + (size_t)(c0 + row) * K + kb * 128 + 8 * csrc, (unsigned)__builtin_amdgcn_readfirstlane(lds0 + slot_off + 16384 + w * 1024 + i * 8192));
            }
        };
        f32x4 acc[2] = {(f32x4){0.f, 0.f, 0.f, 0.f}, (f32x4){0.f, 0.f, 0.f, 0.f}};
        asm volatile("s_waitcnt lgkmcnt(0)\n\ts_barrier" ::: "memory");
        dma_blk(0, 0); dma_blk(1, 32768);
        int s_cur = 0, s_n1 = 32768, s_n2 = 65536;
        for (int kb = 0; kb < nkb; ++kb) {
            if (kb + 1 < nkb) asm volatile("s_waitcnt vmcnt(4) lgkmcnt(0)\n\ts_barrier" ::: "memory");
            else asm volatile("s_waitcnt vmcnt(0) lgkmcnt(0)\n\ts_barrier" ::: "memory");
            if (kb + 2 < nkb) dma_blk(kb + 2, s_n2);
            const LAS unsigned char* Ai = lds + s_cur; const LAS unsigned char* Bi = lds + s_cur + 16384;
#pragma unroll
            for (int st = 0; st < 4; ++st) {
                const bf16x8 fa = *(const LAS bf16x8*)(Ai + ret::ioff(16 * wr + l15, 4 * st + fq));
                const bf16x8 fb0 = *(const LAS bf16x8*)(Bi + ret::ioff(32 * wc + l15, 4 * st + fq));
                const bf16x8 fb1 = *(const LAS bf16x8*)(Bi + ret::ioff(32 * wc + 16 + l15, 4 * st + fq));
                acc[0] = __builtin_amdgcn_mfma_f32_16x16x32_bf16(fb0, fa, acc[0], 0, 0, 0);
                acc[1] = __builtin_amdgcn_mfma_f32_16x16x32_bf16(fb1, fa, acc[1], 0, 0, 0);
            }
            { const int tmp = s_cur; s_cur = s_n1; s_n1 = s_n2; s_n2 = tmp; }
        }
        const int row = MP + r0 + 16 * wr + l15, p0 = c0 + 32 * wc + 4 * fq;
        E(row, logical_col(p0), acc[0], logical_col(p0 + 16), acc[1], fq);
    }
    asm volatile("s_waitcnt lgkmcnt(0)\n\ts_barrier" ::: "memory");
}

struct EpiStoreBf16 {
    bf16_t* O;
    __device__ __forceinline__ void operator()(int row, int c0, const f32x4 a0, int c1, const f32x4 a1, int) const {
        *(v2u*)(O + (size_t)row * DM + c0) = (v2u){att::cvtpk(a0[0], a0[1]), att::cvtpk(a0[2], a0[3])};
        *(v2u*)(O + (size_t)row * DM + c1) = (v2u){att::cvtpk(a1[0], a1[1]), att::cvtpk(a1[2], a1[3])};
    }
};
struct EpiResid {
    const float* base; float* Xo; bf16_t* Xg; const float* g; float* SS;
    __device__ __forceinline__ void operator()(int row, int c0, const f32x4 a0, int c1, const f32x4 a1, int fq) const {
        const size_t o0 = (size_t)row * DM + c0, o1 = (size_t)row * DM + c1;
        const f32x4 x0 = *(const f32x4*)(base + o0) + a0, x1 = *(const f32x4*)(base + o1) + a1;
        float ss = (x0[0] * x0[0] + x0[1] * x0[1]) + (x0[2] * x0[2] + x0[3] * x0[3]) + (x1[0] * x1[0] + x1[1] * x1[1]) + (x1[2] * x1[2] + x1[3] * x1[3]);
        *(f32x4*)(Xo + o0) = x0; *(f32x4*)(Xo + o1) = x1;
        const f32x4 g0 = *(const f32x4*)(g + c0), g1 = *(const f32x4*)(g + c1), y0 = x0 * g0, y1 = x1 * g1;
        *(v2u*)(Xg + o0) = (v2u){att::cvtpk(y0[0], y0[1]), att::cvtpk(y0[2], y0[3])};
        *(v2u*)(Xg + o1) = (v2u){att::cvtpk(y1[0], y1[1]), att::cvtpk(y1[2], y1[3])};
        ss += __shfl_xor(ss, 16); ss += __shfl_xor(ss, 32);
        if (fq == 0) atomicAdd(SS + row, ss);
    }
};
struct EpiFinal {
    const float* SS; const bf16_t* T; const float* y; float* yo;
    __device__ __forceinline__ void operator()(int row, int c0, const f32x4 a0, int c1, const f32x4 a1, int) const {
        const float r = __builtin_amdgcn_rsqf(SS[row] * (1.0f / DM) + EPS);
        const size_t o0 = (size_t)row * DM + c0, o1 = (size_t)row * DM + c1;
        const v2u t0 = *(const v2u*)(T + o0), t1 = *(const v2u*)(T + o1);
        const f32x4 tf0 = (f32x4){__uint_as_float(t0.x << 16), __uint_as_float(t0.x & 0xffff0000u), __uint_as_float(t0.y << 16), __uint_as_float(t0.y & 0xffff0000u)};
        const f32x4 tf1 = (f32x4){__uint_as_float(t1.x << 16), __uint_as_float(t1.x & 0xffff0000u), __uint_as_float(t1.y << 16), __uint_as_float(t1.y & 0xffff0000u)};
        *(f32x4*)(yo + o0) = *(const f32x4*)(y + o0) + pg8::sig4(a0 * r) * tf0;
        *(f32x4*)(yo + o1) = *(const f32x4*)(y + o1) + pg8::sig4(a1 * r) * tf1;
    }
};
}
#ifndef PG8_SP2
#define PG8_SP2 true
#endif
#ifndef PG8_ALIGN
#define PG8_ALIGN true
#endif
__global__ void __launch_bounds__(NTHREADS, 2) fwd(Args args) {
    extern __shared__ __attribute__((aligned(16))) unsigned char lds_raw[];
    LAS unsigned char* lds = (LAS unsigned char*)lds_raw;
    volatile LAS unsigned* MISC = (volatile LAS unsigned*)(lds + MISC_OFF);
    const int tid = threadIdx.x, lane = tid & 63, wave = __builtin_amdgcn_readfirstlane(tid >> 6);
    const int G = gridDim.x, bx = blockIdx.x;
    const int vcu = (G % 8 == 0) ? (bx % 8) * (G / 8) + bx / 8 : bx;
    gu32* ctl = (gu32*)(args.ws + WS_CTL);
    for (int u = tid; u < (LDS_BYTES - LDSCTL_OFF) / 4; u += NTHREADS) ((LAS unsigned*)(lds + LDSCTL_OFF))[u] = 0u;
    __syncthreads();
    const int lo = args.ph_lo, hi = args.ph_hi;
    const bool multi = (hi - lo) > 1;
    XcdBarrier bar; bar.bar = (unsigned*)ctl + CW_BAR + args.li * XCD_BAR_WORDS; bar.x = 0; bar.st = nullptr;
    if (multi) bar = xcd_barrier_post((unsigned*)ctl + CW_BAR + args.li * XCD_BAR_WORDS, MISC + 8);
#ifndef PHASE_MASK
#define PHASE_MASK 0x7f
#endif
#define WSB(T_, off) ((T_*)(args.ws + (off)))
#define IN(k) (((PHASE_MASK >> (k)) & 1) && lo <= (k) && (k) < hi)
#define SEAM(k) do { if (IN(k) && IN((k) + 1)) xcd_barrier(bar); } while (0)
#ifndef PROBE_REP
#define PROBE_REP (-1)
#endif
#define PHASE(k, ...) do { if (IN(k)) { { constexpr int rep = 0; (void)rep; __VA_ARGS__ } if (PROBE_REP == (k)) { xcd_barrier(bar); { constexpr int rep = 1; (void)rep; __VA_ARGS__ } } } } while (0)
    PHASE(0, { p0_prologue(args, lds, vcu * NWAVES + wave, G * NWAVES, lane); });
    SEAM(0);
    PHASE(1, {
        { pg8::Gemm g{WSB(bf16_t, WS_H), WSB(const bf16_t, WS_WIN), M, NIN, DM}; pg8::StaticOrder S; S.init(M, NIN, G, bx);
          pg8::EpiInProj E{args.in[9], args.in[10], args.out, args.ws, args.fc};
          pg8::gemm_phase<pg8::EpiInProj, pg8::StaticOrder, PG8_ALIGN, PG8_SP2>(lds + RING_OFF, g, S, E); }
        asm volatile("" ::: "memory");
        if (G != 256 || bx >= 128) {
          pg8::Gemm g{WSB(bf16_t, WS_PB), WSB(const bf16_t, WS_WPL), MP, DM, PLE}; pg8::StaticOrder S; S.init(MP, DM, G == 256 ? 128 : G, G == 256 ? (bx & 127) : bx);
          pg8::EpiStoreBf16 E{WSB(bf16_t, WS_T)};
          pg8::gemm_phase<pg8::EpiStoreBf16, pg8::StaticOrder, PG8_ALIGN, PG8_SP2>(lds + RING_OFF, g, S, E); }
        { sg::EpiStoreBf16 E{WSB(bf16_t, WS_T)}; sg::sgemm_phase(lds + RING_OFF, WSB(const bf16_t, WS_PB) + (size_t)MP * PLE, WSB(const bf16_t, WS_WPL), PLE, bx, G, E); }
    });
    SEAM(1);
    PHASE(2, { p2_mixers(args, lds, rep); });
    SEAM(2);
    PHASE(3, {
        { pg8::Gemm g{WSB(bf16_t, WS_MIX), WSB(const bf16_t, WS_WO), MP, DM, 2048}; pg8::StaticOrder S; S.init(MP, DM, G, bx);
          pg8::EpiResid E{args.in[0], args.in[1], WSB(float, WS_X1), WSB(bf16_t, WS_X1G), args.in[16], WSB(float, WS_SS + rep * 256 * 1024)};
          pg8::gemm_phase<pg8::EpiResid, pg8::StaticOrder, PG8_ALIGN, PG8_SP2>(lds + RING_OFF, g, S, E); }
        { sg::EpiResid E{args.in[1] - (size_t)MP * DM, WSB(float, WS_X1), WSB(bf16_t, WS_X1G), args.in[16], WSB(float, WS_SS + rep * 256 * 1024)};
          sg::sgemm_phase(lds + RING_OFF, WSB(const bf16_t, WS_MIX) + (size_t)MP * 2048, WSB(const bf16_t, WS_WO), 2048, bx, G, E); }
    });
    SEAM(3);
    PHASE(4, {
        pg8::Gemm g{WSB(bf16_t, WS_X1G), WSB(const bf16_t, WS_WGU), M, 2 * DFF, DM}; pg8::StaticOrder S; S.init(M, 2 * DFF, G, bx);
        pg8::EpiGateUp E{WSB(const float, WS_SS), WSB(bf16_t, WS_HID)};
        pg8::gemm_phase<pg8::EpiGateUp, pg8::StaticOrder, PG8_ALIGN, PG8_SP2>(lds + RING_OFF, g, S, E);
    });
    SEAM(4);
    PHASE(5, {
        { pg8::Gemm g{WSB(bf16_t, WS_HID), WSB(const bf16_t, WS_WDN), MP, DM, DFF}; pg8::StaticOrder S; S.init(MP, DM, G, bx);
          pg8::EpiResid E{WSB(const float, WS_X1), WSB(const float, WS_X1) + (size_t)MP * DM, args.out + O_Y, WSB(bf16_t, WS_X2G), args.in[20], WSB(float, WS_SS + 128 * 1024 + rep * 256 * 1024)};
          pg8::gemm_phase<pg8::EpiResid, pg8::StaticOrder, PG8_ALIGN, PG8_SP2>(lds + RING_OFF, g, S, E); }
        { sg::EpiResid E{WSB(const float, WS_X1), args.out + O_Y, WSB(bf16_t, WS_X2G), args.in[20], WSB(float, WS_SS + 128 * 1024 + rep * 256 * 1024)};
          sg::sgemm_phase(lds + RING_OFF, WSB(const bf16_t, WS_HID) + (size_t)MP * DFF, WSB(const bf16_t, WS_WDN), DFF, bx, G, E); }
    });
    SEAM(5);
#ifndef PROBE_P6SUB
#define PROBE_P6SUB 3
#endif
    if (PROBE_REP == 6 && IN(6)) {
        if (PROBE_P6SUB & 1) { pg8::Gemm g{WSB(bf16_t, WS_X2G), WSB(const bf16_t, WS_WPG), MP, DM, DM}; pg8::StaticOrder S; S.init(MP, DM, G, bx);
          pg8::EpiFinal E{WSB(const float, WS_SS + 128 * 1024), WSB(const bf16_t, WS_T), args.out + O_Y, WSB(float, WS_NS1)};
          pg8::gemm_phase<pg8::EpiFinal, pg8::StaticOrder, PG8_ALIGN, PG8_SP2>(lds + RING_OFF, g, S, E); }
        if (PROBE_P6SUB & 2) { sg::EpiFinal E{WSB(const float, WS_SS + 128 * 1024), WSB(const bf16_t, WS_T), args.out + O_Y, WSB(float, WS_NS1)};
          sg::sgemm_phase(lds + RING_OFF, WSB(const bf16_t, WS_X2G) + (size_t)MP * DM, WSB(const bf16_t, WS_WPG), DM, bx, G, E); }
        xcd_barrier(bar);
    }
    if (IN(6)) {
        { pg8::Gemm g{WSB(bf16_t, WS_X2G), WSB(const bf16_t, WS_WPG), MP, DM, DM}; pg8::StaticOrder S; S.init(MP, DM, G, bx);
          pg8::EpiFinal E{WSB(const float, WS_SS + 128 * 1024), WSB(const bf16_t, WS_T), args.out + O_Y, args.out + O_Y};
          pg8::gemm_phase<pg8::EpiFinal, pg8::StaticOrder, PG8_ALIGN, PG8_SP2>(lds + RING_OFF, g, S, E); }
        { sg::EpiFinal E{WSB(const float, WS_SS + 128 * 1024), WSB(const bf16_t, WS_T), args.out + O_Y, args.out + O_Y};
          sg::sgemm_phase(lds + RING_OFF, WSB(const bf16_t, WS_X2G) + (size_t)MP * DM, WSB(const bf16_t, WS_WPG), DM, bx, G, E); }
    }
#undef PHASE
#undef IN
#undef SEAM
}
extern "C" void kernel_launch(void* const* d_in, const int* in_sizes, int n_in, void* d_out, int out_size, void* d_ws, size_t ws_size, hipStream_t stream) {
    static int grid = 0;
    if (grid == 0) {
        if (n_in != 23 || out_size != (int)O_END || ws_size < WS_END) { fprintf(stderr, "kernel_launch: unexpected sizes n_in %d out %d ws %zu\n", n_in, out_size, ws_size); grid = -1; return; }
        int dev = 0, cus = 0;
        if (hipGetDevice(&dev) != hipSuccess || hipDeviceGetAttribute(&cus, hipDeviceAttributeMultiprocessorCount, dev) != hipSuccess) { grid = -1; return; }
        if (hipFuncSetAttribute((const void*)fwd, hipFuncAttributeMaxDynamicSharedMemorySize, LDS_BYTES) != hipSuccess) { fprintf(stderr, "kernel_launch: hipFuncSetAttribute failed\n"); grid = -1; return; }
        grid = cus;
    }
    if (grid < 0) return;
    Args a{};
    for (int i = 0; i < 23; ++i) a.in[i] = (const float*)d_in[i];
    a.out = (float*)d_out; a.ws = (unsigned char*)d_ws; a.ph_lo = 0; a.ph_hi = 7; a.li = 0; a.fc = -1;
    (void)hipMemsetAsync((unsigned char*)d_ws + WS_CTL, 0, CTL_ZERO_BYTES, stream);
#ifdef PROBE_LAUNCH_BASE
    a.ph_hi = 2; hipLaunchKernelGGL(fwd, dim3(grid), dim3(NTHREADS), LDS_BYTES, stream, a);
    a.ph_lo = 2; a.ph_hi = 7; a.li = 2; hipLaunchKernelGGL(fwd, dim3(grid), dim3(NTHREADS), LDS_BYTES, stream, a);
#elif defined(PROBE_LAUNCH_P1)
    a.ph_hi = 2; hipLaunchKernelGGL(fwd, dim3(grid), dim3(NTHREADS), LDS_BYTES, stream, a);
    a.ph_lo = 1; a.ph_hi = 2; a.li = 1; a.fc = PROBE_LAUNCH_P1; hipLaunchKernelGGL(fwd, dim3(grid), dim3(NTHREADS), LDS_BYTES, stream, a);
    a.ph_lo = 2; a.ph_hi = 7; a.li = 2; a.fc = -1; hipLaunchKernelGGL(fwd, dim3(grid), dim3(NTHREADS), LDS_BYTES, stream, a);
#else
    hipLaunchKernelGGL(fwd, dim3(grid), dim3(NTHREADS), LDS_BYTES, stream, a);
#endif
}
```

```cpp
#include <hip/hip_runtime.h>
#include <cstdint>
#include <cstdio>
#include <type_traits>

typedef unsigned short bf16_t;

constexpr int DM = 1024, SEQ = 4096, NB = 4, MP = NB * SEQ;
constexpr int DB = 32, DT = 32, MS = DB * DT, PAST = 2048;
constexpr int M = MP + MS;
constexpr int NIN = 8192, DFF = 2816, PLE = 256, NH = 8;
constexpr float EPS = 1e-6f;
constexpr float LAM_INIT = 0.2f;
constexpr float LOG2E = 1.4426950408889634f;
constexpr float QSCALE = 0.125f * LOG2E;

constexpr size_t O_Y = 0, O_NKP = 17825792, O_NVP = 34603008, O_NRP = 51380224, O_NKS = 51642368, O_NVS = 52690944, O_NRS = 53739520, O_END = 55836672;

constexpr size_t MiB = 1u << 20;
constexpr size_t WS_CTL = 0;
constexpr size_t WS_SC = 512 * 1024;
constexpr size_t WS_ROPE = 1 * MiB;
constexpr size_t WS_WIN = 4 * MiB;
constexpr size_t WS_WO = 20 * MiB;
constexpr size_t WS_WGU = 24 * MiB;
constexpr size_t WS_WDN = 35 * MiB;
constexpr size_t WS_WPG = 41 * MiB;
constexpr size_t WS_WPL = 43 * MiB;
constexpr size_t WS_H = 44 * MiB;
constexpr size_t WS_PB = 78 * MiB;
constexpr size_t WS_Q = 87 * MiB;
constexpr size_t WS_KB = 121 * MiB;
constexpr size_t WS_VB = 155 * MiB;
constexpr size_t WS_QR = 189 * MiB;
constexpr size_t WS_KR = 206 * MiB;
constexpr size_t WS_VR = 223 * MiB;
constexpr size_t WS_GS = 257 * MiB;
constexpr size_t WS_GA = 291 * MiB;
constexpr size_t WS_GR = 325 * MiB;
constexpr size_t WS_MIX = 359 * MiB;
constexpr size_t WS_X1 = 427 * MiB;
constexpr size_t WS_X1G = 495 * MiB;
constexpr size_t WS_SS = 529 * MiB;
constexpr size_t WS_SS0 = 529 * MiB + 768 * 1024;
constexpr size_t WS_HID = 530 * MiB;
constexpr size_t WS_X2G = 624 * MiB;
constexpr size_t WS_T = 658 * MiB;
constexpr size_t WS_NS1 = 692 * MiB;
constexpr size_t WS_NS2 = 828 * MiB;
constexpr size_t WS_END = 964 * MiB;

__device__ __forceinline__ float bf2f(bf16_t v) { return __uint_as_float((unsigned)v << 16); }
__device__ __forceinline__ bf16_t f2bf(float f) { unsigned u = __float_as_uint(f); return (bf16_t)((u + 0x7fffu + ((u >> 16) & 1u)) >> 16); }
__device__ __forceinline__ unsigned pk2(float lo, float hi) { return (unsigned)f2bf(lo) | ((unsigned)f2bf(hi) << 16); }
__device__ __forceinline__ float sigmoidf_(float x) { return 1.0f / (1.0f + __expf(-x)); }
__device__ __forceinline__ float siluf_(float x) { return x / (1.0f + __expf(-x)); }

struct Ptrs {
    const float* in[23];
    float* out;
    unsigned char* ws;
};
namespace pg8 {
#define PG8_LAS __attribute__((address_space(3)))
typedef unsigned short bf16_t;
typedef short bf16x8 __attribute__((ext_vector_type(8)));
typedef float f32x4 __attribute__((ext_vector_type(4)));
typedef unsigned u32x4 __attribute__((ext_vector_type(4)));
constexpr int BM = 256, BK = 64, HALF = 128, HTB = HALF * BK * 2  , STAGE_BYTES = 8 * HTB, NXCD = 8, WGM = 8;

__host__ __device__ __forceinline__ int lds_byte(int r, int c) { const int st = (r >> 4) * 2 + (c >> 5), rr = r & 15, cc = c & 31, ob = rr * 64 + cc * 2; return st * 1024 + (ob ^ (((ob >> 9) & 1) << 5)); }
__host__ __device__ __forceinline__ void stage_rc(int b, int& R, int& C) { const int st = b / 1024, sb = b % 1024, swz = sb ^ (((sb >> 9) & 1) << 5); R = (st >> 1) * 16 + swz / 64; C = (st & 1) * 32 + (swz % 64) / 2; }
__host__ __device__ __forceinline__ int perm32(int rho) { const int n = rho >> 4, i = rho & 15; return 8 * (i >> 2) + 4 * n + (i & 3); }

struct Unit { int pm, pn; };
struct Gemm { const bf16_t* A; const bf16_t* Bt; int M, N, K; };

struct StaticOrder {
    int nM, nN, nwg, G, c;
    __host__ __device__ void init(int M, int N, int G_, int c_) { nM = M / BM; nN = N / BM; nwg = nM * nN; G = G_; c = c_; }
    __host__ __device__ bool next(int i, Unit& u) const {
        const long L = (long)i * G + c; if (L >= nwg) return false;
        int wgid = (int)L; { const int q = nwg / NXCD, r = nwg % NXCD, xcd = wgid % NXCD, off = wgid / NXCD; wgid = (xcd < r ? xcd * (q + 1) : r * (q + 1) + (xcd - r) * q) + off; }
        const int nig = WGM * nN, gid = wgid / nig, fm = gid * WGM, gsz = (nM - fm) < WGM ? (nM - fm) : WGM;
        u.pm = fm + ((wgid % nig) % gsz); u.pn = (wgid % nig) / gsz; return true;
    }
    __device__ __forceinline__ void a_ready(const Unit&) const {}
    __device__ __forceinline__ void done(const Unit&) const {}
};
__device__ __forceinline__ unsigned cvt_pk_bf16(float lo, float hi) { unsigned r; asm volatile("v_cvt_pk_bf16_f32 %0, %1, %2" : "=v"(r) : "v"(lo), "v"(hi)); return r; }
typedef float f32x2 __attribute__((ext_vector_type(2)));
template <class Epi, class Sched, bool ALIGN_EPI = false, bool SP2 = false>
__device__ __forceinline__ void gemm_phase(PG8_LAS unsigned char* lds, const Gemm g, const Sched& S, const Epi& E) {
    const int tid = threadIdx.x, wid = __builtin_amdgcn_readfirstlane(tid >> 6), lane = tid & 63, wr = wid >> 2, wc = wid & 3, fr = lane & 15, fq = lane >> 4;
    const int K = g.K, nt = K / BK;
    unsigned voffA[2], voffB[2];
#pragma unroll
    for (int i = 0; i < 2; ++i) { int R, C; stage_rc(tid * 16 + i * 8192, R, C); const int Rb = Epi::PERM ? ((R & ~31) + perm32(R & 31)) : R;
        voffA[i] = (unsigned)(R * K + C) * 2u; voffB[i] = (unsigned)(Rb * K + C) * 2u; }
    const size_t kstep = (size_t)(BK * 2);
    const size_t hstep = (size_t)HALF * K * 2;
    const size_t tstep = 2 * hstep;
    const unsigned ldsw = (unsigned)wid * 1024u;
    const int aoff = lds_byte(wr * 64 + fr, fq * 8), boff = lds_byte(wc * 32 + fr, fq * 8);
#define PG8_SA(b, h) (((b) * 2 + (h)) * HTB)
#define PG8_SB(b, h) ((4 + (b) * 2 + (h)) * HTB)
#define PG8_STAGE(bufoff, gbase, voff) do { _Pragma("unroll") for (int _i = 0; _i < 2; ++_i) \
        __builtin_amdgcn_global_load_lds((const unsigned*)((const char*)(gbase) + (voff)[_i]), (PG8_LAS unsigned*)(lds + (bufoff) + ldsw + _i * 8192), 16, 0, 0); } while (0)
#define PG8_LDA(dst, b, h) do { _Pragma("unroll") for (int m = 0; m < 4; ++m) _Pragma("unroll") for (int k = 0; k < 2; ++k) dst[m][k] = *(const PG8_LAS bf16x8*)(lds + PG8_SA(b, h) + aoff + m * 2048 + k * 1024); } while (0)
#define PG8_LDB(dst, b, h) do { _Pragma("unroll") for (int n = 0; n < 2; ++n) _Pragma("unroll") for (int k = 0; k < 2; ++k) dst[n][k] = *(const PG8_LAS bf16x8*)(lds + PG8_SB(b, h) + boff + n * 2048 + k * 1024); } while (0)
#define PG8_MMA(ai, bj, At, Bt) do { __builtin_amdgcn_s_setprio(1); _Pragma("unroll") for (int m = 0; m < 4; ++m) _Pragma("unroll") for (int n = 0; n < 2; ++n) _Pragma("unroll") for (int k = 0; k < 2; ++k) \
        acc[ai][bj][m][n] = __builtin_amdgcn_mfma_f32_16x16x32_bf16(Bt[n][k], At[m][k], acc[ai][bj][m][n], 0, 0, 0); __builtin_amdgcn_s_setprio(0); } while (0)
#define PG8_WAIT_V(n) asm volatile("s_waitcnt vmcnt(" #n ")" ::: "memory")
#define PG8_WAIT_L(n) asm volatile("s_waitcnt lgkmcnt(" #n ")" ::: "memory")
#define PG8_BAR __builtin_amdgcn_s_barrier()
#define PG8_SCHED __builtin_amdgcn_sched_barrier(0)
    Unit cur, nxt; int ui = 0;
    if (!S.next(0, cur)) return;
    f32x4 acc[2][2][4][2];
#pragma unroll
    for (int a = 0; a < 2; ++a)
#pragma unroll
        for (int b = 0; b < 2; ++b)
#pragma unroll
            for (int m = 0; m < 4; ++m)
#pragma unroll
                for (int n = 0; n < 2; ++n) acc[a][b][m][n] = (f32x4){0.f, 0.f, 0.f, 0.f};
    bf16x8 At[4][2], B0[2][2], B1[2][2];
    const char* cA = (const char*)g.A + (size_t)cur.pm * tstep; const char* cB = (const char*)g.Bt + (size_t)cur.pn * tstep;
    S.a_ready(cur);
    if constexpr (SP2) {
        PG8_STAGE(PG8_SB(0, 0), cB, voffB); PG8_STAGE(PG8_SB(0, 1), cB + hstep, voffB); PG8_STAGE(PG8_SA(0, 0), cA, voffA); PG8_STAGE(PG8_SA(0, 1), cA + hstep, voffA);
        if (wr == 1) PG8_BAR;
        PG8_WAIT_V(2); PG8_BAR;
        PG8_STAGE(PG8_SB(1, 0), cB + kstep, voffB); PG8_STAGE(PG8_SA(1, 0), cA + kstep, voffA); PG8_STAGE(PG8_SB(1, 1), cB + hstep + kstep, voffB);
        PG8_WAIT_V(6); PG8_BAR;
    } else {
        PG8_STAGE(PG8_SB(0, 0), cB, voffB); PG8_STAGE(PG8_SA(0, 0), cA, voffA); PG8_STAGE(PG8_SB(0, 1), cB + hstep, voffB); PG8_STAGE(PG8_SA(0, 1), cA + hstep, voffA);
        if (wr == 1) PG8_BAR;
        PG8_WAIT_V(4); PG8_BAR;
        PG8_STAGE(PG8_SB(1, 0), cB + kstep, voffB); PG8_STAGE(PG8_SA(1, 0), cA + kstep, voffA); PG8_STAGE(PG8_SB(1, 1), cB + hstep + kstep, voffB);
        PG8_WAIT_V(6); PG8_BAR;
    }
    for (;;) {
        const bool has_next = S.next(ui + 1, nxt);
        const char* nA = has_next ? (const char*)g.A + (size_t)nxt.pm * tstep : cA; const char* nB = has_next ? (const char*)g.Bt + (size_t)nxt.pn * tstep : cB;
        for (int t = 0; t < nt; t += 2) {
            const bool last = (t == nt - 2);
            const char* a1 = cA + (size_t)(t + 1) * kstep;
            const char* a2 = last ? nA : cA + (size_t)(t + 2) * kstep; const char* b2 = last ? nB : cB + (size_t)(t + 2) * kstep;
            const char* a3 = a2 + kstep; const char* b3 = b2 + kstep;
            if (last && has_next) S.a_ready(nxt);
            if constexpr (SP2) {
            PG8_LDB(B0, 0, 0); PG8_LDB(B1, 0, 1); PG8_SCHED; PG8_LDA(At, 0, 0); PG8_STAGE(PG8_SA(1, 1), a1 + hstep, voffA);
            PG8_WAIT_V(8); PG8_WAIT_L(0); PG8_BAR; PG8_MMA(0, 0, At, B0); PG8_MMA(0, 1, At, B1); PG8_BAR; PG8_SCHED;
            PG8_LDA(At, 0, 1); PG8_STAGE(PG8_SB(0, 0), b2, voffB); PG8_STAGE(PG8_SB(0, 1), b2 + hstep, voffB); PG8_STAGE(PG8_SA(0, 0), a2, voffA);
            PG8_WAIT_V(8); PG8_WAIT_L(0); PG8_BAR; PG8_MMA(1, 0, At, B0); PG8_MMA(1, 1, At, B1); PG8_BAR; PG8_SCHED;
            PG8_LDB(B0, 1, 0); PG8_LDB(B1, 1, 1); PG8_SCHED; PG8_LDA(At, 1, 0); PG8_STAGE(PG8_SA(0, 1), a2 + hstep, voffA);
            PG8_WAIT_V(8); PG8_WAIT_L(0); PG8_BAR; PG8_MMA(0, 0, At, B0); PG8_MMA(0, 1, At, B1); PG8_BAR; PG8_SCHED;
            PG8_LDA(At, 1, 1); PG8_STAGE(PG8_SB(1, 0), b3, voffB); PG8_STAGE(PG8_SB(1, 1), b3 + hstep, voffB); PG8_STAGE(PG8_SA(1, 0), a3, voffA);
            PG8_WAIT_V(8); PG8_WAIT_L(0); PG8_BAR; PG8_MMA(1, 0, At, B0); PG8_MMA(1, 1, At, B1); PG8_BAR; PG8_SCHED;
            } else {
            PG8_LDB(B0, 0, 0); PG8_SCHED; PG8_LDA(At, 0, 0); PG8_STAGE(PG8_SA(1, 1), a1 + hstep, voffA);
            PG8_WAIT_L(8); PG8_BAR; PG8_WAIT_L(0); PG8_MMA(0, 0, At, B0); PG8_BAR; PG8_SCHED;
            PG8_LDB(B1, 0, 1); PG8_STAGE(PG8_SB(0, 0), b2, voffB);
            PG8_BAR; PG8_WAIT_L(0); PG8_MMA(0, 1, At, B1); PG8_BAR;
            PG8_LDA(At, 0, 1); PG8_STAGE(PG8_SA(0, 0), a2, voffA);
            PG8_BAR; PG8_WAIT_L(0); PG8_MMA(1, 0, At, B0); PG8_BAR; PG8_SCHED;
            PG8_STAGE(PG8_SB(0, 1), b2 + hstep, voffB);
            PG8_WAIT_V(6); PG8_BAR; PG8_MMA(1, 1, At, B1); PG8_BAR;
            PG8_LDB(B0, 1, 0); PG8_SCHED; PG8_LDA(At, 1, 0); PG8_STAGE(PG8_SA(0, 1), a2 + hstep, voffA);
            PG8_WAIT_L(8); PG8_BAR; PG8_WAIT_L(0); PG8_MMA(0, 0, At, B0); PG8_BAR; PG8_SCHED;
            PG8_LDB(B1, 1, 1); PG8_STAGE(PG8_SB(1, 0), b3, voffB);
            PG8_BAR; PG8_WAIT_L(0); PG8_MMA(0, 1, At, B1); PG8_BAR;
            PG8_LDA(At, 1, 1); PG8_STAGE(PG8_SA(1, 0), a3, voffA);
            PG8_BAR; PG8_WAIT_L(0); PG8_MMA(1, 0, At, B0); PG8_BAR; PG8_SCHED;
            PG8_STAGE(PG8_SB(1, 1), b3 + hstep, voffB);
            PG8_WAIT_V(6); PG8_BAR; PG8_MMA(1, 1, At, B1); PG8_BAR;
            }
        }
        if constexpr (ALIGN_EPI) { if (wr == 0) PG8_BAR; }
        if constexpr (!Epi::AFTER_DRAIN) { E(acc, cur, wr, wc, fr, fq); S.done(cur); }
        if (!has_next) break;
#pragma unroll
        for (int a = 0; a < 2; ++a)
#pragma unroll
            for (int b = 0; b < 2; ++b)
#pragma unroll
                for (int m = 0; m < 4; ++m)
#pragma unroll
                    for (int n = 0; n < 2; ++n) acc[a][b][m][n] = (f32x4){0.f, 0.f, 0.f, 0.f};
        cur = nxt; cA = nA; cB = nB; ++ui;
        if constexpr (ALIGN_EPI) { if (wr == 1) PG8_BAR; }
    }
    PG8_WAIT_V(0);
    if constexpr (!ALIGN_EPI) { if (wr == 0) PG8_BAR; }
    PG8_BAR;
    if constexpr (Epi::AFTER_DRAIN) { E.fused(acc, cur, wr, wc, fr, fq, lds, wid, lane); S.done(cur); }
#undef PG8_SA
#undef PG8_SB
#undef PG8_STAGE
#undef PG8_LDA
#undef PG8_LDB
#undef PG8_MMA
#undef PG8_WAIT_V
#undef PG8_WAIT_L
#undef PG8_BAR
#undef PG8_SCHED
}
}
#define GAS __attribute__((address_space(1)))
#define LAS __attribute__((address_space(3)))
typedef unsigned v4u __attribute__((ext_vector_type(4)));
typedef unsigned v2u __attribute__((ext_vector_type(2)));
typedef float f32x4 __attribute__((ext_vector_type(4)));
typedef float f32x16 __attribute__((ext_vector_type(16)));
typedef short bf16x8 __attribute__((ext_vector_type(8)));
typedef short s16x4 __attribute__((ext_vector_type(4)));
typedef GAS unsigned gu32;
#define LDS_WAIT() asm volatile("s_waitcnt lgkmcnt(0)" ::: "memory")
#define VM_WAIT() asm volatile("s_waitcnt vmcnt(0)" ::: "memory")
#define LBAR() asm volatile("s_waitcnt lgkmcnt(0)\n\ts_barrier" ::: "memory")

constexpr int NWAVES = 8, NTHREADS = 512;
constexpr int RING_OFF = 0, RING_BYTES = 131072;
constexpr int LDSCTL_OFF = RING_BYTES, MISC_OFF = LDSCTL_OFF + 320;
constexpr int LDS_BYTES = 147456;
constexpr int CW_BAR = 4096;
constexpr int CW_QUEUE = 1024;
constexpr size_t CTL_ZERO_BYTES = 64 * 1024;

#define XB_TMO      128
#define XB_XCNT(j)  (256  + 64 * (j))
#define XB_XSUB(j)  (1280 + 64 * (j))
#define XB_XGEN(j)  (2304 + 64 * (j))
#define XB_TOP      3328
#define XB_TOPGEN   3392
#define XCD_BAR_WORDS 3456
#define XB_SPIN_CAP (1u << 18)

__device__ __forceinline__ unsigned xb_ld(unsigned* p)              { return __hip_atomic_load(p, __ATOMIC_RELAXED, __HIP_MEMORY_SCOPE_AGENT); }
__device__ __forceinline__ unsigned xb_add(unsigned* p, unsigned v) { return __hip_atomic_fetch_add(p, v, __ATOMIC_RELAXED, __HIP_MEMORY_SCOPE_AGENT); }
__device__ __forceinline__ unsigned xb_xcc_id() { return (unsigned)__builtin_amdgcn_s_getreg((3 << 11) | 20) & 0xFu; }
#define XB_SPIN(cond, bar) do { unsigned _sp = 0; while (cond) { __builtin_amdgcn_s_sleep(1); \
    if ((++_sp & 255u) == 0u) { if (xb_ld(&(bar)[XB_TMO])) break; if (_sp > XB_SPIN_CAP) { atomicAdd(&(bar)[XB_TMO], 1u); break; } } } } while (0)

struct XcdBarrier {
    unsigned* bar; unsigned x;
    volatile LAS unsigned* st;
};

__device__ __forceinline__ XcdBarrier xcd_barrier_post(unsigned* bar, volatile LAS unsigned* st) {
    XcdBarrier b; b.bar = bar; b.x = xb_xcc_id(); b.st = st;
    if (threadIdx.x == 0) (void)xb_add(&bar[XB_XCNT(b.x)], 1u);
    return b;
}
__device__ __forceinline__ void xcd_barrier_complete(unsigned* bar, unsigned x, unsigned& nloc, unsigned& nx) {
    const unsigned G = gridDim.x * gridDim.y * gridDim.z;
    unsigned sum, cnt, mine, sp = 0u;
    for (;;) {
        sum = 0u; cnt = 0u; mine = 0u;
#pragma unroll
        for (unsigned j = 0; j < 16; ++j) { const unsigned c = xb_ld(&bar[XB_XCNT(j)]); sum += c; cnt += (c > 0u) ? 1u : 0u; mine = (j == x) ? c : mine; }
        if (sum == G) break;
        __builtin_amdgcn_s_sleep(1);
        if ((++sp & 255u) == 0u) { if (xb_ld(&bar[XB_TMO])) break; if (sp > XB_SPIN_CAP) { atomicAdd(&bar[XB_TMO], 1u); break; } }
    }
    nloc = mine > 0u ? mine : 1u; nx = cnt > 0u ? cnt : 1u;
}

__device__ __forceinline__ void xcd_barrier(const XcdBarrier& b) {
    asm volatile("s_waitcnt vmcnt(0)" ::: "memory");
    __syncthreads();
    if (threadIdx.x == 0) {
        unsigned* bar = b.bar;
        __builtin_amdgcn_s_waitcnt(0);
        unsigned nloc = b.st[0], nx = b.st[1];
        if (nloc == 0u) { xcd_barrier_complete(bar, b.x, nloc, nx); b.st[0] = nloc; b.st[1] = nx; }
        const unsigned old = xb_add(&bar[XB_XSUB(b.x)], 1u);
        const unsigned gen = old / nloc;
        if (old + 1u == (gen + 1u) * nloc) {
            __builtin_amdgcn_fence(__ATOMIC_RELEASE, "agent");
            asm volatile("s_waitcnt vmcnt(0)" ::: "memory");
            const unsigned og = xb_add(&bar[XB_TOP], 1u);
            const unsigned tg = og / nx;
            if (og + 1u == (tg + 1u) * nx) xb_add(&bar[XB_TOPGEN], 1u);
            else XB_SPIN(xb_ld(&bar[XB_TOPGEN]) == tg, bar);
            __builtin_amdgcn_fence(__ATOMIC_ACQUIRE, "agent");
            xb_add(&bar[XB_XGEN(b.x)], 1u);
            asm volatile("s_waitcnt vmcnt(0)" ::: "memory");
        } else {
            XB_SPIN(xb_ld(&bar[XB_XGEN(b.x)]) == gen, bar);
            __builtin_amdgcn_fence(__ATOMIC_ACQUIRE, "agent");
            asm volatile("s_waitcnt vmcnt(0)" ::: "memory");
        }
    }
    __syncthreads();
}
namespace pg8 {
#define PG8_LANEPOS int t_ = threadIdx.x; asm volatile("" : "+v"(t_)); const int wid_ = __builtin_amdgcn_readfirstlane(t_ >> 6), wr = wid_ >> 2, wc = wid_ & 3, fr = t_ & 15, fq = (t_ >> 4) & 3

__device__ __forceinline__ u32x4 pack8(const f32x4 a, const f32x4 b) { u32x4 w; w.x = cvt_pk_bf16(a[0], a[1]); w.y = cvt_pk_bf16(a[2], a[3]); w.z = cvt_pk_bf16(b[0], b[1]); w.w = cvt_pk_bf16(b[2], b[3]); return w; }
__device__ __forceinline__ float fsig(float x) { return __builtin_amdgcn_rcpf(1.0f + __builtin_amdgcn_exp2f(-LOG2E * x)); }
__device__ __forceinline__ f32x4 sig4(const f32x4 v) { return (f32x4){fsig(v[0]), fsig(v[1]), fsig(v[2]), fsig(v[3])}; }
__device__ __forceinline__ f32x4 silu4(const f32x4 v) { return (f32x4){v[0] * fsig(v[0]), v[1] * fsig(v[1]), v[2] * fsig(v[2]), v[3] * fsig(v[3])}; }
__device__ __forceinline__ f32x4 bf4_lo(const u32x4 w, int half) {
    const unsigned a = half ? w.z : w.x, b = half ? w.w : w.y;
    return (f32x4){__uint_as_float(a << 16), __uint_as_float(a & 0xffff0000u), __uint_as_float(b << 16), __uint_as_float(b & 0xffff0000u)};
}

struct EpiInProj {
    static constexpr bool PERM = true, AFTER_DRAIN = false;
    const float* gq; const float* gk; float* out; unsigned char* ws; int force_cat;
    __device__ __forceinline__ void operator()(const f32x4 (&acc)[2][2][4][2], const Unit& u, int, int, int, int) const {
        PG8_LANEPOS;
        const int pn = u.pn, cat = force_cat >= 0 ? force_cat : (pn >> 2);
        const int row0 = u.pm * BM + wr * 64 + fr;
        const int lc0 = (pn & 3) * 256 + wc * 64 + 8 * fq;
        const bool smp = u.pm >= (MP / BM);
        bf16_t* const Q = (bf16_t*)(ws + WS_Q); bf16_t* const Kb = (bf16_t*)(ws + WS_KB);
        float rx[2][4];
#pragma unroll
        for (int ai = 0; ai < 2; ++ai)
#pragma unroll
            for (int m = 0; m < 4; ++m) rx[ai][m] = ((const float*)(ws + WS_SS0))[row0 + ai * HALF + m * 16];
#pragma unroll
        for (int ai = 0; ai < 2; ++ai)
#pragma unroll
            for (int m = 0; m < 4; ++m) rx[ai][m] = __builtin_amdgcn_rsqf(rx[ai][m] * (1.0f / DM) + EPS);
        if (cat == 0 || cat == 1) {
            const float* g = cat == 0 ? gq : gk; f32x4 gv[2][2];
#pragma unroll
            for (int bj = 0; bj < 2; ++bj)
#pragma unroll
                for (int n = 0; n < 2; ++n) { gv[bj][n] = *(const f32x4*)(g + 32 * bj + 8 * fq + 4 * n); if (cat == 0) gv[bj][n] = gv[bj][n] * QSCALE; }
            float* ok = smp ? out + O_NKS - (size_t)MP * DM : out + O_NKP;
            float rs[2][4];
#pragma unroll
            for (int ai = 0; ai < 2; ++ai)
#pragma unroll
                for (int m = 0; m < 4; ++m) { float ss = 0.f;
#pragma unroll
                    for (int bj = 0; bj < 2; ++bj)
#pragma unroll
                        for (int n = 0; n < 2; ++n) { const f32x4 v = acc[ai][bj][m][n]; ss += (v[0] * v[0] + v[1] * v[1]) + (v[2] * v[2] + v[3] * v[3]); }
                    rs[ai][m] = ss; }
#pragma unroll
            for (int ai = 0; ai < 2; ++ai)
#pragma unroll
                for (int m = 0; m < 4; ++m) rs[ai][m] += __shfl_xor(rs[ai][m], 16);
#pragma unroll
            for (int ai = 0; ai < 2; ++ai)
#pragma unroll
                for (int m = 0; m < 4; ++m) rs[ai][m] += __shfl_xor(rs[ai][m], 32);
#pragma unroll
            for (int ai = 0; ai < 2; ++ai)
#pragma unroll
                for (int m = 0; m < 4; ++m) { const int row = row0 + ai * HALF + m * 16;
                    const float r = rx[ai][m] * __builtin_amdgcn_rsqf(rs[ai][m] * (rx[ai][m] * rx[ai][m]) * (1.0f / 64.0f) + EPS);
#pragma unroll
                    for (int bj = 0; bj < 2; ++bj) { const f32x4 a = acc[ai][bj][m][0] * r * gv[bj][0], b = acc[ai][bj][m][1] * r * gv[bj][1];
                        const size_t off = (size_t)row * DM + lc0 + 32 * bj;
                        if (cat == 0) { *(u32x4*)(Q + off) = pack8(a, b); }
                        else { *(f32x4*)(ok + off) = a; *(f32x4*)(ok + off + 4) = b; *(u32x4*)(Kb + off) = pack8(a, b); } } }
        } else if (cat == 2 || cat == 8) {
            float* ov = cat == 8 ? (float*)(ws + WS_NS2) : smp ? out + O_NVS - (size_t)MP * DM : out + O_NVP;
            bf16_t* const Vb = (bf16_t*)(ws + (cat == 8 ? WS_NS1 : WS_VB));
#pragma unroll
            for (int ai = 0; ai < 2; ++ai)
#pragma unroll
                for (int m = 0; m < 4; ++m) { const int row = row0 + ai * HALF + m * 16;
#pragma unroll
                    for (int bj = 0; bj < 2; ++bj) { const f32x4 a = acc[ai][bj][m][0] * rx[ai][m], b = acc[ai][bj][m][1] * rx[ai][m]; const size_t off = (size_t)row * DM + lc0 + 32 * bj;
                        *(f32x4*)(ov + off) = a; *(f32x4*)(ov + off + 4) = b; *(u32x4*)(Vb + off) = pack8(a, b); } }
        } else if (cat == 3) {
            const int g64 = (pn - 12) * 4 + wc, hh = g64 & 7; const bool isk = g64 >= 8;
            bf16_t* dst = (bf16_t*)(ws + (isk ? WS_KR : WS_QR)); const float sc = isk ? 0.125f : 1.0f;
            f32x4 rv[2];
#pragma unroll
            for (int n = 0; n < 2; ++n)
#pragma unroll
                for (int e = 0; e < 4; ++e) rv[n][e] = __builtin_amdgcn_exp2f(-(float)(8 * fq + 4 * n + e) * (13.287712379549449f / 32.0f));
#pragma unroll
            for (int ai = 0; ai < 2; ++ai)
#pragma unroll
                for (int m = 0; m < 4; ++m) { const int row = row0 + ai * HALF + m * 16;
                    const float pos = (float)(smp ? PAST + ((row - MP) & 31) : (row & 4095));
                    f32x4 o1[2], o2[2];
#pragma unroll
                    for (int n = 0; n < 2; ++n) { f32x4 cs, sn;
#pragma unroll
                        for (int e = 0; e < 4; ++e) { const float ang = pos * rv[n][e]; const float fr = __builtin_amdgcn_fractf(ang * 0.15915494309189535f);
                            cs[e] = __builtin_amdgcn_cosf(fr); sn[e] = __builtin_amdgcn_sinf(fr); }
                        const f32x4 x1 = acc[ai][0][m][n], x2 = acc[ai][1][m][n];
                        o1[n] = (x1 * cs - x2 * sn) * (sc * rx[ai][m]); o2[n] = (x1 * sn + x2 * cs) * (sc * rx[ai][m]); }
                    const size_t off = (size_t)row * 512 + hh * 64 + 8 * fq;
                    *(u32x4*)(dst + off) = pack8(o1[0], o1[1]); *(u32x4*)(dst + off + 32) = pack8(o2[0], o2[1]); }
        } else {
            bf16_t* dst = (bf16_t*)(ws + (force_cat >= 0 ? WS_NS1 : cat == 4 ? WS_VR : cat == 5 ? WS_GS : cat == 6 ? WS_GA : WS_GR));
#pragma unroll
            for (int ai = 0; ai < 2; ++ai)
#pragma unroll
                for (int m = 0; m < 4; ++m) { const int row = row0 + ai * HALF + m * 16;
#pragma unroll
                    for (int bj = 0; bj < 2; ++bj) { f32x4 a = acc[ai][bj][m][0] * rx[ai][m], b = acc[ai][bj][m][1] * rx[ai][m];
                        if (cat == 5) { a = silu4(a); b = silu4(b); } else if (cat >= 6) { a = sig4(a); b = sig4(b); }
                        *(u32x4*)(dst + (size_t)row * DM + lc0 + 32 * bj) = pack8(a, b); } }
        }
    }
};

struct EpiStoreBf16 {
    static constexpr bool PERM = true, AFTER_DRAIN = false;
    bf16_t* O;
    __device__ __forceinline__ void operator()(const f32x4 (&acc)[2][2][4][2], const Unit& u, int, int, int, int) const {
        PG8_LANEPOS;
        const int row0 = u.pm * BM + wr * 64 + fr, col0 = u.pn * BM + wc * 64 + 8 * fq;
#pragma unroll
        for (int ai = 0; ai < 2; ++ai)
#pragma unroll
            for (int m = 0; m < 4; ++m)
#pragma unroll
                for (int bj = 0; bj < 2; ++bj) *(u32x4*)(O + (size_t)(row0 + ai * HALF + m * 16) * DM + col0 + 32 * bj) = pack8(acc[ai][bj][m][0], acc[ai][bj][m][1]);
    }
};

template <bool BASE_BF16>
struct EpiResidB {
    static constexpr bool PERM = true, AFTER_DRAIN = false;
    const float* base0; const float* base1;
    const bf16_t* baseb;
    bf16_t* Xb; float* SS;
    __device__ __forceinline__ void operator()(const f32x4 (&acc)[2][2][4][2], const Unit& u, int, int, int, int) const {
        PG8_LANEPOS;
        const int row0 = u.pm * BM + wr * 64 + fr, col0 = u.pn * BM + wc * 64 + 8 * fq;
        const float* base = u.pm >= (MP / BM) ? base1 - (size_t)MP * DM : base0;
#pragma unroll
        for (int ai = 0; ai < 2; ++ai) {
            f32x4 r[4][2][2]; u32x4 rb[4][2];
#pragma unroll
            for (int m = 0; m < 4; ++m)
#pragma unroll
                for (int bj = 0; bj < 2; ++bj) { const size_t off = (size_t)(row0 + ai * HALF + m * 16) * DM + col0 + 32 * bj;
                    if (BASE_BF16) rb[m][bj] = *(const u32x4*)(baseb + off);
                    else { r[m][bj][0] = *(const f32x4*)(base + off); r[m][bj][1] = *(const f32x4*)(base + off + 4); } }
            asm volatile("" ::: "memory");
#pragma unroll
            for (int m = 0; m < 4; ++m) { const int row = row0 + ai * HALF + m * 16; float ss = 0.f;
#pragma unroll
                for (int bj = 0; bj < 2; ++bj) { const size_t off = (size_t)row * DM + col0 + 32 * bj;
                    const f32x4 a = (BASE_BF16 ? bf4_lo(rb[m][bj], 0) : r[m][bj][0]) + acc[ai][bj][m][0], b = (BASE_BF16 ? bf4_lo(rb[m][bj], 1) : r[m][bj][1]) + acc[ai][bj][m][1];
                    ss += (a[0] * a[0] + a[1] * a[1]) + (a[2] * a[2] + a[3] * a[3]) + (b[0] * b[0] + b[1] * b[1]) + (b[2] * b[2] + b[3] * b[3]);
                    *(u32x4*)(Xb + off) = pack8(a, b); }
                ss += __shfl_xor(ss, 16); ss += __shfl_xor(ss, 32);
                if (fq == 0) atomicAdd(SS + row, ss); }
            asm volatile("" ::: "memory");
        }
    }
};

struct EpiGateUp {
    static constexpr bool PERM = true, AFTER_DRAIN = false;
    const float* SS; bf16_t* HID;
    __device__ __forceinline__ void operator()(const f32x4 (&acc)[2][2][4][2], const Unit& u, int, int, int, int) const {
        PG8_LANEPOS;
        const int row0 = u.pm * BM + wr * 64 + fr, col0 = u.pn * 128 + wc * 32 + 8 * fq;
        float sv[2][4];
#pragma unroll
        for (int ai = 0; ai < 2; ++ai)
#pragma unroll
            for (int m = 0; m < 4; ++m) sv[ai][m] = SS[row0 + ai * HALF + m * 16];
        asm volatile("" ::: "memory");
#pragma unroll
        for (int ai = 0; ai < 2; ++ai)
#pragma unroll
            for (int m = 0; m < 4; ++m) { const int row = row0 + ai * HALF + m * 16;
                const float r = __builtin_amdgcn_rsqf(sv[ai][m] * (1.0f / DM) + EPS);
                const f32x4 g0 = acc[ai][0][m][0] * r, g1 = acc[ai][0][m][1] * r, u0 = acc[ai][1][m][0] * r, u1 = acc[ai][1][m][1] * r;
                *(u32x4*)(HID + (size_t)row * DFF + col0) = pack8(silu4(g0) * u0, silu4(g1) * u1); }
    }
};

struct EpiFinalB {
    static constexpr bool PERM = true, AFTER_DRAIN = false;
    const float* SS; const bf16_t* T; const bf16_t* xb; float* yo;
    __device__ __forceinline__ void operator()(const f32x4 (&acc)[2][2][4][2], const Unit& u, int, int, int, int) const {
        PG8_LANEPOS;
        const int row0 = u.pm * BM + wr * 64 + fr, col0 = u.pn * BM + wc * 64 + 8 * fq;
#pragma unroll
        for (int ai = 0; ai < 2; ++ai) {
            u32x4 xv[4][2], tv[4][2]; float sv[4];
#pragma unroll
            for (int m = 0; m < 4; ++m) { const int row = row0 + ai * HALF + m * 16; sv[m] = SS[row];
#pragma unroll
                for (int bj = 0; bj < 2; ++bj) { const size_t off = (size_t)row * DM + col0 + 32 * bj; xv[m][bj] = *(const u32x4*)(xb + off); tv[m][bj] = *(const u32x4*)(T + off); } }
            asm volatile("" ::: "memory");
#pragma unroll
            for (int m = 0; m < 4; ++m) { const int row = row0 + ai * HALF + m * 16;
                const float r = __builtin_amdgcn_rsqf(sv[m] * (1.0f / DM) + EPS);
#pragma unroll
                for (int bj = 0; bj < 2; ++bj) { const size_t off = (size_t)row * DM + col0 + 32 * bj;
                    const f32x4 a = bf4_lo(xv[m][bj], 0) + sig4(acc[ai][bj][m][0] * r) * bf4_lo(tv[m][bj], 0), b = bf4_lo(xv[m][bj], 1) + sig4(acc[ai][bj][m][1] * r) * bf4_lo(tv[m][bj], 1);
                    *(f32x4*)(yo + off) = a; *(f32x4*)(yo + off + 4) = b; } }
            asm volatile("" ::: "memory");
        }
    }
};

}
struct Args { const float* in[23]; float* out; unsigned char* ws; int ph_lo, ph_hi, li, fc; };

__device__ __forceinline__ void transpose_item(const float* src, int ldw, bf16_t* dst, int ldk, LAS float* scr, int lane, const float* ks = nullptr) {
    float tv[32];
#pragma unroll
    for (int i = 0; i < 32; ++i) tv[i] = src[(size_t)(2 * i + (lane >> 5)) * ldw + (lane & 31)];
    if (ks) {
#pragma unroll
        for (int i = 0; i < 32; ++i) tv[i] *= ks[2 * i + (lane >> 5)];
    }
#pragma unroll
    for (int i = 0; i < 32; ++i) scr[(2 * i + (lane >> 5)) * 33 + (lane & 31)] = tv[i];
    LDS_WAIT(); asm volatile("" ::: "memory");
    const int c = lane & 7;
#pragma unroll
    for (int j = 0; j < 4; ++j) { const int n = (lane >> 3) + 8 * j; const LAS float* s = scr + (8 * c) * 33 + n;
        v4u o; o.x = pk2(s[0 * 33], s[1 * 33]); o.y = pk2(s[2 * 33], s[3 * 33]); o.z = pk2(s[4 * 33], s[5 * 33]); o.w = pk2(s[6 * 33], s[7 * 33]);
        *(v4u*)(dst + (size_t)n * ldk + 8 * c) = o; }
    LDS_WAIT(); asm volatile("" ::: "memory");
}

__device__ __forceinline__ int perm_col0(int g32) { const int pn = g32 >> 3, bj = (g32 >> 2) & 1, wc = g32 & 3; return 256 * pn + 64 * wc + 32 * bj; }

constexpr int LW_I_O = (DM / 32) * (2048 / 64), LW_I_GU = (2 * DFF / 32) * (DM / 64), LW_I_DN = (DM / 32) * (DFF / 64), LW_I_PG = (DM / 32) * (DM / 64);
constexpr int LW_ITEMS = LW_I_O + LW_I_GU + LW_I_DN + LW_I_PG;
__device__ __forceinline__ void late_weight_item(const Args& a, int it, LAS float* scr, int lane) {
    unsigned char* ws = a.ws;
    const float *w_o = a.in[15], *w_g = a.in[17], *w_u = a.in[18], *w_d = a.in[19], *w_pg = a.in[22];
    const float *g_ffn = a.in[16], *g_ple = a.in[20];
    bf16_t *WO = (bf16_t*)(ws + WS_WO), *WGU = (bf16_t*)(ws + WS_WGU), *WDN = (bf16_t*)(ws + WS_WDN), *WPG = (bf16_t*)(ws + WS_WPG);
    int r = it;
    if (r < LW_I_O) { const int g32 = r / 32, kb = r % 32; transpose_item(w_o + (size_t)((kb * 64) % DM) * DM + perm_col0(g32), DM, WO + (size_t)g32 * 32 * 2048 + kb * 64, 2048, scr, lane); return; } r -= LW_I_O;
    if (r < LW_I_GU) { const int g32 = r / (DM / 64), kb = r % (DM / 64); const int pn = g32 >> 3, bj = (g32 >> 2) & 1, wc = g32 & 3;
        transpose_item((bj ? w_u : w_g) + (size_t)kb * 64 * DFF + 128 * pn + 32 * wc, DFF, WGU + (size_t)g32 * 32 * DM + kb * 64, DM, scr, lane, g_ffn + kb * 64); return; } r -= LW_I_GU;
    if (r < LW_I_DN) { const int g32 = r / (DFF / 64), kb = r % (DFF / 64); transpose_item(w_d + (size_t)kb * 64 * DM + perm_col0(g32), DM, WDN + (size_t)g32 * 32 * DFF + kb * 64, DFF, scr, lane); return; } r -= LW_I_DN;
    { const int g32 = r / (DM / 64), kb = r % (DM / 64); transpose_item(w_pg + (size_t)kb * 64 * DM + perm_col0(g32), DM, WPG + (size_t)g32 * 32 * DM + kb * 64, DM, scr, lane, g_ple + kb * 64); }
}

__device__ __forceinline__ void p0_prologue(const Args& a, LAS unsigned char* lds, int gw, int NGW, int lane) {
    unsigned char* ws = a.ws;
    LAS float* scr = (LAS float*)(lds + (threadIdx.x >> 6) * 16384);
    const float *w_in = a.in[7], *w_ple = a.in[21];
    bf16_t *WIN = (bf16_t*)(ws + WS_WIN), *WPL = (bf16_t*)(ws + WS_WPL);
    constexpr int I_IN = (NIN / 32) * (DM / 64), I_PL = (DM / 32) * (PLE / 64);
    constexpr int NITEMS = I_IN + I_PL;
    for (int it = gw; it < NITEMS; it += NGW) {
        int r = it;
        if (r < I_IN) { const int g32 = r / (DM / 64), kb = r % (DM / 64); transpose_item(w_in + (size_t)kb * 64 * NIN + perm_col0(g32), NIN, WIN + (size_t)g32 * 32 * DM + kb * 64, DM, scr, lane, a.in[8] + kb * 64); continue; } r -= I_IN;
        { const int g32 = r / (PLE / 64), kb = r % (PLE / 64); transpose_item(w_ple + (size_t)kb * 64 * DM + perm_col0(g32), DM, WPL + (size_t)g32 * 32 * PLE + kb * 64, PLE, scr, lane); }
    }
    const float *xp = a.in[0], *xs = a.in[1]; bf16_t* H = (bf16_t*)(ws + WS_H); float* SS0 = (float*)(ws + WS_SS0);
    for (int row0 = gw; row0 < M; row0 += 2 * NGW) {
        const int row1 = row0 + NGW; const bool has1 = row1 < M;
        const f32x4* x0 = (const f32x4*)(row0 < MP ? xp + (size_t)row0 * DM : xs + (size_t)(row0 - MP) * DM);
        const f32x4* x1 = (const f32x4*)(!has1 ? (const float*)x0 : row1 < MP ? xp + (size_t)row1 * DM : xs + (size_t)(row1 - MP) * DM);
        f32x4 v[4], u[4]; float s = 0.f, t = 0.f;
#pragma unroll
        for (int j = 0; j < 4; ++j) { v[j] = x0[lane + 64 * j]; u[j] = x1[lane + 64 * j]; }
#pragma unroll
        for (int j = 0; j < 4; ++j) { s += (v[j][0] * v[j][0] + v[j][1] * v[j][1]) + (v[j][2] * v[j][2] + v[j][3] * v[j][3]); t += (u[j][0] * u[j][0] + u[j][1] * u[j][1]) + (u[j][2] * u[j][2] + u[j][3] * u[j][3]); }
#pragma unroll
        for (int j = 0; j < 4; ++j) {
            v2u o; o.x = pk2(v[j][0], v[j][1]); o.y = pk2(v[j][2], v[j][3]);
            ((v2u*)(H + (size_t)row0 * DM))[lane + 64 * j] = o;
            if (has1) { v2u w; w.x = pk2(u[j][0], u[j][1]); w.y = pk2(u[j][2], u[j][3]); ((v2u*)(H + (size_t)row1 * DM))[lane + 64 * j] = w; } }
#pragma unroll
        for (int o = 1; o < 64; o <<= 1) { s += __shfl_xor(s, o); t += __shfl_xor(t, o); }
        if (lane == 0) { SS0[row0] = s; if (has1) SS0[row1] = t; }
    }
    { const float *pp = a.in[5], *ps = a.in[6]; bf16_t* PB = (bf16_t*)(ws + WS_PB);
      const size_t n4 = (size_t)M * PLE / 4, np4 = (size_t)MP * PLE / 4;
      const size_t st = (size_t)NGW * 64;
      for (size_t i0 = (size_t)gw * 64 + lane; i0 < n4; i0 += 4 * st) {
          f32x4 v[4];
#pragma unroll
          for (int k = 0; k < 4; ++k) { const size_t i = i0 + k * st; v[k] = i < np4 ? ((const f32x4*)pp)[i] : i < n4 ? ((const f32x4*)ps)[i - np4] : (f32x4){0.f, 0.f, 0.f, 0.f}; }
#pragma unroll
          for (int k = 0; k < 4; ++k) { const size_t i = i0 + k * st; if (i < n4) { v2u o; o.x = pk2(v[k][0], v[k][1]); o.y = pk2(v[k][2], v[k][3]); ((v2u*)PB)[i] = o; } }
      } }
    { float* SS = (float*)(ws + WS_SS);
      for (int i = gw * 64 + lane; i < 65536; i += NGW * 64) SS[i] = 0.f; }
    { const float *lq = a.in[11], *lk = a.in[12], *gq = a.in[9], *gk = a.in[10]; float* sc = (float*)(ws + WS_SC);
      if (gw == 0) {
          float s0 = lq[lane] * lk[lane], s1 = lq[64 + lane] * lk[64 + lane], mq = fabsf(gq[lane]), mk = fabsf(gk[lane]);
#pragma unroll
          for (int o = 1; o < 64; o <<= 1) { s0 += __shfl_xor(s0, o); s1 += __shfl_xor(s1, o); mq = fmaxf(mq, __shfl_xor(mq, o)); mk = fmaxf(mk, __shfl_xor(mk, o)); }
          if (lane == 0) { sc[0] = expf(s0) - expf(s1) + LAM_INIT; sc[1] = 8.0f * LOG2E * mq * mk * 1.01f; }
      }
    }
}
#ifndef ATT_PRIO
#define ATT_PRIO 0
#endif
namespace att {
typedef short v4i16_t __attribute__((ext_vector_type(4)));
typedef float f32x2_t __attribute__((ext_vector_type(2)));
typedef __bf16 bf16x2_t __attribute__((ext_vector_type(2)));
__device__ __forceinline__ unsigned cvtpk(float lo, float hi) { f32x2_t v = {lo, hi}; bf16x2_t b = __builtin_convertvector(v, bf16x2_t); return __builtin_bit_cast(unsigned, b); }
__device__ __forceinline__ s16x4 vtr(const LAS unsigned char* p) { return __builtin_bit_cast(s16x4, __builtin_amdgcn_ds_read_tr16_b64_v4i16((LAS v4i16_t*)p)); }
__device__ __forceinline__ void glds16(const void* gsrc, unsigned lds_dst) { unsigned keep;
    asm volatile("s_mov_b32 %0, m0\n\ts_mov_b32 m0, %2\n\ts_nop 0\n\tglobal_load_lds_dwordx4 %1, off\n\ts_mov_b32 m0, %0" : "=&s"(keep) : "v"(gsrc), "s"(lds_dst) : "memory"); }
__device__ __forceinline__ int crow(int r, int hi) { return (r & 3) + 8 * (r >> 2) + 4 * hi; }
__device__ __forceinline__ int koff(int row, int ch) { return 256 * row + 16 * (ch ^ (((row & 3) << 2) | ((row >> 2) & 3))); }
constexpr int L_K = 0, L_V = 32768, L_WS = 132096;
constexpr int L_CONST = 131520;

template <bool SAMPLE, int ABL = 0>
__device__ __forceinline__ void attn_unit(const Args& a, LAS unsigned char* lds, int b, int h, int qb, bf16_t* mixbase = nullptr, gu32* qhead = nullptr) {
    unsigned char* ws = a.ws;
    const bf16_t *Q = (const bf16_t*)(ws + WS_Q), *Kb = (const bf16_t*)(ws + WS_KB), *Vb = (const bf16_t*)(ws + WS_VB), *GA = (const bf16_t*)(ws + WS_GA);
    bf16_t* MIX = mixbase ? mixbase : (bf16_t*)(ws + WS_MIX);
    const float *cK = a.in[2], *cV = a.in[3];
    const LAS float* cst = (const LAS float*)(lds + L_CONST);
    int tid_ = threadIdx.x; asm volatile("" : "+v"(tid_));
    const int tid = tid_, lane = tid & 63, r32 = lane & 31, hi = lane >> 5;
    const int wave = __builtin_amdgcn_readfirstlane(tid >> 6), rb = wave >> 1, map = wave & 1;
    const int row0 = SAMPLE ? MP + b * DT : b * SEQ + qb * 128;
    const int NT = SAMPLE ? (PAST / 64 + 1) : 2 * qb + 2;
    const int tlast = SAMPLE ? NT - 1 : 2 * qb + (rb >> 1);
    const bool wactive = SAMPLE ? (rb == 0) : true;
    const float lam = cst[128], shift = cst[129];

    const int lw = (wave - 2) & 3;
    auto ldraw = [&](f32x4 (&r)[16], int t) {
        const size_t row0c = (size_t)(b * PAST + 64 * t + 2 * lw + hi) * NH + h;
        const float* kp = cK + row0c * 128 + 4 * r32;
        const float* vp = cV + row0c * 128 + 4 * r32;
#pragma unroll
        for (int n = 0; n < 8; ++n) {
            r[n] = __builtin_nontemporal_load((const f32x4*)(kp + (size_t)(8 * (n >> 2) + 16 * (n & 3)) * NH * 128));
            r[8 + n] = __builtin_nontemporal_load((const f32x4*)(vp + (size_t)(8 * (n >> 2) + 16 * (n & 3)) * NH * 128));
        }
    };
    auto wrraw = [&](const f32x4 (&r)[16], int buf) {
        int k0 = 2 * lw + hi; asm volatile("" : "+v"(k0));
        const int ch = r32 >> 1;
        const LAS unsigned char* ka0 = lds + buf * 32768 + 256 * k0 + 16 * (ch ^ (((k0 & 3) << 2) | ((k0 >> 2) & 3))) + 8 * (r32 & 1);
        const LAS unsigned char* ka1 = lds + buf * 32768 + 256 * (k0 + 8) + 16 * (ch ^ (((k0 & 3) << 2) | (((k0 >> 2) & 3) + 2))) + 8 * (r32 & 1);
        const LAS unsigned char* va0 = lds + buf * 32768 + 16384 + (r32 >> 3) * 4096 + k0 * 64 + (r32 & 7) * 8;
#pragma unroll
        for (int n = 0; n < 8; ++n) {
            const int cls = n >> 2, j = n & 3;
            *(LAS v2u*)((cls ? ka1 : ka0) + 4096 * j) = (v2u){cvtpk(r[n][0], r[n][1]), cvtpk(r[n][2], r[n][3])};
            *(LAS v2u*)(va0 + 512 * cls + 1024 * j) = (v2u){cvtpk(r[8 + n][0], r[8 + n][1]), cvtpk(r[8 + n][2], r[8 + n][3])};
        }
    };

    bf16x8 qf[4];
    const bf16_t* qp = Q + (size_t)(row0 + (SAMPLE ? 0 : 32 * rb) + r32) * DM + h * 128 + map * 64 + 8 * hi;
    if constexpr (SAMPLE) {
#pragma unroll
        for (int d0 = 0; d0 < 4; ++d0) qf[d0] = *(const bf16x8*)(qp + 16 * d0);
    }
    f32x16 o[4];
#pragma unroll
    for (int d = 0; d < 4; ++d)
#pragma unroll
        for (int r = 0; r < 16; ++r) o[d][r] = 0.f;
    float l_reg = 0.f;
    f32x16 negs;
#pragma unroll
    for (int r = 0; r < 16; ++r) negs[r] = -shift;
    const int vp0 = ((lane >> 4) & 1) * 32 + (lane & 3) * 8 + (4 * hi + ((lane & 15) >> 2)) * 64;

    __syncthreads();
    if constexpr (!SAMPLE) {
        const int lds0 = (int)(size_t)lds;
        auto dma_tile = [&](int t, int slot_off) {
#pragma unroll
            for (int i = 0; i < 2; ++i) {
                const int kid = tid + 512 * i, key = kid >> 4, cl = kid & 15;
                const int csrc = cl ^ (((key & 3) << 2) | ((key >> 2) & 3));
                const int pz = wave + 8 * i, vkey = 16 * (pz & 3) + (lane >> 2), vd = 32 * (pz >> 2) + 8 * (lane & 3);
                const bf16_t* ksrc = Kb + (size_t)(b * SEQ + 64 * t + key) * DM + h * 128 + 8 * csrc;
                const bf16_t* vsrc = Vb + (size_t)(b * SEQ + 64 * t + vkey) * DM + h * 128 + vd;
                glds16(ksrc, (unsigned)__builtin_amdgcn_readfirstlane(lds0 + slot_off + wave * 1024 + i * 8192));
                glds16(vsrc, (unsigned)__builtin_amdgcn_readfirstlane(lds0 + slot_off + 16384 + (wave + 8 * i) * 1024));
            }
        };
        dma_tile(0, 0); dma_tile(1, 32768);
#pragma unroll
        for (int d0 = 0; d0 < 4; ++d0) qf[d0] = *(const bf16x8*)(qp + 16 * d0);
        asm volatile("" : "+v"(qf[0]), "+v"(qf[1]), "+v"(qf[2]), "+v"(qf[3]));
        int s_cur = 0, s_n1 = 32768, s_n2 = 65536;
        for (int t = 0; t < NT; ++t) {
            if (!(ABL & 16)) {
            if (t + 1 < NT) asm volatile("s_waitcnt vmcnt(4) lgkmcnt(0)\n\ts_barrier" ::: "memory");
            else asm volatile("s_waitcnt vmcnt(0) lgkmcnt(0)\n\ts_barrier" ::: "memory");
            }
            if (t > tlast) { if (t + 2 < NT) dma_tile(t + 2, s_n2); }
            if (t <= tlast) {
                const LAS unsigned char* Kt = lds + s_cur;
                const LAS unsigned char* Vt = lds + s_cur + 16384 + vp0;
#define MFMA32(A_, B_, C_) __builtin_amdgcn_mfma_f32_32x32x16_bf16(A_, B_, C_, 0, 0, 0)
#define VLD(dst, ks) do { _Pragma("unroll") for (int db = 0; db < 4; ++db) { if (!(ABL & 8)) { const s16x4 lo_ = vtr(Vt + db * 4096 + (ks) * 1024), hh_ = vtr(Vt + db * 4096 + (ks) * 1024 + 512); \
                          dst[db] = (bf16x8){lo_[0], lo_[1], lo_[2], lo_[3], hh_[0], hh_[1], hh_[2], hh_[3]}; } else dst[db] = qf[db]; } } while (0)
#define SGB(mask, n) __builtin_amdgcn_sched_group_barrier(mask, n, 0)
#define PVM(P_, V_, O_) do { if (!(ABL & 2)) O_ = MFMA32(__builtin_bit_cast(bf16x8, P_), V_, O_); else asm volatile("" :: "v"(P_), "v"(V_)); } while (0)
                bf16x8 ka[4], kb[4], va[4], vb[4];
#pragma unroll
                for (int d0 = 0; d0 < 4; ++d0) { const int c = map * 8 + 2 * d0 + hi; ka[d0] = *(const LAS bf16x8*)(Kt + koff(r32, c)); kb[d0] = *(const LAS bf16x8*)(Kt + koff(32 + r32, c)); }
                VLD(va, 0);
                f32x16 p0 = negs, p1 = negs;
                if (ATT_PRIO) __builtin_amdgcn_s_setprio(1);
#pragma unroll
                for (int d0 = 0; d0 < 4; ++d0) { if (!(ABL & 4)) { p0 = MFMA32(ka[d0], qf[d0], p0); p1 = MFMA32(kb[d0], qf[d0], p1); } else { asm volatile("" :: "v"(ka[d0]), "v"(kb[d0])); } }
                __builtin_amdgcn_sched_barrier(0);
                if (!(ABL & 32)) { if (t + 2 < NT) dma_tile(t + 2, s_n2); }
                __builtin_amdgcn_sched_barrier(0);
                float s0 = 0.f, s1 = 0.f;
#pragma unroll
                for (int r = 0; r < 16; ++r) { if (!(ABL & 1)) p0[r] = __builtin_amdgcn_exp2f(p0[r]); s0 += p0[r]; }
                v4u pw0 = (v4u){cvtpk(p0[0], p0[1]), cvtpk(p0[2], p0[3]), cvtpk(p0[4], p0[5]), cvtpk(p0[6], p0[7])};
                v4u pw1 = (v4u){cvtpk(p0[8], p0[9]), cvtpk(p0[10], p0[11]), cvtpk(p0[12], p0[13]), cvtpk(p0[14], p0[15])};
                VLD(vb, 1);
                __builtin_amdgcn_sched_barrier(0);
#pragma unroll
                for (int db = 0; db < 4; ++db) PVM(pw0, va[db], o[db]);
#pragma unroll
                for (int r = 0; r < 16; ++r) { if (!(ABL & 1)) p1[r] = __builtin_amdgcn_exp2f(p1[r]); s1 += p1[r]; }
                v4u pw2 = (v4u){cvtpk(p1[0], p1[1]), cvtpk(p1[2], p1[3]), cvtpk(p1[4], p1[5]), cvtpk(p1[6], p1[7])};
                v4u pw3 = (v4u){cvtpk(p1[8], p1[9]), cvtpk(p1[10], p1[11]), cvtpk(p1[12], p1[13]), cvtpk(p1[14], p1[15])};
                VLD(va, 2);
#pragma unroll
                for (int db = 0; db < 4; ++db) PVM(pw1, vb[db], o[db]);
#pragma unroll
                for (int i = 0; i < 8; ++i) { SGB(0x8, 1); SGB(0x2, 5); SGB(0x100, 1); }
                __builtin_amdgcn_sched_barrier(0);
                VLD(vb, 3);
#pragma unroll
                for (int db = 0; db < 4; ++db) PVM(pw2, va[db], o[db]);
#pragma unroll
                for (int db = 0; db < 4; ++db) PVM(pw3, vb[db], o[db]);
                if (ATT_PRIO) __builtin_amdgcn_s_setprio(0);
                l_reg += s0 + s1;
#undef MFMA32
#undef VLD
#undef SGB
#undef PVM
            }
            { const int tmp = s_cur; s_cur = s_n1; s_n1 = s_n2; s_n2 = tmp; }
        }
        asm volatile("s_waitcnt lgkmcnt(0)\n\ts_barrier" ::: "memory");
    } else {
        auto tile = [&](int slot, auto half_) {
            constexpr bool halftile = decltype(half_)::value;
            if (wactive) {
                const LAS unsigned char* Kt = lds + slot * 32768;
                const LAS unsigned char* Vt = lds + slot * 32768 + 16384 + vp0;
                f32x16 p0 = negs, p1 = negs;
#pragma unroll
                for (int d0 = 0; d0 < 4; ++d0) {
                    const int c = map * 8 + 2 * d0 + hi;
                    p0 = __builtin_amdgcn_mfma_f32_32x32x16_bf16(*(const LAS bf16x8*)(Kt + koff(r32, c)), qf[d0], p0, 0, 0, 0);
                    if (!halftile) p1 = __builtin_amdgcn_mfma_f32_32x32x16_bf16(*(const LAS bf16x8*)(Kt + koff(32 + r32, c)), qf[d0], p1, 0, 0, 0);
                }
                float s = 0.f;
#pragma unroll
                for (int r = 0; r < 16; ++r) { p0[r] = __builtin_amdgcn_exp2f(p0[r]); s += p0[r]; }
                if (!halftile) {
#pragma unroll
                    for (int r = 0; r < 16; ++r) { p1[r] = __builtin_amdgcn_exp2f(p1[r]); s += p1[r]; }
                }
                l_reg += s;
                v4u pw[4];
                pw[0] = (v4u){cvtpk(p0[0], p0[1]), cvtpk(p0[2], p0[3]), cvtpk(p0[4], p0[5]), cvtpk(p0[6], p0[7])};
                pw[1] = (v4u){cvtpk(p0[8], p0[9]), cvtpk(p0[10], p0[11]), cvtpk(p0[12], p0[13]), cvtpk(p0[14], p0[15])};
                pw[2] = (v4u){cvtpk(p1[0], p1[1]), cvtpk(p1[2], p1[3]), cvtpk(p1[4], p1[5]), cvtpk(p1[6], p1[7])};
                pw[3] = (v4u){cvtpk(p1[8], p1[9]), cvtpk(p1[10], p1[11]), cvtpk(p1[12], p1[13]), cvtpk(p1[14], p1[15])};
#pragma unroll
                for (int db = 0; db < 4; ++db)
#pragma unroll
                    for (int ks = 0; ks < 4; ++ks) {
                        if (ks < 2 || !halftile) {
                            const s16x4 lo = vtr(Vt + db * 4096 + ks * 1024), hh = vtr(Vt + db * 4096 + ks * 1024 + 512);
                            const bf16x8 vf = (bf16x8){lo[0], lo[1], lo[2], lo[3], hh[0], hh[1], hh[2], hh[3]};
                            o[db] = __builtin_amdgcn_mfma_f32_32x32x16_bf16(__builtin_bit_cast(bf16x8, pw[ks]), vf, o[db], 0, 0, 0);
                        }
                    }
            }
        };
        constexpr int NC = PAST / 64;
        if (wave < 2) {
            { v4u nk[4], nv[4];
#pragma unroll
              for (int i = 0; i < 4; ++i) {
                  const int id = tid + 128 * i, key = id >> 4, c = id & 15;
                  const int blk = id >> 6, li = id & 63, vkey = 16 * (blk & 1) + (li >> 2), vd = 32 * (blk >> 1) + 8 * (li & 3);
                  nk[i] = *(const v4u*)(Kb + (size_t)(MP + b * DT + key) * DM + h * 128 + 8 * c);
                  nv[i] = *(const v4u*)(Vb + (size_t)(MP + b * DT + vkey) * DM + h * 128 + vd);
              }
#pragma unroll
              for (int i = 0; i < 4; ++i) {
                  const int id = tid + 128 * i, blk = id >> 6, li = id & 63;
                  *(LAS v4u*)(lds + 2 * 32768 + koff(id >> 4, id & 15)) = nk[i];
                  *(LAS v4u*)(lds + 2 * 32768 + 16384 + ((blk >> 1) * 4 + (blk & 1)) * 1024 + li * 16) = nv[i];
              } }
            __syncthreads();
#pragma unroll 1
            for (int t = 0; t < NC - 2; t += 3) { tile(0, std::false_type{}); __syncthreads(); tile(1, std::false_type{}); __syncthreads(); tile(3, std::false_type{}); __syncthreads(); }
            tile(0, std::false_type{}); __syncthreads(); tile(1, std::false_type{}); __syncthreads();
            tile(2, std::true_type{});
        } else if (wave < 6) {
            f32x4 s0[16], s1[16], s2[16];
            ldraw(s0, 0); ldraw(s1, 1); ldraw(s2, 2);
            wrraw(s0, 0); ldraw(s0, 3);
            __syncthreads();
#pragma unroll 1
            for (int k = 1; k < NC - 4; k += 3) {
                wrraw(s1, 1); ldraw(s1, k + 3); __syncthreads();
                wrraw(s2, 3); ldraw(s2, k + 4); __syncthreads();
                wrraw(s0, 0); ldraw(s0, k + 5); __syncthreads();
            }
            wrraw(s1, 1); ldraw(s1, NC - 1); __syncthreads();
            wrraw(s2, 3); __syncthreads();
            wrraw(s0, 0); __syncthreads();
            wrraw(s1, 1); __syncthreads();
            __syncthreads();
        } else {
            __syncthreads();
#pragma unroll 1
            for (int t = 0; t < NC; ++t) __syncthreads();
        }
        __syncthreads();
    }
    unsigned nxt_unit = 0u;
    if (qhead && tid == 0) nxt_unit = __hip_atomic_fetch_add(qhead, 1u, __ATOMIC_RELAXED, __HIP_MEMORY_SCOPE_AGENT);
    LAS float* wsf = (LAS float*)(lds + L_WS) + wave * 64;
    l_reg += __shfl_xor(l_reg, 32);
    if (hi == 0) wsf[r32] = (map == 0 ? 1.0f : -lam) / l_reg;
    LDS_WAIT();
    LAS float* Tw = (LAS float*)(lds + rb * 16896) + hi * 528 + r32;
    const int rowo = row0 + (SAMPLE ? 0 : 32 * rb) + r32;
    v4u gaw[8];
#pragma unroll
    for (int i = 0; i < 8; ++i) gaw[i] = (v4u){0u, 0u, 0u, 0u};
    if (wactive && map == 0) { const bf16_t* gap = GA + (size_t)rowo * DM + h * 128 + 64 * hi;
#pragma unroll
        for (int i = 0; i < 8; ++i) gaw[i] = *(const v4u*)(gap + 8 * i); }
    if (wactive) {
#pragma unroll
        for (int r = 0; r < 16; ++r) { const float inv = wsf[crow(r, hi)];
#pragma unroll
            for (int db = 0; db < 4; ++db) o[db][r] *= inv; }
    }
    if (wactive && map == 1) {
#pragma unroll
        for (int db = 0; db < 4; ++db)
#pragma unroll
            for (int r = 0; r < 16; ++r) Tw[crow(r, 0) * 132 + 32 * db] = o[db][r];
    }
    __syncthreads();
    if (wactive && map == 0) {
#pragma unroll
        for (int db = 0; db < 4; ++db) {
#pragma unroll
            for (int r = 0; r < 16; ++r) o[db][r] += Tw[crow(r, 0) * 132 + 32 * db];
#pragma unroll
            for (int r = 0; r < 16; ++r) Tw[crow(r, 0) * 132 + 32 * db] = o[db][r];
            asm volatile("" ::: "memory");
        }
        f32x4 gsv[16];
        { const LAS float* gs = cst + 64 * hi;
#pragma unroll
          for (int i = 0; i < 16; ++i) gsv[i] = *(const LAS f32x4*)(gs + 4 * i); }
        LDS_WAIT();
        const LAS float* Tr = (const LAS float*)(lds + rb * 16896) + r32 * 132 + 64 * hi;
        float ss = 0.f;
#pragma unroll
        for (int i = 0; i < 16; ++i) { const f32x4 v = *(const LAS f32x4*)(Tr + 4 * i); ss += (v[0] * v[0] + v[1] * v[1]) + (v[2] * v[2] + v[3] * v[3]); }
        ss += __shfl_xor(ss, 32);
        const float rn = __builtin_amdgcn_rsqf(ss * (1.0f / 128.0f) + EPS) * (1.0f - LAM_INIT);
        bf16_t* mp = MIX + (size_t)rowo * 2048 + h * 128 + 64 * hi;
#pragma unroll
        for (int i = 0; i < 8; ++i) {
            const f32x4 v0 = *(const LAS f32x4*)(Tr + 8 * i), v1 = *(const LAS f32x4*)(Tr + 8 * i + 4);
            const v4u gw = gaw[i];
            const f32x4 a0 = (f32x4){__uint_as_float(gw.x << 16), __uint_as_float(gw.x & 0xffff0000u), __uint_as_float(gw.y << 16), __uint_as_float(gw.y & 0xffff0000u)};
            const f32x4 a1 = (f32x4){__uint_as_float(gw.z << 16), __uint_as_float(gw.z & 0xffff0000u), __uint_as_float(gw.w << 16), __uint_as_float(gw.w & 0xffff0000u)};
            const f32x4 r0 = v0 * rn * gsv[2 * i] * a0, r1 = v1 * rn * gsv[2 * i + 1] * a1;
            *(v4u*)(mp + 8 * i) = (v4u){cvtpk(r0[0], r0[1]), cvtpk(r0[2], r0[3]), cvtpk(r1[0], r1[1]), cvtpk(r1[2], r1[3])};
        }
    }
    if (qhead && tid == 0) ((volatile LAS unsigned*)(lds + MISC_OFF))[12] = nxt_unit;
}
}
namespace ret {
using att::cvtpk; using att::vtr;
__device__ __forceinline__ int ioff(int row, int ch) { return 256 * row + 16 * (ch ^ (((row & 3) << 2) | ((row >> 2) & 3))); }
__device__ __forceinline__ v4u scale8(const v4u w, float s) {
    v4u o;
    o.x = cvtpk(__uint_as_float(w.x << 16) * s, __uint_as_float(w.x & 0xffff0000u) * s); o.y = cvtpk(__uint_as_float(w.y << 16) * s, __uint_as_float(w.y & 0xffff0000u) * s);
    o.z = cvtpk(__uint_as_float(w.z << 16) * s, __uint_as_float(w.z & 0xffff0000u) * s); o.w = cvtpk(__uint_as_float(w.w << 16) * s, __uint_as_float(w.w & 0xffff0000u) * s);
    return o;
}
__device__ __forceinline__ bf16x8 mk8(const s16x4 a, const s16x4 b) { return (bf16x8){a[0], a[1], a[2], a[3], b[0], b[1], b[2], b[3]}; }
__device__ __forceinline__ bf16x8 mk8u(const v2u a, const v2u b) { const v4u w = (v4u){a.x, a.y, b.x, b.y}; return __builtin_bit_cast(bf16x8, w); }

template <bool SAMPLE>
__device__ __forceinline__ void ret_unit(const Args& a, LAS unsigned char* lds, int b, int h) {
    unsigned char* ws = a.ws;
    const bf16_t *QR = (const bf16_t*)(ws + WS_QR), *KR = (const bf16_t*)(ws + WS_KR), *VR = (const bf16_t*)(ws + WS_VR), *GS = (const bf16_t*)(ws + WS_GS), *GR = (const bf16_t*)(ws + WS_GR);
    bf16_t* MIX = (bf16_t*)(ws + WS_MIX);
    const float* grn = a.in[14];
    constexpr int T = SAMPLE ? DT : 64, NCH = SAMPLE ? 1 : 64;
    constexpr int IMG = 32768, P_IN = 65536, P_O = 81920;
    int tid_ = threadIdx.x; asm volatile("" : "+v"(tid_));
    const int tid = tid_, lane = tid & 63, l15 = lane & 15, fq = lane >> 4;
    const int w = __builtin_amdgcn_readfirstlane(tid >> 6);
    const float lg2 = log1pf(-exp2f(-5.0f - (float)h)) * LOG2E;
    const float cd = __builtin_amdgcn_exp2f(lg2 * (float)T);
    const float ginvT = __builtin_amdgcn_exp2f(-lg2 * (float)T);

    f32x4 S[4];
    { const float* sp = a.in[4] + ((size_t)(b * NH + h) * 64) * 128 + 16 * w + l15;
#pragma unroll
      for (int blk = 0; blk < 4; ++blk)
#pragma unroll
          for (int r = 0; r < 4; ++r) S[blk][r] = SAMPLE ? sp[(size_t)(16 * blk + 4 * fq + r) * 128] : 0.f; }

    const int stok = tid >> 3, sc8 = tid & 7;
    v4u qreg, kreg, vreg[2], gsr[2], grr[2];
    auto stage_load = [&](int c) {
        const int row = (SAMPLE ? MP + b * DT : b * SEQ + c * 64) + (SAMPLE ? (stok & 31) : stok);
        qreg = *(const v4u*)(QR + (size_t)row * 512 + h * 64 + 8 * sc8);
        kreg = *(const v4u*)(KR + (size_t)row * 512 + h * 64 + 8 * sc8);
        vreg[0] = *(const v4u*)(VR + (size_t)row * DM + h * 128 + 16 * sc8);
        vreg[1] = *(const v4u*)(VR + (size_t)row * DM + h * 128 + 16 * sc8 + 8);
    };
    auto gate_load = [&](int c) {
        const int row = (SAMPLE ? MP + b * DT : b * SEQ + c * 64) + (SAMPLE ? (stok & 31) : stok);
        gsr[0] = *(const v4u*)(GS + (size_t)row * DM + h * 128 + 16 * sc8); gsr[1] = *(const v4u*)(GS + (size_t)row * DM + h * 128 + 16 * sc8 + 8);
        grr[0] = *(const v4u*)(GR + (size_t)row * DM + h * 128 + 16 * sc8); grr[1] = *(const v4u*)(GR + (size_t)row * DM + h * 128 + 16 * sc8 + 8);
    };
    const float qd = __builtin_amdgcn_exp2f(lg2 * (float)(stok + 1)), kd = __builtin_amdgcn_exp2f(lg2 * (float)(T - 1 - stok));
    auto stage_write = [&](int buf) {
        const bool valid = stok < T;
        const v4u z = (v4u){0u, 0u, 0u, 0u};
        LAS unsigned char* im = lds + buf * IMG;
        *(LAS v4u*)(im + ioff(stok, sc8)) = valid ? scale8(qreg, qd) : z;
        *(LAS v4u*)(im + ioff(stok, 8 + sc8)) = valid ? scale8(kreg, kd) : z;
        *(LAS v4u*)(im + 16384 + ioff(stok, 2 * sc8)) = valid ? vreg[0] : z;
        *(LAS v4u*)(im + 16384 + ioff(stok, 2 * sc8 + 1)) = valid ? vreg[1] : z;
    };
    const int tq = (lane & 15) >> 2, tp = lane & 3;
    int vrel[2][2], krow[2][2];
#pragma unroll
    for (int s = 0; s < 2; ++s)
#pragma unroll
        for (int hf = 0; hf < 2; ++hf) { const int row = 32 * s + 8 * fq + tq + 4 * hf;
            vrel[s][hf] = 16384 + ioff(row, 2 * w + (tp >> 1)) + 8 * (tp & 1);
            krow[s][hf] = row; }
    f32x4 n0, n1, n2, n3;
    { const float* gp = grn + h * 128 + 16 * sc8; n0 = *(const f32x4*)gp; n1 = *(const f32x4*)(gp + 4); n2 = *(const f32x4*)(gp + 8); n3 = *(const f32x4*)(gp + 12); }
    stage_load(0);
    __syncthreads();
    stage_write(0);
    if (NCH > 1) stage_load(1);
    gate_load(0);
    LBAR();
    for (int c = 0; c < NCH; ++c) {
        const int row0 = SAMPLE ? MP + b * DT : b * SEQ + c * 64;
        const LAS unsigned char* im = lds + (c & 1) * IMG;
#pragma unroll
        for (int bi = 0; bi < 2; ++bi) {
            const int blk = 2 * w + bi, ib = blk >> 2, jb = blk & 3;
            f32x4 d = (f32x4){0.f, 0.f, 0.f, 0.f};
            if (jb <= ib) {
#pragma unroll
                for (int s = 0; s < 2; ++s) {
                    const bf16x8 kf = *(const LAS bf16x8*)(im + ioff(16 * jb + l15, 8 + 4 * s + fq));
                    const bf16x8 qf = *(const LAS bf16x8*)(im + ioff(16 * ib + l15, 4 * s + fq));
                    d = __builtin_amdgcn_mfma_f32_16x16x32_bf16(kf, qf, d, 0, 0, 0);
                }
                const int ti = 16 * ib + l15, tj0 = 16 * jb + 4 * fq;
#pragma unroll
                for (int r = 0; r < 4; ++r) d[r] = (ti - (tj0 + r) >= 0) ? d[r] * ginvT : 0.f;
            }
            *(LAS v2u*)(lds + P_IN + ioff(16 * ib + l15, 2 * jb + (fq >> 1)) + 8 * (fq & 1)) = (v2u){cvtpk(d[0], d[1]), cvtpk(d[2], d[3])};
        }
        bf16x8 vf[2];
#pragma unroll
        for (int s = 0; s < 2; ++s) vf[s] = mk8(vtr(im + vrel[s][0]), vtr(im + vrel[s][1]));
        f32x4 o[4];
        { bf16x8 sf[2];
#pragma unroll
          for (int s = 0; s < 2; ++s) { const v4u wv = (v4u){cvtpk(S[2 * s][0], S[2 * s][1]), cvtpk(S[2 * s][2], S[2 * s][3]), cvtpk(S[2 * s + 1][0], S[2 * s + 1][1]), cvtpk(S[2 * s + 1][2], S[2 * s + 1][3])};
              sf[s] = __builtin_bit_cast(bf16x8, wv); }
#pragma unroll
          for (int tb = 0; tb < 4; ++tb) { o[tb] = (f32x4){0.f, 0.f, 0.f, 0.f};
#pragma unroll
              for (int s = 0; s < 2; ++s) {
                  const int row = 16 * tb + l15;
                  const v2u q0 = *(const LAS v2u*)(im + ioff(row, 4 * s + (fq >> 1)) + 8 * (fq & 1));
                  const v2u q1 = *(const LAS v2u*)(im + ioff(row, 4 * s + 2 + (fq >> 1)) + 8 * (fq & 1));
                  o[tb] = __builtin_amdgcn_mfma_f32_16x16x32_bf16(mk8u(q0, q1), sf[s], o[tb], 0, 0, 0);
              } } }
#pragma unroll
        for (int blk = 0; blk < 4; ++blk) { S[blk] = S[blk] * cd;
#pragma unroll
            for (int s = 0; s < 2; ++s) {
                const bf16x8 kdf = mk8(vtr(im + ioff(krow[s][0], 8 + 2 * blk + (tp >> 1)) + 8 * (tp & 1)), vtr(im + ioff(krow[s][1], 8 + 2 * blk + (tp >> 1)) + 8 * (tp & 1)));
                S[blk] = __builtin_amdgcn_mfma_f32_16x16x32_bf16(kdf, vf[s], S[blk], 0, 0, 0);
            } }
        if (c + 1 < NCH) { stage_write((c + 1) & 1); if (c + 2 < NCH) stage_load(c + 2); }
        LBAR();
#pragma unroll
        for (int tb = 0; tb < 4; ++tb)
#pragma unroll
            for (int s = 0; s < 2; ++s) {
                const bf16x8 inf = *(const LAS bf16x8*)(lds + P_IN + ioff(16 * tb + l15, 4 * s + fq));
                o[tb] = __builtin_amdgcn_mfma_f32_16x16x32_bf16(inf, vf[s], o[tb], 0, 0, 0);
            }
        { LAS float* Os = (LAS float*)(lds + P_O) + (4 * fq) * 132 + 16 * w + l15;
#pragma unroll
          for (int tb = 0; tb < 4; ++tb)
#pragma unroll
              for (int r = 0; r < 4; ++r) Os[(16 * tb + r) * 132] = o[tb][r]; }
        LBAR();
        { const int tok = tid >> 3, seg = tid & 7;
          const LAS float* Or = (const LAS float*)(lds + P_O) + tok * 132 + 16 * seg;
          f32x4 v[4]; float ss = 0.f;
#pragma unroll
          for (int i = 0; i < 4; ++i) { v[i] = *(const LAS f32x4*)(Or + 4 * i); ss += (v[i][0] * v[i][0] + v[i][1] * v[i][1]) + (v[i][2] * v[i][2] + v[i][3] * v[i][3]); }
          ss += __shfl_xor(ss, 1); ss += __shfl_xor(ss, 2); ss += __shfl_xor(ss, 4);
          const float rn = __builtin_amdgcn_rsqf(ss * (1.0f / 128.0f) + EPS);
          if (tok < T) {
              const size_t row = (size_t)(row0 + tok); const int cc = h * 128 + 16 * seg;
              const v4u gs0 = gsr[0], gs1 = gsr[1], gr0 = grr[0], gr1 = grr[1];
#define BF4(wd, hf) ((f32x4){__uint_as_float(((hf) ? (wd).z : (wd).x) << 16), __uint_as_float(((hf) ? (wd).z : (wd).x) & 0xffff0000u), __uint_as_float(((hf) ? (wd).w : (wd).y) << 16), __uint_as_float(((hf) ? (wd).w : (wd).y) & 0xffff0000u)})
              const f32x4 r0 = v[0] * rn * n0 * BF4(gs0, 0) * BF4(gr0, 0), r1 = v[1] * rn * n1 * BF4(gs0, 1) * BF4(gr0, 1);
              const f32x4 r2 = v[2] * rn * n2 * BF4(gs1, 0) * BF4(gr1, 0), r3 = v[3] * rn * n3 * BF4(gs1, 1) * BF4(gr1, 1);
#undef BF4
              bf16_t* mp = MIX + row * 2048 + 1024 + cc;
              *(v4u*)mp = (v4u){cvtpk(r0[0], r0[1]), cvtpk(r0[2], r0[3]), cvtpk(r1[0], r1[1]), cvtpk(r1[2], r1[3])};
              *(v4u*)(mp + 8) = (v4u){cvtpk(r2[0], r2[1]), cvtpk(r2[2], r2[3]), cvtpk(r3[0], r3[1]), cvtpk(r3[2], r3[3])};
          }
          if (c + 1 < NCH) gate_load(c + 1); }
    }
    { float* op = a.out + (SAMPLE ? O_NRS : O_NRP) + ((size_t)(b * NH + h) * 64) * 128 + 16 * w + l15;
#pragma unroll
      for (int blk = 0; blk < 4; ++blk)
#pragma unroll
          for (int r = 0; r < 4; ++r) op[(size_t)(16 * blk + 4 * fq + r) * 128] = S[blk][r]; }
}
}
__device__ __forceinline__ int p2_pop(gu32* qhead, volatile LAS unsigned* MISC) {
    __syncthreads();
    if (threadIdx.x == 0) MISC[12] = __hip_atomic_fetch_add(qhead, 1u, __ATOMIC_RELAXED, __HIP_MEMORY_SCOPE_AGENT);
    __syncthreads();
    return (int)MISC[12];
}
__device__ __forceinline__ void p2_mixers(const Args& a, LAS unsigned char* lds, int rep) {
    constexpr int E_RP = 32, E_AP = E_RP + 1024, E_AS = E_AP + 256, E_RS = E_AS + 256, E_LW = E_RS + LW_ITEMS / 32;
    gu32* qhead = (gu32*)(a.ws + WS_CTL) + CW_QUEUE + 64 * rep;
    volatile LAS unsigned* MISC = (volatile LAS unsigned*)(lds + MISC_OFF);
    { LAS float* cst = (LAS float*)(lds + att::L_CONST);
      if (threadIdx.x < 128) cst[threadIdx.x] = a.in[13][threadIdx.x];
      if (threadIdx.x < 2) cst[128 + threadIdx.x] = ((const float*)(a.ws + WS_SC))[threadIdx.x];
      __syncthreads(); }
#ifdef PROBE_P2SUB
    if (rep == 1) {
        int r = p2_pop(qhead, MISC);
        if (PROBE_P2SUB == 1) while (r < 32) { ret::ret_unit<false>(a, lds, r >> 3, r & 7); r = p2_pop(qhead, MISC); }
#ifndef PROBE_ABL
#define PROBE_ABL 0
#endif
        if (PROBE_P2SUB == 2) while (r < 1024) { const int qb = 31 - (r >> 5), bh = r & 31; att::attn_unit<false, PROBE_ABL>(a, lds, bh >> 3, bh & 7, qb, (bf16_t*)(a.ws + WS_NS1)); r = p2_pop(qhead, MISC); }
        if (PROBE_P2SUB == 3) while (r < 256) { att::attn_unit<true>(a, lds, r >> 3, r & 7, 0); r = p2_pop(qhead, MISC); }
        if (PROBE_P2SUB == 5) while (r < 32) { att::attn_unit<true>(a, lds, r >> 3, r & 7, 0); r = p2_pop(qhead, MISC); }
        if (PROBE_P2SUB == 4) while (r < 256) { ret::ret_unit<true>(a, lds, r >> 3, r & 7); r = p2_pop(qhead, MISC); }
        return;
    }
#endif
#ifndef P2_R
#define P2_R 3
#endif
    constexpr int NLW2 = (LW_I_O + LW_I_GU) / 32;
    constexpr int F_RP = 32, F_MIX = F_RP + 1280, F_LW = F_MIX + NLW2, F_RS = F_LW + 256;
    constexpr int MIXED = 256 * (P2_R + 1);
    int r = p2_pop(qhead, MISC);
    while (r < F_RP) { ret::ret_unit<false>(a, lds, r >> 3, r & 7); r = p2_pop(qhead, MISC); }
    asm volatile("" ::: "memory");
    while (r < F_MIX) {
        while (r < F_MIX && !((r - F_RP) < MIXED && (r - F_RP) % (P2_R + 1) == P2_R)) {
            const int u = r - F_RP, pu = u < MIXED ? (u / (P2_R + 1)) * P2_R + u % (P2_R + 1) : u - 256, qb = 31 - (pu >> 5), bh = pu & 31;
            att::attn_unit<false>(a, lds, bh >> 3, bh & 7, qb, nullptr, qhead); __syncthreads(); r = (int)MISC[12]; }
        asm volatile("" ::: "memory");
        while (r < F_MIX && (r - F_RP) < MIXED && (r - F_RP) % (P2_R + 1) == P2_R) { const int g = (r - F_RP) / (P2_R + 1); att::attn_unit<true>(a, lds, g >> 3, g & 7, 0, nullptr, qhead); __syncthreads(); r = (int)MISC[12]; }
        asm volatile("" ::: "memory");
    }
    {
        const int lw_wave = __builtin_amdgcn_readfirstlane(threadIdx.x >> 6);
        LAS float* scr = (LAS float*)(lds + lw_wave * 16384);
        while (r < F_LW) { const int u = r - F_MIX;
            if (rep == 0) {
#pragma unroll 1
                for (int i = 0; i < 4; ++i) late_weight_item(a, u * 32 + i * 8 + lw_wave, scr, threadIdx.x & 63); }
            r = p2_pop(qhead, MISC); }
    }
    asm volatile("" ::: "memory");
    while (r < F_RS) { const int u = r - F_LW; ret::ret_unit<true>(a, lds, u >> 3, u & 7); r = p2_pop(qhead, MISC); }
}
namespace sg {
__device__ __forceinline__ int logical_col(int p) { return (p & ~255) + 64 * ((p >> 5) & 3) + 32 * ((p >> 7) & 1) + (p & 31); }

template <class Epi>
__device__ __forceinline__ void sgemm_phase(LAS unsigned char* lds, const bf16_t* A  , const bf16_t* Wt, int K, int bx, int G, const Epi& E) {
    int t_ = threadIdx.x; asm volatile("" : "+v"(t_));
    const int tid = t_, lane = tid & 63, l15 = lane & 15, fq = lane >> 4, w = __builtin_amdgcn_readfirstlane(tid >> 6), wr = w >> 1, wc = w & 1;
    const int lds0 = (int)(size_t)lds;
    const int nkb = K / 128;
    for (int tile = bx; tile < 256; tile += G) {
        const int r0 = (tile >> 4) * 64, c0 = (tile & 15) * 64;
        auto dma_blk = [&](int kb, int slot_off) {
#pragma unroll
            for (int i = 0; i < 2; ++i) {
                const int kid = tid + 512 * i, row = kid >> 4, cl = kid & 15, csrc = cl ^ (((row & 3) << 2) | ((row >> 2) & 3));
                att::glds16(A + (size_t)(r0 + row) * K + kb * 128 + 8 * csrc, (unsigned)__builtin_amdgcn_readfirstlane(lds0 + slot_off + w * 1024 + i * 8192));
                att::glds16(Wt + (size_t)(c0 + row) * K + kb * 128 + 8 * csrc, (unsigned)__builtin_amdgcn_readfirstlane(lds0 + slot_off + 16384 + w * 1024 + i * 8192));
            }
        };
        f32x4 acc[2] = {(f32x4){0.f, 0.f, 0.f, 0.f}, (f32x4){0.f, 0.f, 0.f, 0.f}};
        asm volatile("s_waitcnt lgkmcnt(0)\n\ts_barrier" ::: "memory");
        dma_blk(0, 0); dma_blk(1, 32768);
        int s_cur = 0, s_n1 = 32768, s_n2 = 65536;
        for (int kb = 0; kb < nkb; ++kb) {
            if (kb + 1 < nkb) asm volatile("s_waitcnt vmcnt(4) lgkmcnt(0)\n\ts_barrier" ::: "memory");
            else asm volatile("s_waitcnt vmcnt(0) lgkmcnt(0)\n\ts_barrier" ::: "memory");
            if (kb + 2 < nkb) dma_blk(kb + 2, s_n2);
            const LAS unsigned char* Ai = lds + s_cur; const LAS unsigned char* Bi = lds + s_cur + 16384;
#pragma unroll
            for (int st = 0; st < 4; ++st) {
                const bf16x8 fa = *(const LAS bf16x8*)(Ai + ret::ioff(16 * wr + l15, 4 * st + fq));
                const bf16x8 fb0 = *(const LAS bf16x8*)(Bi + ret::ioff(32 * wc + l15, 4 * st + fq));
                const bf16x8 fb1 = *(const LAS bf16x8*)(Bi + ret::ioff(32 * wc + 16 + l15, 4 * st + fq));
                acc[0] = __builtin_amdgcn_mfma_f32_16x16x32_bf16(fb0, fa, acc[0], 0, 0, 0);
                acc[1] = __builtin_amdgcn_mfma_f32_16x16x32_bf16(fb1, fa, acc[1], 0, 0, 0);
            }
            { const int tmp = s_cur; s_cur = s_n1; s_n1 = s_n2; s_n2 = tmp; }
        }
        const int row = MP + r0 + 16 * wr + l15, p0 = c0 + 32 * wc + 4 * fq;
        E(row, logical_col(p0), acc[0], logical_col(p0 + 16), acc[1], fq);
    }
    asm volatile("s_waitcnt lgkmcnt(0)\n\ts_barrier" ::: "memory");
}

struct EpiStoreBf16 {
    bf16_t* O;
    __device__ __forceinline__ void operator()(int row, int c0, const f32x4 a0, int c1, const f32x4 a1, int) const {
        *(v2u*)(O + (size_t)row * DM + c0) = (v2u){att::cvtpk(a0[0], a0[1]), att::cvtpk(a0[2], a0[3])};
        *(v2u*)(O + (size_t)row * DM + c1) = (v2u){att::cvtpk(a1[0], a1[1]), att::cvtpk(a1[2], a1[3])};
    }
};
__device__ __forceinline__ f32x4 bf4(const v2u t) { return (f32x4){__uint_as_float(t.x << 16), __uint_as_float(t.x & 0xffff0000u), __uint_as_float(t.y << 16), __uint_as_float(t.y & 0xffff0000u)}; }
template <bool BASE_BF16>
struct EpiResidB {
    const float* base; const bf16_t* baseb; bf16_t* Xb; float* SS;
    __device__ __forceinline__ void operator()(int row, int c0, const f32x4 a0, int c1, const f32x4 a1, int fq) const {
        const size_t o0 = (size_t)row * DM + c0, o1 = (size_t)row * DM + c1;
        const f32x4 x0 = (BASE_BF16 ? bf4(*(const v2u*)(baseb + o0)) : *(const f32x4*)(base + o0)) + a0, x1 = (BASE_BF16 ? bf4(*(const v2u*)(baseb + o1)) : *(const f32x4*)(base + o1)) + a1;
        float ss = (x0[0] * x0[0] + x0[1] * x0[1]) + (x0[2] * x0[2] + x0[3] * x0[3]) + (x1[0] * x1[0] + x1[1] * x1[1]) + (x1[2] * x1[2] + x1[3] * x1[3]);
        *(v2u*)(Xb + o0) = (v2u){att::cvtpk(x0[0], x0[1]), att::cvtpk(x0[2], x0[3])};
        *(v2u*)(Xb + o1) = (v2u){att::cvtpk(x1[0], x1[1]), att::cvtpk(x1[2], x1[3])};
        ss += __shfl_xor(ss, 16); ss += __shfl_xor(ss, 32);
        if (fq == 0) atomicAdd(SS + row, ss);
    }
};
struct EpiFinalB {
    const float* SS; const bf16_t* T; const bf16_t* xb; float* yo;
    __device__ __forceinline__ void operator()(int row, int c0, const f32x4 a0, int c1, const f32x4 a1, int) const {
        const float r = __builtin_amdgcn_rsqf(SS[row] * (1.0f / DM) + EPS);
        const size_t o0 = (size_t)row * DM + c0, o1 = (size_t)row * DM + c1;
        const f32x4 tf0 = bf4(*(const v2u*)(T + o0)), tf1 = bf4(*(const v2u*)(T + o1)), y0 = bf4(*(const v2u*)(xb + o0)), y1 = bf4(*(const v2u*)(xb + o1));
        *(f32x4*)(yo + o0) = y0 + pg8::sig4(a0 * r) * tf0;
        *(f32x4*)(yo + o1) = y1 + pg8::sig4(a1 * r) * tf1;
    }
};
}
#ifndef PG8_SP2
#define PG8_SP2 true
#endif
#ifndef PG8_ALIGN
#define PG8_ALIGN true
#endif
__global__ void __launch_bounds__(NTHREADS, 2) fwd(Args args) {
    extern __shared__ __attribute__((aligned(16))) unsigned char lds_raw[];
    LAS unsigned char* lds = (LAS unsigned char*)lds_raw;
    volatile LAS unsigned* MISC = (volatile LAS unsigned*)(lds + MISC_OFF);
    const int tid = threadIdx.x, lane = tid & 63, wave = __builtin_amdgcn_readfirstlane(tid >> 6);
    const int G = gridDim.x, bx = blockIdx.x;
    const int vcu = (G % 8 == 0) ? (bx % 8) * (G / 8) + bx / 8 : bx;
    gu32* ctl = (gu32*)(args.ws + WS_CTL);
    for (int u = tid; u < (LDS_BYTES - LDSCTL_OFF) / 4; u += NTHREADS) ((LAS unsigned*)(lds + LDSCTL_OFF))[u] = 0u;
    __syncthreads();
    const int lo = args.ph_lo, hi = args.ph_hi;
    const bool multi = (hi - lo) > 1;
    XcdBarrier bar; bar.bar = (unsigned*)ctl + CW_BAR + args.li * XCD_BAR_WORDS; bar.x = 0; bar.st = nullptr;
    if (multi) bar = xcd_barrier_post((unsigned*)ctl + CW_BAR + args.li * XCD_BAR_WORDS, MISC + 8);
#ifndef PHASE_MASK
#define PHASE_MASK 0x7f
#endif
#define WSB(T_, off) ((T_*)(args.ws + (off)))
#define IN(k) (((PHASE_MASK >> (k)) & 1) && lo <= (k) && (k) < hi)
#define SEAM(k) do { if (IN(k) && IN((k) + 1)) xcd_barrier(bar); } while (0)
#ifndef PROBE_REP
#define PROBE_REP (-1)
#endif
#define PHASE(k, ...) do { if (IN(k)) { { constexpr int rep = 0; (void)rep; __VA_ARGS__ } if (PROBE_REP == (k)) { xcd_barrier(bar); { constexpr int rep = 1; (void)rep; __VA_ARGS__ } } } } while (0)
    PHASE(0, { p0_prologue(args, lds, vcu * NWAVES + wave, G * NWAVES, lane); });
    SEAM(0);
    PHASE(1, {
        { pg8::Gemm g{WSB(bf16_t, WS_H), WSB(const bf16_t, WS_WIN), M, NIN, DM}; pg8::StaticOrder S; S.init(M, NIN, G, bx);
          pg8::EpiInProj E{args.in[9], args.in[10], args.out, args.ws, args.fc};
          pg8::gemm_phase<pg8::EpiInProj, pg8::StaticOrder, PG8_ALIGN, PG8_SP2>(lds + RING_OFF, g, S, E); }
        asm volatile("" ::: "memory");
        if (G != 256 || bx >= 128) {
          pg8::Gemm g{WSB(bf16_t, WS_PB), WSB(const bf16_t, WS_WPL), MP, DM, PLE}; pg8::StaticOrder S; S.init(MP, DM, G == 256 ? 128 : G, G == 256 ? (bx & 127) : bx);
          pg8::EpiStoreBf16 E{WSB(bf16_t, WS_T)};
          pg8::gemm_phase<pg8::EpiStoreBf16, pg8::StaticOrder, PG8_ALIGN, PG8_SP2>(lds + RING_OFF, g, S, E);
          sg::EpiStoreBf16 E2{WSB(bf16_t, WS_T)}; sg::sgemm_phase(lds + RING_OFF, WSB(const bf16_t, WS_PB) + (size_t)MP * PLE, WSB(const bf16_t, WS_WPL), PLE, G == 256 ? (bx & 127) : bx, G == 256 ? 128 : G, E2); }
    });
    SEAM(1);
    PHASE(2, { p2_mixers(args, lds, rep); });
    SEAM(2);
    PHASE(3, {
        if (bx & 1) { sg::EpiResidB<true> E{nullptr, WSB(const bf16_t, WS_H), WSB(bf16_t, WS_X1G), WSB(float, WS_SS + rep * 256 * 1024)};
          sg::sgemm_phase(lds + RING_OFF, WSB(const bf16_t, WS_MIX) + (size_t)MP * 2048, WSB(const bf16_t, WS_WO), 2048, bx, G, E); }
        { pg8::Gemm g{WSB(bf16_t, WS_MIX), WSB(const bf16_t, WS_WO), MP, DM, 2048}; pg8::StaticOrder S; S.init(MP, DM, G, bx);
          pg8::EpiResidB<true> E{nullptr, nullptr, WSB(const bf16_t, WS_H), WSB(bf16_t, WS_X1G), WSB(float, WS_SS + rep * 256 * 1024)};
          pg8::gemm_phase<pg8::EpiResidB<true>, pg8::StaticOrder, PG8_ALIGN, PG8_SP2>(lds + RING_OFF, g, S, E); }
        if (!(bx & 1)) { sg::EpiResidB<true> E{nullptr, WSB(const bf16_t, WS_H), WSB(bf16_t, WS_X1G), WSB(float, WS_SS + rep * 256 * 1024)};
          sg::sgemm_phase(lds + RING_OFF, WSB(const bf16_t, WS_MIX) + (size_t)MP * 2048, WSB(const bf16_t, WS_WO), 2048, bx, G, E); }
    });
    SEAM(3);
    PHASE(4, {
        pg8::Gemm g{WSB(bf16_t, WS_X1G), WSB(const bf16_t, WS_WGU), M, 2 * DFF, DM}; pg8::StaticOrder S; S.init(M, 2 * DFF, G, bx);
        pg8::EpiGateUp E{WSB(const float, WS_SS), WSB(bf16_t, WS_HID)};
        pg8::gemm_phase<pg8::EpiGateUp, pg8::StaticOrder, PG8_ALIGN, PG8_SP2>(lds + RING_OFF, g, S, E);
        if (bx >= G - 40 && rep == 0) {
            int t4 = threadIdx.x; asm volatile("" : "+v"(t4));
            const int w4 = __builtin_amdgcn_readfirstlane(t4 >> 6);
            LAS float* scr = (LAS float*)(lds + w4 * 16384);
            _Pragma("unroll 1") for (int it = LW_I_O + LW_I_GU + (bx - (G - 40)) * 8 + w4; it < LW_ITEMS; it += 40 * 8) late_weight_item(args, it, scr, t4 & 63);
        }
    });
    SEAM(4);
    PHASE(5, {
        if (bx & 1) { sg::EpiResidB<true> E{nullptr, WSB(const bf16_t, WS_X1G), WSB(bf16_t, WS_X2G), WSB(float, WS_SS + 128 * 1024 + rep * 256 * 1024)};
          sg::sgemm_phase(lds + RING_OFF, WSB(const bf16_t, WS_HID) + (size_t)MP * DFF, WSB(const bf16_t, WS_WDN), DFF, bx, G, E); }
        { pg8::Gemm g{WSB(bf16_t, WS_HID), WSB(const bf16_t, WS_WDN), MP, DM, DFF}; pg8::StaticOrder S; S.init(MP, DM, G, bx);
          pg8::EpiResidB<true> E{nullptr, nullptr, WSB(const bf16_t, WS_X1G), WSB(bf16_t, WS_X2G), WSB(float, WS_SS + 128 * 1024 + rep * 256 * 1024)};
          pg8::gemm_phase<pg8::EpiResidB<true>, pg8::StaticOrder, PG8_ALIGN, PG8_SP2>(lds + RING_OFF, g, S, E); }
        if (!(bx & 1)) { sg::EpiResidB<true> E{nullptr, WSB(const bf16_t, WS_X1G), WSB(bf16_t, WS_X2G), WSB(float, WS_SS + 128 * 1024 + rep * 256 * 1024)};
          sg::sgemm_phase(lds + RING_OFF, WSB(const bf16_t, WS_HID) + (size_t)MP * DFF, WSB(const bf16_t, WS_WDN), DFF, bx, G, E); }
    });
    SEAM(5);
#ifndef PROBE_P6SUB
#define PROBE_P6SUB 3
#endif
    if (PROBE_REP == 6 && IN(6)) {
        if (PROBE_P6SUB & 1) { pg8::Gemm g{WSB(bf16_t, WS_X2G), WSB(const bf16_t, WS_WPG), MP, DM, DM}; pg8::StaticOrder S; S.init(MP, DM, G, bx);
          pg8::EpiFinalB E{WSB(const float, WS_SS + 128 * 1024), WSB(const bf16_t, WS_T), WSB(const bf16_t, WS_X2G), WSB(float, WS_NS1)};
          pg8::gemm_phase<pg8::EpiFinalB, pg8::StaticOrder, PG8_ALIGN, PG8_SP2>(lds + RING_OFF, g, S, E); }
        if (PROBE_P6SUB & 2) { sg::EpiFinalB E{WSB(const float, WS_SS + 128 * 1024), WSB(const bf16_t, WS_T), WSB(const bf16_t, WS_X2G), WSB(float, WS_NS1)};
          sg::sgemm_phase(lds + RING_OFF, WSB(const bf16_t, WS_X2G) + (size_t)MP * DM, WSB(const bf16_t, WS_WPG), DM, bx, G, E); }
        xcd_barrier(bar);
    }
    if (IN(6)) {
        if (bx & 1) { sg::EpiFinalB E{WSB(const float, WS_SS + 128 * 1024), WSB(const bf16_t, WS_T), WSB(const bf16_t, WS_X2G), args.out + O_Y};
          sg::sgemm_phase(lds + RING_OFF, WSB(const bf16_t, WS_X2G) + (size_t)MP * DM, WSB(const bf16_t, WS_WPG), DM, bx, G, E); }
        { pg8::Gemm g{WSB(bf16_t, WS_X2G), WSB(const bf16_t, WS_WPG), MP, DM, DM}; pg8::StaticOrder S; S.init(MP, DM, G, bx);
          pg8::EpiFinalB E{WSB(const float, WS_SS + 128 * 1024), WSB(const bf16_t, WS_T), WSB(const bf16_t, WS_X2G), args.out + O_Y};
          pg8::gemm_phase<pg8::EpiFinalB, pg8::StaticOrder, PG8_ALIGN, PG8_SP2>(lds + RING_OFF, g, S, E); }
        if (!(bx & 1)) { sg::EpiFinalB E{WSB(const float, WS_SS + 128 * 1024), WSB(const bf16_t, WS_T), WSB(const bf16_t, WS_X2G), args.out + O_Y};
          sg::sgemm_phase(lds + RING_OFF, WSB(const bf16_t, WS_X2G) + (size_t)MP * DM, WSB(const bf16_t, WS_WPG), DM, bx, G, E); }
    }
#undef PHASE
#undef IN
#undef SEAM
}
extern "C" void kernel_launch(void* const* d_in, const int* in_sizes, int n_in, void* d_out, int out_size, void* d_ws, size_t ws_size, hipStream_t stream) {
    static int grid = 0;
    if (grid == 0) {
        if (n_in != 23 || out_size != (int)O_END || ws_size < WS_END) { fprintf(stderr, "kernel_launch: unexpected sizes n_in %d out %d ws %zu\n", n_in, out_size, ws_size); grid = -1; return; }
        int dev = 0, cus = 0;
        if (hipGetDevice(&dev) != hipSuccess || hipDeviceGetAttribute(&cus, hipDeviceAttributeMultiprocessorCount, dev) != hipSuccess) { grid = -1; return; }
        if (hipFuncSetAttribute((const void*)fwd, hipFuncAttributeMaxDynamicSharedMemorySize, LDS_BYTES) != hipSuccess) { fprintf(stderr, "kernel_launch: hipFuncSetAttribute failed\n"); grid = -1; return; }
        grid = cus;
    }
    if (grid < 0) return;
    Args a{};
    for (int i = 0; i < 23; ++i) a.in[i] = (const float*)d_in[i];
    a.out = (float*)d_out; a.ws = (unsigned char*)d_ws; a.ph_lo = 0; a.ph_hi = 7; a.li = 0; a.fc = -1;
    (void)hipMemsetAsync((unsigned char*)d_ws + WS_CTL, 0, CTL_ZERO_BYTES, stream);
#ifdef PROBE_LAUNCH_BASE
    a.ph_hi = 2; hipLaunchKernelGGL(fwd, dim3(grid), dim3(NTHREADS), LDS_BYTES, stream, a);
    a.ph_lo = 2; a.ph_hi = 7; a.li = 2; hipLaunchKernelGGL(fwd, dim3(grid), dim3(NTHREADS), LDS_BYTES, stream, a);
#elif defined(PROBE_LAUNCH_P1)
    a.ph_hi = 2; hipLaunchKernelGGL(fwd, dim3(grid), dim3(NTHREADS), LDS_BYTES, stream, a);
    a.ph_lo = 1; a.ph_hi = 2; a.li = 1; a.fc = PROBE_LAUNCH_P1; hipLaunchKernelGGL(fwd, dim3(grid), dim3(NTHREADS), LDS_BYTES, stream, a);
    a.ph_lo = 2; a.ph_hi = 7; a.li = 2; a.fc = -1; hipLaunchKernelGGL(fwd, dim3(grid), dim3(NTHREADS), LDS_BYTES, stream, a);
#else
    hipLaunchKernelGGL(fwd, dim3(grid), dim3(NTHREADS), LDS_BYTES, stream, a);
#endif
}
```
